# Optimizing an MI355X kernel written in HIP

```python
import math
import jax, jax.numpy as jnp
from jax import lax
import numpy as np

D_MODEL = 1024
BATCH = 8
SEQ = 2048
DEPTH = 1

HEAD_DIM = 64
N_HEADS = D_MODEL // HEAD_DIM
MOBA_HEADS = N_HEADS // 2
DIL_HEADS = N_HEADS - MOBA_HEADS
MOBA_WIDTH = MOBA_HEADS * HEAD_DIM
DIL_WIDTH = DIL_HEADS * HEAD_DIM
MIX_WIDTH = MOBA_WIDTH + DIL_WIDTH
IN_WIDTH = 3 * MIX_WIDTH
MOBA_BLOCK = 256
MOBA_TOPK = 3
MOBA_Q_CHUNK = 32
DIL_PAIRS = ((128, 1), (512, 4), (2048, 16))
DIL_BLOCK = 128
REL_BUCKETS = 32
REL_MAX_EXACT = 16
REL_MAX_DIST = 2048
PEER_HEADS = 8
PEER_N_KEYS = 128
PEER_N_EXPERTS = PEER_N_KEYS * PEER_N_KEYS
PEER_TOPK = 16
PEER_DK = 128
PEER_CHUNK = 128
DEEPNORM_ALPHA = (2 * DEPTH) ** 0.25
DEEPNORM_BETA = (8 * DEPTH) ** -0.25
LN_EPS = 1e-5
NEG_INF = -1e30

kernel_name = "hybrid_moba_dilated_peer_block"


def layer_norm(x, g, b):
    xf = x.astype(jnp.float32)
    mu = xf.mean(-1, keepdims=True)
    var = jnp.square(xf - mu).mean(-1, keepdims=True)
    return ((xf - mu) * lax.rsqrt(var + LN_EPS) * g + b).astype(x.dtype)


def rms_norm(x, g):
    xf = x.astype(jnp.float32)
    return (xf * lax.rsqrt(jnp.square(xf).mean(-1, keepdims=True) + LN_EPS) * g).astype(x.dtype)


def t5_bucket(dist):
    n = jnp.maximum(dist, 0)
    nf = jnp.maximum(n, 1).astype(jnp.float32)
    large = REL_MAX_EXACT + (jnp.log(nf / REL_MAX_EXACT) / math.log(REL_MAX_DIST / REL_MAX_EXACT)
                             * (REL_BUCKETS - REL_MAX_EXACT)).astype(jnp.int32)
    large = jnp.minimum(large, REL_BUCKETS - 1)
    return jnp.where(n < REL_MAX_EXACT, n, large)


def moba_attention(q, k, v, bias_tab):
    B, H, S, hd = q.shape
    nb = -(-S // MOBA_BLOCK)
    Sp = nb * MOBA_BLOCK
    pad = ((0, 0), (0, 0), (0, Sp - S), (0, 0))
    kp, vp = jnp.pad(k, pad), jnp.pad(v, pad)
    kblk = kp.reshape(B, H, nb, MOBA_BLOCK, hd)
    vblk = vp.reshape(B, H, nb, MOBA_BLOCK, hd)
    kmean = kblk.astype(jnp.float32).mean(3)
    qblk = jnp.arange(S) // MOBA_BLOCK
    gate = jnp.einsum('bhsd,bhnd->bhsn', q.astype(jnp.float32), kmean)
    past = jnp.arange(nb)[None, :] < qblk[:, None]
    gate = jnp.where(past, gate, -jnp.inf)
    k_sel = min(MOBA_TOPK, nb)
    _, sel = lax.top_k(gate, k_sel)
    sel_valid = jnp.arange(k_sel)[None, :] < qblk[:, None]
    scale = hd ** -0.5
    bi = jnp.arange(B)[:, None, None, None]
    hi = jnp.arange(H)[None, :, None, None]
    hi5 = jnp.arange(H)[None, :, None, None, None]

    def chunk(ci):
        t0 = ci * MOBA_Q_CHUNK
        qc = lax.dynamic_slice_in_dim(q, t0, MOBA_Q_CHUNK, 2)
        selc = lax.dynamic_slice_in_dim(sel, t0, MOBA_Q_CHUNK, 2)
        validc = lax.dynamic_slice_in_dim(sel_valid, t0, MOBA_Q_CHUNK, 0)
        qpos = t0 + jnp.arange(MOBA_Q_CHUNK)
        ks = kblk[bi, hi, selc]
        vs = vblk[bi, hi, selc]
        l_sel = jnp.einsum('bhqd,bhqkjd->bhqkj', qc, ks).astype(jnp.float32) * scale
        kpos_sel = selc[..., None] * MOBA_BLOCK + jnp.arange(MOBA_BLOCK)
        l_sel = l_sel + bias_tab[hi5, t5_bucket(qpos[:, None, None] - kpos_sel)]
        l_sel = jnp.where(validc[None, None, :, :, None], l_sel, NEG_INF)
        own0 = (t0 // MOBA_BLOCK) * MOBA_BLOCK
        ko = lax.dynamic_slice_in_dim(kp, own0, MOBA_BLOCK, 2)
        vo = lax.dynamic_slice_in_dim(vp, own0, MOBA_BLOCK, 2)
        dist = qpos[:, None] - (own0 + jnp.arange(MOBA_BLOCK))[None, :]
        l_own = jnp.einsum('bhqd,bhjd->bhqj', qc, ko).astype(jnp.float32) * scale
        l_own = jnp.where(dist >= 0, l_own + bias_tab[:, t5_bucket(dist)], NEG_INF)
        n_sel = k_sel * MOBA_BLOCK
        p = jax.nn.softmax(jnp.concatenate(
            [l_sel.reshape(B, H, MOBA_Q_CHUNK, n_sel), l_own], -1), axis=-1).astype(v.dtype)
        p_sel = p[..., :n_sel].reshape(B, H, MOBA_Q_CHUNK, k_sel, MOBA_BLOCK)
        return (jnp.einsum('bhqkj,bhqkjd->bhqd', p_sel, vs)
                + jnp.einsum('bhqj,bhjd->bhqd', p[..., n_sel:], vo))

    outs = lax.map(chunk, jnp.arange(S // MOBA_Q_CHUNK))
    return outs.transpose(1, 2, 0, 3, 4).reshape(B, H, S, hd)


def dilated_branch(q, k, v, bias_tab, window, dil):
    B, H, S, hd = q.shape
    L = S // dil
    nblk = -(-L // DIL_BLOCK)
    Lp = nblk * DIL_BLOCK

    def to_blocks(a):
        a = a.reshape(B, H, L, dil, hd).transpose(0, 1, 3, 2, 4)
        a = jnp.pad(a, ((0, 0), (0, 0), (0, 0), (0, Lp - L), (0, 0)))
        return a.reshape(B, H, dil, nblk, DIL_BLOCK, hd)

    qb, kb, vb = to_blocks(q), to_blocks(k), to_blocks(v)
    pad_prev = ((0, 0), (0, 0), (0, 0), (1, 0), (0, 0), (0, 0))
    k2 = jnp.concatenate([jnp.pad(kb, pad_prev)[:, :, :, :-1], kb], axis=4)
    v2 = jnp.concatenate([jnp.pad(vb, pad_prev)[:, :, :, :-1], vb], axis=4)
    logits = jnp.einsum('bhrnqd,bhrnkd->bhrnqk', qb, k2).astype(jnp.float32) * hd ** -0.5
    i = jnp.arange(DIL_BLOCK)[:, None]
    j = jnp.arange(2 * DIL_BLOCK)[None, :]
    off = DIL_BLOCK + i - j
    band = (off >= 0) & (off <= window // dil)
    has_prev = (jnp.arange(nblk)[:, None, None] > 0) | (j[None] >= DIL_BLOCK)
    mask = band[None] & has_prev
    bias = bias_tab[:, t5_bucket(off * dil)]
    logits = jnp.where(mask, logits + bias[:, None, None], NEG_INF)
    lse = jax.nn.logsumexp(logits, axis=-1)
    p = jnp.exp(logits - lse[..., None]).astype(v.dtype)
    o = jnp.einsum('bhrnqk,bhrnkd->bhrnqd', p, v2)
    o = o.reshape(B, H, dil, Lp, hd)[:, :, :, :L].transpose(0, 1, 3, 2, 4).reshape(B, H, S, hd)
    lse = lse.reshape(B, H, dil, Lp)[..., :L].transpose(0, 1, 3, 2).reshape(B, H, S)
    return o, lse


def dilated_attention(q, k, v, bias_tab):
    outs, lses = [], []
    for window, dil in DIL_PAIRS:
        o, l = dilated_branch(q, k, v, bias_tab, window, dil)
        outs.append(o)
        lses.append(l)
    wts = jax.nn.softmax(jnp.stack(lses, 0), axis=0)
    out = jnp.einsum('nbhs,nbhsd->bhsd', wts, jnp.stack(outs, 0).astype(jnp.float32))
    return out.astype(q.dtype)


def peer_ffn(h, w_q, sub_keys, u_tab, v_tab):
    B, S, D = h.shape
    T = B * S
    xt = h.reshape(T, D)
    q = (xt @ w_q).reshape(T, PEER_HEADS, PEER_DK)
    half = PEER_DK // 2
    s1 = jnp.einsum('thd,nd->thn', q[..., :half], sub_keys[0]).astype(jnp.float32)
    s2 = jnp.einsum('thd,nd->thn', q[..., half:], sub_keys[1]).astype(jnp.float32)
    v1, i1 = lax.top_k(s1, PEER_TOPK)
    v2, i2 = lax.top_k(s2, PEER_TOPK)
    cand = (v1[..., :, None] + v2[..., None, :]).reshape(T, PEER_HEADS, PEER_TOPK * PEER_TOPK)
    vals, pos = lax.top_k(cand, PEER_TOPK)
    e = (jnp.take_along_axis(i1, pos // PEER_TOPK, -1) * PEER_N_KEYS
         + jnp.take_along_axis(i2, pos % PEER_TOPK, -1))
    g = jax.nn.softmax(vals, axis=-1).astype(h.dtype)
    nc = T // PEER_CHUNK

    def chunk(args):
        xc, ec, gc = args
        pre = jnp.einsum('cd,chkd->chk', xc, u_tab[ec])
        a = jax.nn.gelu(pre, approximate=False) * gc
        return jnp.einsum('chk,chkd->cd', a, v_tab[ec])

    out = lax.map(chunk, (xt.reshape(nc, PEER_CHUNK, D),
                          e.reshape(nc, PEER_CHUNK, PEER_HEADS, PEER_TOPK),
                          g.reshape(nc, PEER_CHUNK, PEER_HEADS, PEER_TOPK)))
    return out.reshape(B, S, D)


def setup_inputs(seed: int = 0) -> dict:
    key = jax.random.key(seed)
    ks = jax.random.split(key, 17)
    f32 = jnp.float32

    def nrm(k, shape, s):
        return jax.random.normal(k, shape, f32) * s

    beta = DEEPNORM_BETA
    col_scale = jnp.concatenate([
        jnp.ones((2 * MOBA_WIDTH,), f32), jnp.full((MOBA_WIDTH,), beta, f32),
        jnp.ones((2 * DIL_WIDTH,), f32), jnp.full((DIL_WIDTH,), beta, f32)])
    return {
        "x": nrm(ks[0], (BATCH, SEQ, D_MODEL), 1.0),
        "c": nrm(ks[1], (BATCH, D_MODEL), 1.0),
        "w_ada": nrm(ks[2], (DEPTH, D_MODEL, 6 * D_MODEL), 0.2 * D_MODEL ** -0.5),
        "b_ada": nrm(ks[3], (DEPTH, 6 * D_MODEL), 0.01),
        "w_in": nrm(ks[4], (DEPTH, D_MODEL, IN_WIDTH), D_MODEL ** -0.5) * col_scale,
        "rel_bias": nrm(ks[5], (N_HEADS, REL_BUCKETS), 0.2),
        "gn_moba": 1.0 + nrm(ks[6], (DEPTH, MOBA_WIDTH), 0.02),
        "gn_dil": 1.0 + nrm(ks[7], (DEPTH, DIL_WIDTH), 0.02),
        "w_out": nrm(ks[8], (DEPTH, MIX_WIDTH, D_MODEL), beta * MIX_WIDTH ** -0.5),
        "ln1_g": 1.0 + nrm(ks[9], (DEPTH, D_MODEL), 0.02),
        "ln1_b": nrm(ks[10], (DEPTH, D_MODEL), 0.02),
        "w_q_peer": nrm(ks[11], (DEPTH, D_MODEL, PEER_HEADS * PEER_DK), D_MODEL ** -0.5),
        "sub_keys": nrm(ks[12], (DEPTH, 2, PEER_N_KEYS, PEER_DK // 2), (PEER_DK // 2) ** -0.5),
        "peer_u": nrm(ks[13], (DEPTH, PEER_N_EXPERTS, D_MODEL), beta * D_MODEL ** -0.5),
        "peer_v": nrm(ks[14], (DEPTH, PEER_N_EXPERTS, D_MODEL), beta),
        "ln2_g": 1.0 + nrm(ks[15], (DEPTH, D_MODEL), 0.02),
        "ln2_b": nrm(ks[16], (DEPTH, D_MODEL), 0.02),
    }


def reference(x, c, w_ada, b_ada, w_in, rel_bias, gn_moba, gn_dil, w_out, ln1_g, ln1_b,
              w_q_peer, sub_keys, peer_u, peer_v, ln2_g, ln2_b):
    B, S, D = x.shape
    bias_moba = rel_bias[:MOBA_HEADS]
    bias_dil = rel_bias[MOBA_HEADS:]
    c_act = jax.nn.silu(c)

    def heads(a, n):
        return a.reshape(B, S, n, HEAD_DIM).transpose(0, 2, 1, 3)

    for l in range(DEPTH):
        mod = c_act @ w_ada[l] + b_ada[l]
        sh1, sc1, g1, sh2, sc2, g2 = [m[:, None, :] for m in jnp.split(mod, 6, axis=-1)]
        h = x * (1 + sc1) + sh1
        proj = h @ w_in[l]
        qa, ka, va, qb, kb, vb = jnp.split(
            proj, np.cumsum([MOBA_WIDTH] * 3 + [DIL_WIDTH] * 2).tolist(), axis=-1)
        ya = moba_attention(heads(qa, MOBA_HEADS), heads(ka, MOBA_HEADS), heads(va, MOBA_HEADS), bias_moba)
        yb = dilated_attention(heads(qb, DIL_HEADS), heads(kb, DIL_HEADS), heads(vb, DIL_HEADS), bias_dil)
        ya = rms_norm(ya.transpose(0, 2, 1, 3).reshape(B, S, MOBA_WIDTH), gn_moba[l])
        yb = rms_norm(yb.transpose(0, 2, 1, 3).reshape(B, S, DIL_WIDTH), gn_dil[l])
        y = jnp.concatenate([ya, yb], axis=-1) @ w_out[l]
        x = layer_norm(DEEPNORM_ALPHA * x + (1 + g1) * y, ln1_g[l], ln1_b[l])
        h2 = x * (1 + sc2) + sh2
        f = peer_ffn(h2, w_q_peer[l], sub_keys[l], peer_u[l], peer_v[l])
        x = layer_norm(DEEPNORM_ALPHA * x + (1 + g2) * f, ln2_g[l], ln2_b[l])
    return x
```

```cpp
#include <hip/hip_runtime.h>
#include <stdint.h>
#include <math.h>

namespace {
constexpr int NB = 8, SEQ = 2048, DM = 1024, T = NB * SEQ, NQKV = 3072;
constexpr float LN_EPS = 1e-5f;
constexpr float DN_ALPHA = 1.189207115002721f;

__device__ __forceinline__ int t5_bucket(int d) {
    if (d < 16) return d;
    int b = 16;
    b += (d >= 22); b += (d >= 30); b += (d >= 40); b += (d >= 54); b += (d >= 73); b += (d >= 99); b += (d >= 134); b += (d >= 182);
    b += (d >= 246); b += (d >= 332); b += (d >= 450); b += (d >= 609); b += (d >= 825); b += (d >= 1117); b += (d >= 1513);
    return b;
}
__device__ __forceinline__ float wave_sum(float v) {
#pragma unroll
    for (int o = 1; o < 64; o <<= 1) v += __shfl_xor(v, o);
    return v;
}

__global__ void k_mod(const float* c, const float* w_ada, const float* b_ada, float* mod) {
    __shared__ float sc[DM];
    const int b = blockIdx.y, j = blockIdx.x * 256 + threadIdx.x;
    for (int i = threadIdx.x; i < DM; i += 256) { const float v = c[b * DM + i]; sc[i] = v / (1.f + expf(-v)); }
    __syncthreads();
    float acc = 0.f;
    for (int i = 0; i < DM; ++i) acc += sc[i] * w_ada[(size_t)i * 6144 + j];
    mod[b * 6144 + j] = acc + b_ada[j];
}

template <bool MODA>
__global__ void k_gemm(const float* A, const float* B, float* C, int M, int N, int K, const float* mod, int sc_off, int sh_off) {
    __shared__ float As[16][65], Bs[16][64];
    const int bm = blockIdx.y * 64, bn = blockIdx.x * 64, tx = threadIdx.x & 15, ty = threadIdx.x >> 4;
    float acc[4][4];
#pragma unroll
    for (int i = 0; i < 4; ++i)
#pragma unroll
        for (int j = 0; j < 4; ++j) acc[i][j] = 0.f;
    const int bidx = bm / SEQ;
    for (int k0 = 0; k0 < K; k0 += 16) {
#pragma unroll
        for (int i = 0; i < 4; ++i) {
            const int idx = threadIdx.x + i * 256, r = idx >> 4, cc = idx & 15;
            float a = A[(size_t)(bm + r) * K + k0 + cc];
            if (MODA) a = a * (1.f + mod[bidx * 6144 + sc_off + k0 + cc]) + mod[bidx * 6144 + sh_off + k0 + cc];
            As[cc][r] = a;
            const int r2 = idx >> 6, c2 = idx & 63;
            Bs[r2][c2] = B[(size_t)(k0 + r2) * N + bn + c2];
        }
        __syncthreads();
#pragma unroll
        for (int kk = 0; kk < 16; ++kk) {
            float a[4], b[4];
#pragma unroll
            for (int i = 0; i < 4; ++i) { a[i] = As[kk][ty * 4 + i]; b[i] = Bs[kk][tx * 4 + i]; }
#pragma unroll
            for (int i = 0; i < 4; ++i)
#pragma unroll
                for (int j = 0; j < 4; ++j) acc[i][j] += a[i] * b[j];
        }
        __syncthreads();
    }
#pragma unroll
    for (int i = 0; i < 4; ++i)
#pragma unroll
        for (int j = 0; j < 4; ++j) C[(size_t)(bm + ty * 4 + i) * N + bn + tx * 4 + j] = acc[i][j];
}

__global__ void k_kmean(const float* proj, float* kmean) {
    const int idx = blockIdx.x * 256 + threadIdx.x;
    const int d = idx & 63, n = (idx >> 6) & 7, h = (idx >> 9) & 7, b = idx >> 12;
    float s = 0.f;
    for (int j = 0; j < 256; ++j) s += proj[(size_t)(b * SEQ + n * 256 + j) * NQKV + 512 + h * 64 + d];
    kmean[idx] = s * (1.f / 256.f);
}

__global__ void __launch_bounds__(128) k_moba(const float* proj, const float* kmean, const float* rel_bias, float* out) {
    const int idx = blockIdx.x * 128 + threadIdx.x;
    const int s = idx & (SEQ - 1), h = (idx >> 11) & 7, b = idx >> 14;
    const float* qp = proj + (size_t)(b * SEQ + s) * NQKV + h * 64;
    float q[64], o[64];
#pragma unroll
    for (int d = 0; d < 64; ++d) { q[d] = qp[d]; o[d] = 0.f; }
    const int qblk = s >> 8;
    unsigned sel = 0;
    if (qblk <= 3) sel = (1u << qblk) - 1u;
    else {
        float g[8];
#pragma unroll
        for (int n = 0; n < 8; ++n) {
            float a = -INFINITY;
            if (n < qblk) { a = 0.f; const float* km = kmean + ((b * 8 + h) * 8 + n) * 64;
#pragma unroll
                for (int d = 0; d < 64; ++d) a += q[d] * km[d]; }
            g[n] = a;
        }
#pragma unroll
        for (int r = 0; r < 3; ++r) {
            float best = -INFINITY; int bi = 0;
#pragma unroll
            for (int n = 0; n < 8; ++n) { const bool take = !((sel >> n) & 1u) && (g[n] > best); best = take ? g[n] : best; bi = take ? n : bi; }
            sel |= 1u << bi;
        }
    }
    float m = -INFINITY, l = 0.f;
    const float* bias = rel_bias + h * 32;
    for (int n = 0; n <= qblk; ++n) {
        if (n < qblk && !((sel >> n) & 1u)) continue;
        const int jmax = (n == qblk) ? (s & 255) : 255;
        for (int j = 0; j <= jmax; ++j) {
            const int kpos = n * 256 + j;
            const float* kp = proj + (size_t)(b * SEQ + kpos) * NQKV + 512 + h * 64;
            float a = 0.f;
#pragma unroll
            for (int d = 0; d < 64; ++d) a += q[d] * kp[d];
            a = a * 0.125f + bias[t5_bucket(s - kpos)];
            const float mn = fmaxf(m, a), al = expf(m - mn), p = expf(a - mn);
            l = l * al + p; m = mn;
            const float* vp = kp + 512;
#pragma unroll
            for (int d = 0; d < 64; ++d) o[d] = o[d] * al + p * vp[d];
        }
    }
    const float inv = 1.f / l;
    float* op = out + (size_t)(b * SEQ + s) * DM + h * 64;
#pragma unroll
    for (int d = 0; d < 64; ++d) op[d] = o[d] * inv;
}

__global__ void __launch_bounds__(128) k_dil(const float* proj, const float* rel_bias, float* out) {
    const int idx = blockIdx.x * 128 + threadIdx.x;
    const int s = idx & (SEQ - 1), h = (idx >> 11) & 7, b = idx >> 14;
    const float* qp = proj + (size_t)(b * SEQ + s) * NQKV + 1536 + h * 64;
    float q[64], o[64];
#pragma unroll
    for (int d = 0; d < 64; ++d) { q[d] = qp[d]; o[d] = 0.f; }
    float m = -INFINITY, l = 0.f;
    const float* bias = rel_bias + (8 + h) * 32;
    for (int br = 0; br < 3; ++br) {
        const int dil = (br == 0) ? 1 : (br == 1 ? 4 : 16);
        for (int j = 0; j <= 128; ++j) {
            const int kpos = s - j * dil;
            if (kpos < 0) break;
            const float* kp = proj + (size_t)(b * SEQ + kpos) * NQKV + 2048 + h * 64;
            float a = 0.f;
#pragma unroll
            for (int d = 0; d < 64; ++d) a += q[d] * kp[d];
            a = a * 0.125f + bias[t5_bucket(j * dil)];
            const float mn = fmaxf(m, a), al = expf(m - mn), p = expf(a - mn);
            l = l * al + p; m = mn;
            const float* vp = kp + 512;
#pragma unroll
            for (int d = 0; d < 64; ++d) o[d] = o[d] * al + p * vp[d];
        }
    }
    const float inv = 1.f / l;
    float* op = out + (size_t)(b * SEQ + s) * DM + 512 + h * 64;
#pragma unroll
    for (int d = 0; d < 64; ++d) op[d] = o[d] * inv;
}

__global__ void k_rms(float* y, const float* gn_moba, const float* gn_dil) {
    const int row = blockIdx.x * 4 + (threadIdx.x >> 6), lane = threadIdx.x & 63;
    float* r = y + (size_t)row * DM;
    for (int half = 0; half < 2; ++half) {
        const float* g = half ? gn_dil : gn_moba;
        float v[8], ss = 0.f;
#pragma unroll
        for (int j = 0; j < 8; ++j) { v[j] = r[half * 512 + lane + 64 * j]; ss += v[j] * v[j]; }
        ss = wave_sum(ss);
        const float rs = rsqrtf(ss * (1.f / 512.f) + LN_EPS);
#pragma unroll
        for (int j = 0; j < 8; ++j) r[half * 512 + lane + 64 * j] = v[j] * rs * g[lane + 64 * j];
    }
}

__global__ void k_ln1(const float* x, const float* y, const float* mod, const float* lg, const float* lb, float* x1) {
    const int row = blockIdx.x * 4 + (threadIdx.x >> 6), lane = threadIdx.x & 63, b = row / SEQ;
    float z[16], s = 0.f;
#pragma unroll
    for (int j = 0; j < 16; ++j) { const int c = lane + 64 * j; z[j] = DN_ALPHA * x[(size_t)row * DM + c] + (1.f + mod[b * 6144 + 2048 + c]) * y[(size_t)row * DM + c]; s += z[j]; }
    const float mu = wave_sum(s) * (1.f / DM);
    float q = 0.f;
#pragma unroll
    for (int j = 0; j < 16; ++j) { z[j] -= mu; q += z[j] * z[j]; }
    const float rs = rsqrtf(wave_sum(q) * (1.f / DM) + LN_EPS);
#pragma unroll
    for (int j = 0; j < 16; ++j) { const int c = lane + 64 * j; x1[(size_t)row * DM + c] = z[j] * rs * lg[c] + lb[c]; }
}

__global__ void __launch_bounds__(64) k_topk(const float* qp, const float* sub_keys, int* elist, float* glist) {
    __shared__ float sS[64][129];
    __shared__ float sV[64][2][16];
    __shared__ int sI[64][2][16];
    const int tid = threadIdx.x, p = blockIdx.x * 64 + tid, tok = p >> 3, head = p & 7;
    const float* q = qp + (size_t)tok * DM + head * 128;
    for (int hf = 0; hf < 2; ++hf) {
        float qv[64];
#pragma unroll
        for (int d = 0; d < 64; ++d) qv[d] = q[hf * 64 + d];
        for (int n = 0; n < 128; ++n) {
            const float* kk = sub_keys + (size_t)(hf * 128 + n) * 64;
            float a = 0.f;
#pragma unroll
            for (int d = 0; d < 64; ++d) a += qv[d] * kk[d];
            sS[tid][n] = a;
        }
        for (int r = 0; r < 16; ++r) {
            float best = -INFINITY; int bi = 0;
            for (int n = 0; n < 128; ++n) { const float v = sS[tid][n]; if (v > best) { best = v; bi = n; } }
            sV[tid][hf][r] = best; sI[tid][hf][r] = bi; sS[tid][bi] = -INFINITY;
        }
    }
    unsigned taken[8] = {0, 0, 0, 0, 0, 0, 0, 0};
    float vals[16]; int ex[16];
#pragma unroll
    for (int r = 0; r < 16; ++r) {
        float best = -INFINITY; int bp = 0;
        for (int a = 0; a < 16; ++a) {
            const float va = sV[tid][0][a];
            for (int bb = 0; bb < 16; ++bb) {
                const int pos = a * 16 + bb;
                unsigned tk = 0;
#pragma unroll
                for (int w = 0; w < 8; ++w) tk = (w == (pos >> 5)) ? taken[w] : tk;
                const float v = va + sV[tid][1][bb];
                if (!((tk >> (pos & 31)) & 1u) && v > best) { best = v; bp = pos; }
            }
        }
#pragma unroll
        for (int w = 0; w < 8; ++w) if (w == (bp >> 5)) taken[w] |= 1u << (bp & 31);
        vals[r] = best; ex[r] = sI[tid][0][bp >> 4] * 128 + sI[tid][1][bp & 15];
    }
    float sum = 0.f; const float vmax = vals[0];
#pragma unroll
    for (int r = 0; r < 16; ++r) { vals[r] = expf(vals[r] - vmax); sum += vals[r]; }
    const float inv = 1.f / sum;
#pragma unroll
    for (int r = 0; r < 16; ++r) { elist[(size_t)p * 16 + r] = ex[r]; glist[(size_t)p * 16 + r] = vals[r] * inv; }
}

__global__ void k_peer(const float* x1, const float* mod, const int* elist, const float* glist, const float* pu, const float* pv,
                       const float* lg, const float* lb, float* out) {
    const int row = blockIdx.x * 4 + (threadIdx.x >> 6), lane = threadIdx.x & 63, b = row / SEQ;
    float xr[16], hx[16], f[16];
#pragma unroll
    for (int j = 0; j < 16; ++j) { const int c = lane + 64 * j; xr[j] = x1[(size_t)row * DM + c]; hx[j] = xr[j] * (1.f + mod[b * 6144 + 4096 + c]) + mod[b * 6144 + 3072 + c]; f[j] = 0.f; }
    for (int k = 0; k < 128; ++k) {
        const int e = elist[(size_t)row * 128 + k]; const float g = glist[(size_t)row * 128 + k];
        const float* u = pu + (size_t)e * DM; const float* v = pv + (size_t)e * DM;
        float a = 0.f;
#pragma unroll
        for (int j = 0; j < 16; ++j) a += hx[j] * u[lane + 64 * j];
        a = wave_sum(a);
        const float act = 0.5f * a * (1.f + erff(a * 0.70710678118654752f)) * g;
#pragma unroll
        for (int j = 0; j < 16; ++j) f[j] += act * v[lane + 64 * j];
    }
    float z[16], s = 0.f;
#pragma unroll
    for (int j = 0; j < 16; ++j) { const int c = lane + 64 * j; z[j] = DN_ALPHA * xr[j] + (1.f + mod[b * 6144 + 5120 + c]) * f[j]; s += z[j]; }
    const float mu = wave_sum(s) * (1.f / DM);
    float q = 0.f;
#pragma unroll
    for (int j = 0; j < 16; ++j) { z[j] -= mu; q += z[j] * z[j]; }
    const float rs = rsqrtf(wave_sum(q) * (1.f / DM) + LN_EPS);
#pragma unroll
    for (int j = 0; j < 16; ++j) { const int c = lane + 64 * j; out[(size_t)row * DM + c] = z[j] * rs * lg[c] + lb[c]; }
}
}

extern "C" void kernel_launch(void* const* d_in, const int* in_sizes, int n_in, void* d_out, int out_size, void* d_ws, size_t ws_size, hipStream_t stream) {
    const float* x = (const float*)d_in[0];      const float* c = (const float*)d_in[1];
    const float* w_ada = (const float*)d_in[2];  const float* b_ada = (const float*)d_in[3];
    const float* w_in = (const float*)d_in[4];   const float* rel_bias = (const float*)d_in[5];
    const float* gn_moba = (const float*)d_in[6]; const float* gn_dil = (const float*)d_in[7];
    const float* w_out = (const float*)d_in[8];  const float* ln1_g = (const float*)d_in[9]; const float* ln1_b = (const float*)d_in[10];
    const float* w_q = (const float*)d_in[11];   const float* sub_keys = (const float*)d_in[12];
    const float* peer_u = (const float*)d_in[13]; const float* peer_v = (const float*)d_in[14];
    const float* ln2_g = (const float*)d_in[15]; const float* ln2_b = (const float*)d_in[16];
    float* out = (float*)d_out;
    char* ws = (char*)d_ws;
    const size_t MiB = 1u << 20;
    float* proj = (float*)(ws);
    float* mod = (float*)(ws + 192 * MiB);
    float* kmean = (float*)(ws + 193 * MiB);
    float* y = (float*)(ws);
    float* x1 = (float*)(ws + 64 * MiB);
    float* qp = (float*)(ws + 128 * MiB);
    int* elist = (int*)(ws + 194 * MiB);
    float* glist = (float*)(ws + 202 * MiB);

    k_mod<<<dim3(24, 8), 256, 0, stream>>>(c, w_ada, b_ada, mod);
    k_gemm<true><<<dim3(NQKV / 64, T / 64), 256, 0, stream>>>(x, w_in, proj, T, NQKV, DM, mod, 1024, 0);
    k_kmean<<<32768 / 256, 256, 0, stream>>>(proj, kmean);
    k_moba<<<T * 8 / 128, 128, 0, stream>>>(proj, kmean, rel_bias, out);
    k_dil<<<T * 8 / 128, 128, 0, stream>>>(proj, rel_bias, out);
    k_rms<<<T / 4, 256, 0, stream>>>(out, gn_moba, gn_dil);
    k_gemm<false><<<dim3(DM / 64, T / 64), 256, 0, stream>>>(out, w_out, y, T, DM, DM, nullptr, 0, 0);
    k_ln1<<<T / 4, 256, 0, stream>>>(x, y, mod, ln1_g, ln1_b, x1);
    k_gemm<true><<<dim3(DM / 64, T / 64), 256, 0, stream>>>(x1, w_q, qp, T, DM, DM, mod, 4096, 3072);
    k_topk<<<T * 8 / 64, 64, 0, stream>>>(qp, sub_keys, elist, glist);
    k_peer<<<T / 4, 256, 0, stream>>>(x1, mod, elist, glist, peer_u, peer_v, ln2_g, ln2_b, out);
}
```

```cpp
#include <hip/hip_runtime.h>
#include <stdint.h>
#include <math.h>
#include <stdio.h>
namespace pg8 {
#define PG8_LAS __attribute__((address_space(3)))
typedef unsigned short bf16_t;
typedef short bf16x8 __attribute__((ext_vector_type(8)));
typedef float f32x4 __attribute__((ext_vector_type(4)));
typedef unsigned u32x4 __attribute__((ext_vector_type(4)));
constexpr int BM = 256, BK = 64, HALF = 128, HTB = HALF * BK * 2  , STAGE_BYTES = 8 * HTB, NXCD = 8, WGM = 8;

__host__ __device__ __forceinline__ int lds_byte(int r, int c) { const int st = (r >> 4) * 2 + (c >> 5), rr = r & 15, cc = c & 31, ob = rr * 64 + cc * 2; return st * 1024 + (ob ^ (((ob >> 9) & 1) << 5)); }
__host__ __device__ __forceinline__ void stage_rc(int b, int& R, int& C) { const int st = b / 1024, sb = b % 1024, swz = sb ^ (((sb >> 9) & 1) << 5); R = (st >> 1) * 16 + swz / 64; C = (st & 1) * 32 + (swz % 64) / 2; }
__host__ __device__ __forceinline__ int perm32(int rho) { const int n = rho >> 4, i = rho & 15; return 8 * (i >> 2) + 4 * n + (i & 3); }

struct Unit { int pm, pn; };
struct Gemm { const bf16_t* A; const bf16_t* Bt; int M, N, K; };

struct StaticOrder {
    int nM, nN, nwg, G, c;
    __host__ __device__ void init(int M, int N, int G_, int c_) { nM = M / BM; nN = N / BM; nwg = nM * nN; G = G_; c = c_; }
    __host__ __device__ bool next(int i, Unit& u) const {
        const long L = (long)i * G + c; if (L >= nwg) return false;
        int wgid = (int)L; { const int q = nwg / NXCD, r = nwg % NXCD, xcd = wgid % NXCD, off = wgid / NXCD; wgid = (xcd < r ? xcd * (q + 1) : r * (q + 1) + (xcd - r) * q) + off; }
        const int nig = WGM * nN, gid = wgid / nig, fm = gid * WGM, gsz = (nM - fm) < WGM ? (nM - fm) : WGM;
        u.pm = fm + ((wgid % nig) % gsz); u.pn = (wgid % nig) / gsz; return true;
    }
    __device__ __forceinline__ void a_ready(const Unit&) const {}
    __device__ __forceinline__ void done(const Unit&) const {}
};
struct CountedOrder : StaticOrder {
    const unsigned* ready; unsigned need; unsigned* tmo;
    __device__ __forceinline__ void a_ready(const Unit& u) const {
        if (threadIdx.x < 64) {
            const unsigned long long t0 = __builtin_amdgcn_s_memrealtime(); unsigned polls = 0;
            while ((unsigned)__builtin_amdgcn_readfirstlane(__hip_atomic_load(ready + 64 * u.pm, __ATOMIC_RELAXED, __HIP_MEMORY_SCOPE_AGENT)) < need) {
                if ((++polls & 255u) == 0u && __builtin_amdgcn_readfirstlane(__hip_atomic_load(tmo, __ATOMIC_RELAXED, __HIP_MEMORY_SCOPE_AGENT)) != 0u) break;
                if (__builtin_amdgcn_s_memrealtime() - t0 > 2000000ull) {
                    if (threadIdx.x == 0) { unsigned expect = 0u; __hip_atomic_compare_exchange_strong(tmo + 1, &expect, 0x600u | (unsigned)(u.pm & 0xff), __ATOMIC_RELAXED, __ATOMIC_RELAXED, __HIP_MEMORY_SCOPE_AGENT); __hip_atomic_store(tmo, 1u, __ATOMIC_RELAXED, __HIP_MEMORY_SCOPE_AGENT); }
                    break; }
                __builtin_amdgcn_s_sleep(2); }
            __builtin_amdgcn_fence(__ATOMIC_ACQUIRE, "agent");
            asm volatile("s_waitcnt vmcnt(0)" ::: "memory");
        }
#if !defined(BROKEN_HOOK_NO_BARRIER)
        asm volatile("" ::: "memory"); __builtin_amdgcn_s_barrier(); asm volatile("" ::: "memory");
#endif
    }
};

__device__ __forceinline__ unsigned cvt_pk_bf16(float lo, float hi) { unsigned r; asm volatile("v_cvt_pk_bf16_f32 %0, %1, %2" : "=v"(r) : "v"(lo), "v"(hi)); return r; }
typedef float f32x2 __attribute__((ext_vector_type(2)));
__device__ __forceinline__ f32x2 gelu_pk(f32x2 v) {
    const f32x2 av = __builtin_elementwise_abs(v), d = av * 0.2316418882f + 1.0f;
    f32x2 t; t.x = __builtin_amdgcn_rcpf(d.x); t.y = __builtin_amdgcn_rcpf(d.y);
    f32x2 q = t * 0.5307027145f + (-0.7265760135f); q = q * t + 0.7107068705f; q = q * t + (-0.142248368f); q = q * t + 0.127414796f; q = q * t;
    const f32x2 s = (v * v) * (-0.72134752044f);
    f32x2 e; e.x = __builtin_amdgcn_exp2f(s.x); e.y = __builtin_amdgcn_exp2f(s.y);
    const f32x2 m = v * (q * e), r = v - m;
    f32x2 o; o.x = v.x < 0.f ? m.x : r.x; o.y = v.y < 0.f ? m.y : r.y; return o;
}

struct EpiF32 {
    static constexpr bool PERM = false, AFTER_DRAIN = false;
    float* C; int ldc; const float* bias;
    __device__ __forceinline__ void operator()(const f32x4 (&acc)[2][2][4][2], const Unit& u, int wr, int wc, int fr, int fq) const {
        const int row0 = u.pm * BM + wr * 64 + fr, col0 = u.pn * BM + wc * 32 + 4 * fq;
        f32x4 bv[2][2];
#pragma unroll
        for (int bj = 0; bj < 2; ++bj)
#pragma unroll
            for (int n = 0; n < 2; ++n) bv[bj][n] = bias ? *(const f32x4*)(bias + col0 + bj * HALF + n * 16) : (f32x4){0.f, 0.f, 0.f, 0.f};
#pragma unroll
        for (int ai = 0; ai < 2; ++ai)
#pragma unroll
            for (int m = 0; m < 4; ++m) { float* rowp = C + (size_t)(row0 + ai * HALF + m * 16) * ldc + col0;
#pragma unroll
                for (int bj = 0; bj < 2; ++bj)
#pragma unroll
                    for (int n = 0; n < 2; ++n) *(f32x4*)(rowp + bj * HALF + n * 16) = acc[ai][bj][m][n] + bv[bj][n]; }
    }
};
template <int ACT  > struct EpiBf16 {
    static constexpr bool PERM = true, AFTER_DRAIN = false;
    bf16_t* O; int ldc; const float* bias; int split_cols; size_t split_stride;
    __device__ __forceinline__ void operator()(const f32x4 (&acc)[2][2][4][2], const Unit& u, int wr, int wc, int fr, int fq) const {
        const int row0 = u.pm * BM + wr * 64 + fr; int colt = u.pn * BM; bf16_t* base = O;
        if (split_cols) { const int t = colt / split_cols; base += (size_t)t * split_stride; colt -= t * split_cols; }
        const int col0 = colt + wc * 32 + 8 * fq, bcol0 = u.pn * BM + wc * 32 + 8 * fq;
        f32x4 bv[2][2];
#pragma unroll
        for (int bj = 0; bj < 2; ++bj)
#pragma unroll
            for (int n = 0; n < 2; ++n) bv[bj][n] = bias ? *(const f32x4*)(bias + bcol0 + bj * HALF + 4 * n) : (f32x4){0.f, 0.f, 0.f, 0.f};
#pragma unroll
        for (int ai = 0; ai < 2; ++ai)
#pragma unroll
            for (int m = 0; m < 4; ++m) { bf16_t* rowp = base + (size_t)(row0 + ai * HALF + m * 16) * ldc + col0;
#pragma unroll
                for (int bj = 0; bj < 2; ++bj) { f32x4 v0 = acc[ai][bj][m][0] + bv[bj][0], v1 = acc[ai][bj][m][1] + bv[bj][1];
                    if (ACT == 1) { f32x2 a = gelu_pk((f32x2){v0[0], v0[1]}), b = gelu_pk((f32x2){v0[2], v0[3]}), c = gelu_pk((f32x2){v1[0], v1[1]}), d = gelu_pk((f32x2){v1[2], v1[3]});
                        v0 = (f32x4){a.x, a.y, b.x, b.y}; v1 = (f32x4){c.x, c.y, d.x, d.y}; }
                    if (ACT == 2) {
#pragma unroll
                        for (int j = 0; j < 4; ++j) { v0[j] = 0.5f * v0[j] * (1.0f + erff(v0[j] * 0.70710678f)); v1[j] = 0.5f * v1[j] * (1.0f + erff(v1[j] * 0.70710678f)); } }
                    u32x4 w; w.x = cvt_pk_bf16(v0[0], v0[1]); w.y = cvt_pk_bf16(v0[2], v0[3]); w.z = cvt_pk_bf16(v1[0], v1[1]); w.w = cvt_pk_bf16(v1[2], v1[3]);
                    *(u32x4*)(rowp + bj * HALF) = w; } }
    }
};

struct PanelStats {
    unsigned* xbuf;
    unsigned* cnt;
    unsigned* tmo;
    int ntn; float eps;
    unsigned code;
    __device__ __forceinline__ bool run(const f32x4 (&v)[2][2][4][2], const Unit& u, int wr, int wc, int fr, int fq, PG8_LAS unsigned char* lds, int wid, int lane) const {
        typedef float f32x2v __attribute__((ext_vector_type(2)));
        PG8_LAS f32x2v* P = (PG8_LAS f32x2v*)lds;
        PG8_LAS f32x2v* S = (PG8_LAS f32x2v*)(lds + 8192);
        PG8_LAS unsigned* flag = (PG8_LAS unsigned*)(lds + 8192 + 2048);
#pragma unroll
        for (int ai = 0; ai < 2; ++ai)
#pragma unroll
            for (int m = 0; m < 4; ++m) {
                float s = 0.f;
#pragma unroll
                for (int bj = 0; bj < 2; ++bj)
#pragma unroll
                    for (int n = 0; n < 2; ++n) { const f32x4 x = v[ai][bj][m][n]; s += (x[0] + x[1]) + (x[2] + x[3]); }
                s += __shfl_xor(s, 16); s += __shfl_xor(s, 32);
                const float mw = s * (1.0f / 64.0f); float q = 0.f;
#pragma unroll
                for (int bj = 0; bj < 2; ++bj)
#pragma unroll
                    for (int n = 0; n < 2; ++n) { const f32x4 d = v[ai][bj][m][n] - mw; q += (d[0] * d[0] + d[1] * d[1]) + (d[2] * d[2] + d[3] * d[3]); }
                q += __shfl_xor(q, 16); q += __shfl_xor(q, 32);
                if (fq == 0) P[(ai * HALF + wr * 64 + m * 16 + fr) * 4 + wc] = (f32x2v){mw, q};
            }
        asm volatile("s_waitcnt lgkmcnt(0)" ::: "memory"); __builtin_amdgcn_s_barrier(); asm volatile("" ::: "memory");
#if defined(BROKEN_NO_WAIT)
        if (blockIdx.x >= 64) { const long long t0 = clock64(); while (clock64() - t0 < 60000) __builtin_amdgcn_s_sleep(8); }
#endif
        const int row = wid * 32 + (lane & 31);
        if (lane < 32) {
            const f32x2v a = P[row * 4 + 0], b = P[row * 4 + 1], c = P[row * 4 + 2], d = P[row * 4 + 3];
            const float mt = (a.x + b.x + c.x + d.x) * 0.25f;
            const float da = a.x - mt, db = b.x - mt, dc = c.x - mt, dd = d.x - mt;
            const float m2 = (a.y + b.y) + (c.y + d.y) + 64.0f * ((da * da + db * db) + (dc * dc + dd * dd));
            unsigned long long* slot = (unsigned long long*)xbuf + ((size_t)(u.pm * BM + row) * 4 + u.pn);
            __hip_atomic_store(slot, ((unsigned long long)__float_as_uint(m2) << 32) | __float_as_uint(mt), __ATOMIC_RELAXED, __HIP_MEMORY_SCOPE_AGENT);
        }
        asm volatile("s_waitcnt vmcnt(0)" ::: "memory");
        if (lane == 0) __hip_atomic_fetch_add(cnt + 64 * u.pm, 1u, __ATOMIC_RELAXED, __HIP_MEMORY_SCOPE_AGENT);
        if (wid == 0) {
            bool dead = false; const unsigned long long t0 = __builtin_amdgcn_s_memrealtime(); const unsigned want = 8u * (unsigned)ntn;
            for (;;) {
#if defined(BROKEN_NO_WAIT)
                break;
#endif
                if ((unsigned)__builtin_amdgcn_readfirstlane(__hip_atomic_load(cnt + 64 * u.pm, __ATOMIC_RELAXED, __HIP_MEMORY_SCOPE_AGENT)) >= want) break;
                if (__builtin_amdgcn_s_memrealtime() - t0 > 2000000ull) {
                    if (lane == 0) { unsigned expect = 0u; __hip_atomic_compare_exchange_strong(tmo + 1, &expect, code | (unsigned)(u.pm & 0xff), __ATOMIC_RELAXED, __ATOMIC_RELAXED, __HIP_MEMORY_SCOPE_AGENT);
                                     __hip_atomic_store(tmo, 1u, __ATOMIC_RELAXED, __HIP_MEMORY_SCOPE_AGENT); }
                    dead = true; break; }
                __builtin_amdgcn_s_sleep(2);
            }
            __builtin_amdgcn_fence(__ATOMIC_ACQUIRE, "agent");
            if (lane == 0) flag[0] = dead ? 1u : 0u;
        }
        asm volatile("s_waitcnt vmcnt(0) lgkmcnt(0)" ::: "memory"); __builtin_amdgcn_s_barrier(); asm volatile("" ::: "memory");
        const bool bad = flag[0] != 0u;
        if (lane < 32) {
            const unsigned long long* slot = (const unsigned long long*)xbuf + (size_t)(u.pm * BM + row) * 4; float mt[4], m2[4]; float ms = 0.f;
#pragma unroll
            for (int t = 0; t < 4; ++t) { if (t < ntn) { const unsigned long long w = __hip_atomic_load(slot + t, __ATOMIC_RELAXED, __HIP_MEMORY_SCOPE_AGENT); mt[t] = __uint_as_float((unsigned)w); m2[t] = __uint_as_float((unsigned)(w >> 32)); } else { mt[t] = 0.f; m2[t] = 0.f; } ms += mt[t]; }
            const float mean = ms / (float)ntn; float q = 0.f;
#pragma unroll
            for (int t = 0; t < 4; ++t) if (t < ntn) { const float dm = mt[t] - mean; q += m2[t] + 256.0f * dm * dm; }
            S[row] = (f32x2v){mean, 1.0f / sqrtf(q / (256.0f * (float)ntn) + eps)};
        }
        asm volatile("s_waitcnt lgkmcnt(0)" ::: "memory"); __builtin_amdgcn_s_barrier(); asm volatile("" ::: "memory");
        return bad;
    }
};
struct EpiLnRes {
    static constexpr bool PERM = false, AFTER_DRAIN = true;
    const float* base; float* out; int ldc; const float* bias; PanelStats st; unsigned poison;
    __device__ __forceinline__ void refuse(size_t i0, size_t stride, int M, int N) const { const float q = __builtin_nanf(""); for (size_t i = i0; i < (size_t)M * N; i += stride) out[(i / N) * ldc + i % N] = q;
        if (i0 == 0) { unsigned expect = 0u; __hip_atomic_compare_exchange_strong(st.tmo + 1, &expect, 0x7f0u, __ATOMIC_RELAXED, __ATOMIC_RELAXED, __HIP_MEMORY_SCOPE_AGENT); __hip_atomic_store(st.tmo, 1u, __ATOMIC_RELAXED, __HIP_MEMORY_SCOPE_AGENT); } }
    __device__ __forceinline__ void fused(f32x4 (&acc)[2][2][4][2], const Unit& u, int wr, int wc, int fr, int fq, PG8_LAS unsigned char* lds, int wid, int lane) const {
        typedef float f32x2v __attribute__((ext_vector_type(2)));
        const PG8_LAS f32x2v* S = (const PG8_LAS f32x2v*)(lds + 8192);
        const int col0 = u.pn * BM + wc * 32 + 4 * fq;
#pragma unroll
        for (int bj = 0; bj < 2; ++bj)
#pragma unroll
            for (int n = 0; n < 2; ++n) { const f32x4 bv = bias ? *(const f32x4*)(bias + col0 + bj * HALF + n * 16) : (f32x4){0.f, 0.f, 0.f, 0.f};
#pragma unroll
                for (int ai = 0; ai < 2; ++ai)
#pragma unroll
                    for (int m = 0; m < 4; ++m) acc[ai][bj][m][n] += bv; }
        const bool bad = st.run(acc, u, wr, wc, fr, fq, lds, wid, lane) || poison != 0u;
        const float qnan = __builtin_nanf("");
#pragma unroll
        for (int ai = 0; ai < 2; ++ai)
#pragma unroll
            for (int m = 0; m < 4; ++m) { const int r = ai * HALF + wr * 64 + m * 16 + fr; const f32x2v sr = S[r]; const size_t off = (size_t)(u.pm * BM + r) * ldc + col0;
#pragma unroll
                for (int bj = 0; bj < 2; ++bj)
#pragma unroll
                    for (int n = 0; n < 2; ++n) { const f32x4 bs = *(const f32x4*)(base + off + bj * HALF + n * 16); f32x4 o = bs + (acc[ai][bj][m][n] - sr.x) * sr.y;
                        if (bad) o = (f32x4){qnan, qnan, qnan, qnan}; *(f32x4*)(out + off + bj * HALF + n * 16) = o; }
                asm volatile("" ::: "memory"); }
    }
};
struct EpiLnResLn {
    static constexpr bool PERM = false, AFTER_DRAIN = true;
    const float* base; float* out; bf16_t* xn; int ldc; const float* bias; PanelStats st1, st2; unsigned poison;
    __device__ __forceinline__ void refuse(size_t i0, size_t stride, int M, int N) const { const float q = __builtin_nanf(""); for (size_t i = i0; i < (size_t)M * N; i += stride) { const size_t o = (i / N) * ldc + i % N; out[o] = q; xn[o] = (bf16_t)0x7fc0u; }
        if (i0 == 0) { unsigned expect = 0u; __hip_atomic_compare_exchange_strong(st1.tmo + 1, &expect, 0x7f0u, __ATOMIC_RELAXED, __ATOMIC_RELAXED, __HIP_MEMORY_SCOPE_AGENT); __hip_atomic_store(st1.tmo, 1u, __ATOMIC_RELAXED, __HIP_MEMORY_SCOPE_AGENT); } }
    __device__ __forceinline__ void fused(f32x4 (&acc)[2][2][4][2], const Unit& u, int wr, int wc, int fr, int fq, PG8_LAS unsigned char* lds, int wid, int lane) const {
        typedef float f32x2v __attribute__((ext_vector_type(2))); typedef unsigned u32x2v __attribute__((ext_vector_type(2)));
        const PG8_LAS f32x2v* S = (const PG8_LAS f32x2v*)(lds + 8192);
        const int col0 = u.pn * BM + wc * 32 + 4 * fq;
#pragma unroll
        for (int bj = 0; bj < 2; ++bj)
#pragma unroll
            for (int n = 0; n < 2; ++n) { const f32x4 bv = bias ? *(const f32x4*)(bias + col0 + bj * HALF + n * 16) : (f32x4){0.f, 0.f, 0.f, 0.f};
#pragma unroll
                for (int ai = 0; ai < 2; ++ai)
#pragma unroll
                    for (int m = 0; m < 4; ++m) acc[ai][bj][m][n] += bv; }
        bool bad = st1.run(acc, u, wr, wc, fr, fq, lds, wid, lane) || poison != 0u;
        const float qnan = __builtin_nanf("");
#pragma unroll
        for (int ai = 0; ai < 2; ++ai)
#pragma unroll
            for (int m = 0; m < 4; ++m) { const int r = ai * HALF + wr * 64 + m * 16 + fr; const f32x2v sr = S[r]; const size_t off = (size_t)(u.pm * BM + r) * ldc + col0;
#pragma unroll
                for (int bj = 0; bj < 2; ++bj)
#pragma unroll
                    for (int n = 0; n < 2; ++n) { const f32x4 bs = *(const f32x4*)(base + off + bj * HALF + n * 16); acc[ai][bj][m][n] = bs + (acc[ai][bj][m][n] - sr.x) * sr.y; }
                asm volatile("" : "+v"(acc[ai][0][m][0]), "+v"(acc[ai][0][m][1]), "+v"(acc[ai][1][m][0]), "+v"(acc[ai][1][m][1]));
                if (m & 1) asm volatile("" ::: "memory"); }
        const bool bad1 = bad;
        bad = st2.run(acc, u, wr, wc, fr, fq, lds, wid, lane) || bad;
#pragma unroll
        for (int ai = 0; ai < 2; ++ai)
#pragma unroll
            for (int m = 0; m < 4; ++m) { const int r = ai * HALF + wr * 64 + m * 16 + fr; const f32x2v sr = S[r]; const size_t off = (size_t)(u.pm * BM + r) * ldc + col0;
#pragma unroll
                for (int bj = 0; bj < 2; ++bj)
#pragma unroll
                    for (int n = 0; n < 2; ++n) { const f32x4 x1 = acc[ai][bj][m][n]; *(f32x4*)(out + off + bj * HALF + n * 16) = bad1 ? (f32x4){qnan, qnan, qnan, qnan} : x1;
                        const f32x4 o = (x1 - sr.x) * sr.y; u32x2v w; w.x = cvt_pk_bf16(o[0], o[1]); w.y = cvt_pk_bf16(o[2], o[3]);
                        if (bad) { w.x = 0x7fc07fc0u; w.y = 0x7fc07fc0u; } *(u32x2v*)(xn + off + bj * HALF + n * 16) = w; }
                asm volatile("" ::: "memory"); }
    }
};

template <class Epi, class Sched, bool STAMP = false>
__device__ __forceinline__ void gemm_phase(PG8_LAS unsigned char* lds, const Gemm g, const Sched& S, const Epi& E, unsigned long long* stamps) {
    const int tid = threadIdx.x, wid = __builtin_amdgcn_readfirstlane(tid >> 6), lane = tid & 63, wr = wid >> 2, wc = wid & 3, fr = lane & 15, fq = lane >> 4;
    const int K = g.K, nt = K / BK;
    int ts_lo = 0, ts_hi = 0, nts = 0; const unsigned long long rt_entry = STAMP ? (unsigned long long)wall_clock64() : 0ull;
#define PG8_STAMP() do { if (STAMP && wid == 0 && nts < 64) { const unsigned long long _c = (unsigned long long)clock64(); \
        ts_lo = (lane == nts) ? (int)(unsigned)_c : ts_lo; ts_hi = (lane == nts) ? (int)(unsigned)(_c >> 32) : ts_hi; ++nts; } } while (0)
    PG8_STAMP();
    unsigned voffA[2], voffB[2];
#pragma unroll
    for (int i = 0; i < 2; ++i) { int R, C; stage_rc(tid * 16 + i * 8192, R, C); const int Rb = Epi::PERM ? ((R & ~31) + perm32(R & 31)) : R;
        voffA[i] = (unsigned)(R * K + C) * 2u; voffB[i] = (unsigned)(Rb * K + C) * 2u; }
    const size_t kstep = (size_t)(BK * 2);
    const size_t hstep = (size_t)HALF * K * 2;
    const size_t tstep = 2 * hstep;
    const unsigned ldsw = (unsigned)wid * 1024u;
    const int aoff = lds_byte(wr * 64 + fr, fq * 8), boff = lds_byte(wc * 32 + fr, fq * 8);
#define PG8_SA(b, h) (((b) * 2 + (h)) * HTB)
#define PG8_SB(b, h) ((4 + (b) * 2 + (h)) * HTB)
#define PG8_STAGE(bufoff, gbase, voff) do { _Pragma("unroll") for (int _i = 0; _i < 2; ++_i) \
        __builtin_amdgcn_global_load_lds((const unsigned*)((const char*)(gbase) + (voff)[_i]), (PG8_LAS unsigned*)(lds + (bufoff) + ldsw + _i * 8192), 16, 0, 0); } while (0)
#define PG8_LDA(dst, b, h) do { _Pragma("unroll") for (int m = 0; m < 4; ++m) _Pragma("unroll") for (int k = 0; k < 2; ++k) dst[m][k] = *(const PG8_LAS bf16x8*)(lds + PG8_SA(b, h) + aoff + m * 2048 + k * 1024); } while (0)
#define PG8_LDB(dst, b, h) do { _Pragma("unroll") for (int n = 0; n < 2; ++n) _Pragma("unroll") for (int k = 0; k < 2; ++k) dst[n][k] = *(const PG8_LAS bf16x8*)(lds + PG8_SB(b, h) + boff + n * 2048 + k * 1024); } while (0)
#define PG8_MMA(ai, bj, At, Bt) do { __builtin_amdgcn_s_setprio(1); _Pragma("unroll") for (int m = 0; m < 4; ++m) _Pragma("unroll") for (int n = 0; n < 2; ++n) _Pragma("unroll") for (int k = 0; k < 2; ++k) \
        acc[ai][bj][m][n] = __builtin_amdgcn_mfma_f32_16x16x32_bf16(Bt[n][k], At[m][k], acc[ai][bj][m][n], 0, 0, 0); __builtin_amdgcn_s_setprio(0); } while (0)
#define PG8_WAIT_V(n) asm volatile("s_waitcnt vmcnt(" #n ")" ::: "memory")
#define PG8_WAIT_L(n) asm volatile("s_waitcnt lgkmcnt(" #n ")" ::: "memory")
#define PG8_BAR __builtin_amdgcn_s_barrier()
#define PG8_SCHED __builtin_amdgcn_sched_barrier(0)
    Unit cur, nxt; int ui = 0;
    if (!S.next(0, cur)) return;
    f32x4 acc[2][2][4][2];
#pragma unroll
    for (int a = 0; a < 2; ++a)
#pragma unroll
        for (int b = 0; b < 2; ++b)
#pragma unroll
            for (int m = 0; m < 4; ++m)
#pragma unroll
                for (int n = 0; n < 2; ++n) acc[a][b][m][n] = (f32x4){0.f, 0.f, 0.f, 0.f};
    bf16x8 At[4][2], B0[2][2], B1[2][2];
    const char* cA = (const char*)g.A + (size_t)cur.pm * tstep; const char* cB = (const char*)g.Bt + (size_t)cur.pn * tstep;
    S.a_ready(cur);
    PG8_STAGE(PG8_SB(0, 0), cB, voffB); PG8_STAGE(PG8_SA(0, 0), cA, voffA); PG8_STAGE(PG8_SB(0, 1), cB + hstep, voffB); PG8_STAGE(PG8_SA(0, 1), cA + hstep, voffA);
    if (wr == 1) PG8_BAR;
    PG8_WAIT_V(4); PG8_BAR;
    PG8_STAGE(PG8_SB(1, 0), cB + kstep, voffB); PG8_STAGE(PG8_SA(1, 0), cA + kstep, voffA); PG8_STAGE(PG8_SB(1, 1), cB + hstep + kstep, voffB);
    PG8_WAIT_V(6); PG8_BAR;
    PG8_STAMP();
    for (;;) {
        const bool has_next = S.next(ui + 1, nxt);
        const char* nA = has_next ? (const char*)g.A + (size_t)nxt.pm * tstep : cA; const char* nB = has_next ? (const char*)g.Bt + (size_t)nxt.pn * tstep : cB;
        for (int t = 0; t < nt; t += 2) {
            const bool last = (t == nt - 2);
            const char* a1 = cA + (size_t)(t + 1) * kstep;
            const char* a2 = last ? nA : cA + (size_t)(t + 2) * kstep; const char* b2 = last ? nB : cB + (size_t)(t + 2) * kstep;
            const char* a3 = a2 + kstep; const char* b3 = b2 + kstep;
            if (last && has_next) S.a_ready(nxt);
            PG8_LDB(B0, 0, 0); PG8_SCHED; PG8_LDA(At, 0, 0); PG8_STAGE(PG8_SA(1, 1), a1 + hstep, voffA);
            PG8_WAIT_L(8); PG8_BAR; PG8_WAIT_L(0); PG8_MMA(0, 0, At, B0); PG8_BAR; PG8_SCHED;
            PG8_LDB(B1, 0, 1); PG8_STAGE(PG8_SB(0, 0), b2, voffB);
            PG8_BAR; PG8_WAIT_L(0); PG8_MMA(0, 1, At, B1); PG8_BAR;
            PG8_LDA(At, 0, 1); PG8_STAGE(PG8_SA(0, 0), a2, voffA);
            PG8_BAR; PG8_WAIT_L(0); PG8_MMA(1, 0, At, B0); PG8_BAR; PG8_SCHED;
            PG8_STAGE(PG8_SB(0, 1), b2 + hstep, voffB);
            PG8_WAIT_V(6); PG8_BAR; PG8_MMA(1, 1, At, B1); PG8_BAR;
            PG8_LDB(B0, 1, 0); PG8_SCHED; PG8_LDA(At, 1, 0); PG8_STAGE(PG8_SA(0, 1), a2 + hstep, voffA);
            PG8_WAIT_L(8); PG8_BAR; PG8_WAIT_L(0); PG8_MMA(0, 0, At, B0); PG8_BAR; PG8_SCHED;
            PG8_LDB(B1, 1, 1); PG8_STAGE(PG8_SB(1, 0), b3, voffB);
            PG8_BAR; PG8_WAIT_L(0); PG8_MMA(0, 1, At, B1); PG8_BAR;
            PG8_LDA(At, 1, 1); PG8_STAGE(PG8_SA(1, 0), a3, voffA);
            PG8_BAR; PG8_WAIT_L(0); PG8_MMA(1, 0, At, B0); PG8_BAR; PG8_SCHED;
            PG8_STAGE(PG8_SB(1, 1), b3 + hstep, voffB);
            PG8_WAIT_V(6); PG8_BAR; PG8_MMA(1, 1, At, B1); PG8_BAR;
        }
        PG8_STAMP();
        if constexpr (!Epi::AFTER_DRAIN) { E(acc, cur, wr, wc, fr, fq); S.done(cur); }
        PG8_STAMP();
        if (!has_next) break;
#pragma unroll
        for (int a = 0; a < 2; ++a)
#pragma unroll
            for (int b = 0; b < 2; ++b)
#pragma unroll
                for (int m = 0; m < 4; ++m)
#pragma unroll
                    for (int n = 0; n < 2; ++n) acc[a][b][m][n] = (f32x4){0.f, 0.f, 0.f, 0.f};
        cur = nxt; cA = nA; cB = nB; ++ui;
    }
    PG8_WAIT_V(0);
    if (wr == 0) PG8_BAR;
    PG8_BAR;
    if constexpr (Epi::AFTER_DRAIN) { E.fused(acc, cur, wr, wc, fr, fq, lds, wid, lane); S.done(cur); }
    PG8_STAMP();
    if (STAMP && wid == 0) { stamps[lane] = lane < nts ? (((unsigned long long)(unsigned)ts_hi << 32) | (unsigned)ts_lo) : 0ull;
        if (lane == 62) stamps[62] = rt_entry; if (lane == 63) stamps[63] = (unsigned long long)wall_clock64(); }
#undef PG8_STAMP
#undef PG8_SA
#undef PG8_SB
#undef PG8_STAGE
#undef PG8_LDA
#undef PG8_LDB
#undef PG8_MMA
#undef PG8_WAIT_V
#undef PG8_WAIT_L
#undef PG8_BAR
#undef PG8_SCHED
}
}
#define XB_TMO      128
#define XB_XCNT(j)  (256  + 64 * (j))
#define XB_XSUB(j)  (1280 + 64 * (j))
#define XB_XGEN(j)  (2304 + 64 * (j))
#define XB_TOP      3328
#define XB_TOPGEN   3392
#define XCD_BAR_WORDS 3456
#define XB_SPIN_CAP (1u << 18)
#define LAS __attribute__((address_space(3)))

__device__ __forceinline__ unsigned xb_ld(unsigned* p)              { return __hip_atomic_load(p, __ATOMIC_RELAXED, __HIP_MEMORY_SCOPE_AGENT); }
__device__ __forceinline__ unsigned xb_add(unsigned* p, unsigned v) { return __hip_atomic_fetch_add(p, v, __ATOMIC_RELAXED, __HIP_MEMORY_SCOPE_AGENT); }
__device__ __forceinline__ unsigned xb_xcc_id() { return (unsigned)__builtin_amdgcn_s_getreg((3 << 11) | 20) & 0xFu; }
#define XB_SPIN(cond, bar) do { unsigned _sp = 0; while (cond) { __builtin_amdgcn_s_sleep(1); \
    if ((++_sp & 255u) == 0u) { if (xb_ld(&(bar)[XB_TMO])) break; if (_sp > XB_SPIN_CAP) { atomicAdd(&(bar)[XB_TMO], 1u); break; } } } } while (0)

struct XcdBarrier {
    unsigned* bar; unsigned x;
    volatile LAS unsigned* st;
};

__device__ __forceinline__ XcdBarrier xcd_barrier_post(unsigned* bar, volatile LAS unsigned* st) {
    XcdBarrier b; b.bar = bar; b.x = xb_xcc_id(); b.st = st;
    if (threadIdx.x == 0) (void)xb_add(&bar[XB_XCNT(b.x)], 1u);
    return b;
}
__device__ __forceinline__ void xcd_barrier_complete(unsigned* bar, unsigned x, unsigned& nloc, unsigned& nx) {
    const unsigned G = gridDim.x * gridDim.y * gridDim.z;
    unsigned sum, cnt, mine, sp = 0u;
    for (;;) {
        sum = 0u; cnt = 0u; mine = 0u;
#pragma unroll
        for (unsigned j = 0; j < 16; ++j) { const unsigned c = xb_ld(&bar[XB_XCNT(j)]); sum += c; cnt += (c > 0u) ? 1u : 0u; mine = (j == x) ? c : mine; }
        if (sum == G) break;
        __builtin_amdgcn_s_sleep(1);
        if ((++sp & 255u) == 0u) { if (xb_ld(&bar[XB_TMO])) break; if (sp > XB_SPIN_CAP) { atomicAdd(&bar[XB_TMO], 1u); break; } }
    }
    nloc = mine > 0u ? mine : 1u; nx = cnt > 0u ? cnt : 1u;
}

__device__ __forceinline__ void xcd_barrier(const XcdBarrier& b) {
    asm volatile("s_waitcnt vmcnt(0)" ::: "memory");
    __syncthreads();
    if (threadIdx.x == 0) {
        unsigned* bar = b.bar;
        __builtin_amdgcn_s_waitcnt(0);
        unsigned nloc = b.st[0], nx = b.st[1];
        if (nloc == 0u) { xcd_barrier_complete(bar, b.x, nloc, nx); b.st[0] = nloc; b.st[1] = nx; }
        const unsigned old = xb_add(&bar[XB_XSUB(b.x)], 1u);
        const unsigned gen = old / nloc;
        if (old + 1u == (gen + 1u) * nloc) {
            __builtin_amdgcn_fence(__ATOMIC_RELEASE, "agent");
            asm volatile("s_waitcnt vmcnt(0)" ::: "memory");
            const unsigned og = xb_add(&bar[XB_TOP], 1u);
            const unsigned tg = og / nx;
            if (og + 1u == (tg + 1u) * nx) xb_add(&bar[XB_TOPGEN], 1u);
            else XB_SPIN(xb_ld(&bar[XB_TOPGEN]) == tg, bar);
            __builtin_amdgcn_fence(__ATOMIC_ACQUIRE, "agent");
            xb_add(&bar[XB_XGEN(b.x)], 1u);
            asm volatile("s_waitcnt vmcnt(0)" ::: "memory");
        } else {
            XB_SPIN(xb_ld(&bar[XB_XGEN(b.x)]) == gen, bar);
            __builtin_amdgcn_fence(__ATOMIC_ACQUIRE, "agent");
            asm volatile("s_waitcnt vmcnt(0)" ::: "memory");
        }
    }
    __syncthreads();
}

namespace mk {
typedef unsigned short bf16;
typedef unsigned v4u __attribute__((ext_vector_type(4)));
typedef unsigned v2u __attribute__((ext_vector_type(2)));
typedef float f32x4 __attribute__((ext_vector_type(4)));
typedef short bf16x8 __attribute__((ext_vector_type(8)));
typedef __bf16 bf16x2 __attribute__((ext_vector_type(2)));

constexpr int NB = 8, SEQ = 2048, DM = 1024, T = NB * SEQ, NQKV = 3072;
constexpr float LN_EPS = 1e-5f;
constexpr float DN_ALPHA = 1.189207115002721f;
constexpr int NWAVES = 8, NTHR = 512;

constexpr size_t MiB = 1u << 20;
constexpr size_t WS_CTL = 0;
constexpr size_t CTL_ZERO_BYTES = 64 * 1024;
constexpr size_t WS_MODP = 1 * MiB;
constexpr size_t WS_MOD = 4 * MiB;
constexpr size_t WS_KMEAN = 4 * MiB + 256 * 1024;
constexpr size_t WS_WIN = 5 * MiB;
constexpr size_t WS_WOUT = 11 * MiB;
constexpr size_t WS_WQ = 13 * MiB;
constexpr size_t WS_U = 16 * MiB;
constexpr size_t WS_V = 48 * MiB;
constexpr size_t WS_H = 80 * MiB;
constexpr size_t WS_QKV = 112 * MiB;
constexpr size_t WS_ATT = 208 * MiB;
constexpr size_t WS_END = 256 * MiB;
constexpr int CW_BAR = 4096;

constexpr int RING_BYTES = 131072;
constexpr int MISC_OFF = RING_BYTES + 320;
constexpr int LDS_BYTES = 147456;

__device__ __forceinline__ unsigned f2bf(float f) { unsigned u = __float_as_uint(f); return (u + 0x7fffu + ((u >> 16) & 1u)) >> 16; }
__device__ __forceinline__ unsigned pk2(float lo, float hi) { return f2bf(lo) | (f2bf(hi) << 16); }
__device__ __forceinline__ float bflo(unsigned w) { return __uint_as_float(w << 16); }
__device__ __forceinline__ float bfhi(unsigned w) { return __uint_as_float(w & 0xffff0000u); }
__device__ __forceinline__ float dot2(unsigned a, unsigned b, float acc) { return __builtin_amdgcn_fdot2_f32_bf16(__builtin_bit_cast(bf16x2, a), __builtin_bit_cast(bf16x2, b), acc, false); }
__device__ __forceinline__ float wave_sum(float v) {
#pragma unroll
    for (int o = 1; o < 64; o <<= 1) v += __shfl_xor(v, o);
    return v;
}
__device__ __forceinline__ int t5_bucket(int d) {
    if (d < 16) return d;
    int b = 16;
    b += (d >= 22); b += (d >= 30); b += (d >= 40); b += (d >= 54); b += (d >= 73); b += (d >= 99); b += (d >= 134); b += (d >= 182);
    b += (d >= 246); b += (d >= 332); b += (d >= 450); b += (d >= 609); b += (d >= 825); b += (d >= 1117); b += (d >= 1513);
    return b;
}

struct Args {
    const float* in[17]; float* out; unsigned char* ws; int ph_lo, ph_hi, bar_idx, pad;
};

template <int MODE>
__device__ __forceinline__ void transpose_item(const float* W, int K, int N, bf16* WT, LAS float* scr, int item, int lane, const float* gna, const float* gnb) {
    const int nblk = N / 32, kb = item / nblk, nb = item % nblk, k0 = 64 * kb, n0 = 32 * nb;
    float cs = 1.f;
    if (MODE == 1) { if (n0 < 512 || (n0 >= 1536 && n0 < 2048)) cs = 0.125f; }
#pragma unroll 8
    for (int i = 0; i < 32; ++i) { const int kk = 2 * i + (lane >> 5); float v = W[(size_t)(k0 + kk) * N + n0 + (lane & 31)] * cs;
        if (MODE == 2) { const int k = k0 + kk; v *= (k < 512) ? gna[k] : gnb[k - 512]; }
        scr[kk * 33 + (lane & 31)] = v; }
    asm volatile("s_waitcnt lgkmcnt(0)" ::: "memory");
    const int c = lane & 7;
#pragma unroll
    for (int j = 0; j < 4; ++j) { const int n = (lane >> 3) + 8 * j; const LAS float* s = scr + (8 * c) * 33 + n;
        v4u o; o.x = pk2(s[0 * 33], s[1 * 33]); o.y = pk2(s[2 * 33], s[3 * 33]); o.z = pk2(s[4 * 33], s[5 * 33]); o.w = pk2(s[6 * 33], s[7 * 33]);
        *(v4u*)(WT + (size_t)(n0 + n) * K + k0 + 8 * c) = o; }
    asm volatile("s_waitcnt lgkmcnt(0)" ::: "memory");
}

__device__ __forceinline__ void p0_prologue(const Args& a, LAS unsigned char* lds, int G, int tid, int lane, int wave) {
    unsigned char* ws = a.ws;
    {
        const float* c = a.in[1]; const float* w_ada = a.in[2]; float* modp = (float*)(ws + WS_MODP);
        LAS float* sc = (LAS float*)lds;
        for (int item = blockIdx.x; item < 192; item += G) {
            const int ks = item / 12, cb = item % 12;
            { const int b = tid >> 6, i = tid & 63; const float v = c[b * DM + ks * 64 + i]; sc[b * 64 + i] = v / (1.f + __expf(-v)); }
            __syncthreads();
            const int col = cb * 512 + tid;
            float acc[8];
#pragma unroll
            for (int b = 0; b < 8; ++b) acc[b] = 0.f;
#pragma unroll 8
            for (int i = 0; i < 64; ++i) { const float w = w_ada[(size_t)(ks * 64 + i) * 6144 + col];
#pragma unroll
                for (int b = 0; b < 8; ++b) acc[b] += sc[b * 64 + i] * w; }
#pragma unroll
            for (int b = 0; b < 8; ++b) modp[(size_t)(ks * 8 + b) * 6144 + col] = acc[b];
            __syncthreads();
        }
    }
    {
        LAS float* scr = (LAS float*)(lds + wave * 16384);
        const int gw = blockIdx.x * NWAVES + wave, NGW = G * NWAVES;
        constexpr int I_IN = 16 * 96, I_O = 16 * 32, I_Q = 16 * 32;
        for (int it = gw; it < I_IN + I_O + I_Q; it += NGW) {
            int r = it;
            if (r < I_IN) { transpose_item<1>(a.in[4], DM, NQKV, (bf16*)(ws + WS_WIN), scr, r, lane, nullptr, nullptr); continue; } r -= I_IN;
            if (r < I_O) { transpose_item<2>(a.in[8], DM, DM, (bf16*)(ws + WS_WOUT), scr, r, lane, a.in[6], a.in[7]); continue; } r -= I_O;
            transpose_item<0>(a.in[11], DM, DM, (bf16*)(ws + WS_WQ), scr, r, lane, nullptr, nullptr);
        }
    }
    {
        const size_t nthr = (size_t)G * NTHR, gt = (size_t)blockIdx.x * NTHR + tid;
        const size_t per = (size_t)16384 * 1024 / 8;
        for (size_t i = gt; i < 2 * per; i += nthr) {
            const bool second = i >= per; const size_t j = second ? i - per : i;
            const f32x4* src = (const f32x4*)(second ? a.in[14] : a.in[13]) + 2 * j;
            const f32x4 p = src[0], q = src[1];
            v4u o; o.x = pk2(p.x, p.y); o.y = pk2(p.z, p.w); o.z = pk2(q.x, q.y); o.w = pk2(q.z, q.w);
            ((v4u*)(ws + (second ? WS_V : WS_U)))[j] = o;
        }
        float* km = (float*)(ws + WS_KMEAN);
        for (size_t i = gt; i < 32768; i += nthr) km[i] = 0.f;
    }
}

__device__ __forceinline__ void p1_mod_h(const Args& a, LAS unsigned char* lds, int G, int tid, int lane, int wave) {
    unsigned char* ws = a.ws;
    const float* modp = (const float*)(ws + WS_MODP); const float* b_ada = a.in[3];
    float* mod = (float*)(ws + WS_MOD);
    for (int i = blockIdx.x * NTHR + tid; i < 8 * 6144; i += G * NTHR) {
        const int b = i / 6144, j = i % 6144; float s = b_ada[j];
#pragma unroll
        for (int ks = 0; ks < 16; ++ks) s += modp[(size_t)(ks * 8 + b) * 6144 + j];
        mod[i] = s;
    }
    LAS float* sm = (LAS float*)lds;
    const float* x = a.in[0]; bf16* H = (bf16*)(ws + WS_H);
    int curb = -1;
    for (int rb = blockIdx.x; rb < T / 64; rb += G) {
        const int b = rb >> 5;
        if (b != curb) {
            __syncthreads();
            for (int j = tid; j < 2048; j += NTHR) { float s = b_ada[j];
#pragma unroll
                for (int ks = 0; ks < 16; ++ks) s += modp[(size_t)(ks * 8 + b) * 6144 + j];
                sm[j] = s; }
            __syncthreads();
            curb = b;
        }
#pragma unroll 2
        for (int r = 0; r < 8; ++r) {
            const int row = rb * 64 + wave * 8 + r;
#pragma unroll
            for (int hf = 0; hf < 2; ++hf) {
                const int c0 = hf * 512 + 8 * lane;
                const f32x4 p = *(const f32x4*)(x + (size_t)row * DM + c0), q = *(const f32x4*)(x + (size_t)row * DM + c0 + 4);
                const f32x4 s0 = *(const LAS f32x4*)(sm + 1024 + c0), s1 = *(const LAS f32x4*)(sm + 1024 + c0 + 4);
                const f32x4 h0 = *(const LAS f32x4*)(sm + c0), h1 = *(const LAS f32x4*)(sm + c0 + 4);
                v4u o; o.x = pk2(p.x * (1.f + s0.x) + h0.x, p.y * (1.f + s0.y) + h0.y); o.y = pk2(p.z * (1.f + s0.z) + h0.z, p.w * (1.f + s0.w) + h0.w);
                o.z = pk2(q.x * (1.f + s1.x) + h1.x, q.y * (1.f + s1.y) + h1.y); o.w = pk2(q.z * (1.f + s1.z) + h1.z, q.w * (1.f + s1.w) + h1.w);
                *(v4u*)(H + (size_t)row * DM + c0) = o;
            }
        }
    }
}

__device__ __forceinline__ void p3_kmean(const Args& a, LAS unsigned char* lds, int G, int tid) {
    unsigned char* ws = a.ws; const bf16* QKV = (const bf16*)(ws + WS_QKV); float* km = (float*)(ws + WS_KMEAN);
    LAS float* red = (LAS float*)lds;
    for (int item = blockIdx.x; item < 256; item += G) {
        const int b = item >> 5, n = (item >> 2) & 7, rq = item & 3;
        const int cp = tid & 255, rg = tid >> 8;
        const size_t row0 = (size_t)b * SEQ + n * 256 + rq * 64 + rg * 32;
        float s0 = 0.f, s1 = 0.f;
#pragma unroll 8
        for (int r = 0; r < 32; ++r) { const unsigned w = *(const unsigned*)(QKV + (row0 + r) * NQKV + 512 + 2 * cp); s0 += bflo(w); s1 += bfhi(w); }
        if (rg == 1) { red[2 * cp] = s0; red[2 * cp + 1] = s1; }
        __syncthreads();
        if (rg == 0) { s0 += red[2 * cp]; s1 += red[2 * cp + 1]; const int c = 2 * cp, h = c >> 6, d = c & 63;
            float* dst = km + ((b * 8 + h) * 8 + n) * 64 + d;
            atomicAdd(dst, s0 * (1.f / 256.f)); atomicAdd(dst + 1, s1 * (1.f / 256.f)); }
        __syncthreads();
    }
}

__device__ __forceinline__ void unpack8(const v4u w, float (&v)[8]) { v[0] = bflo(w.x); v[1] = bfhi(w.x); v[2] = bflo(w.y); v[3] = bfhi(w.y); v[4] = bflo(w.z); v[5] = bfhi(w.z); v[6] = bflo(w.w); v[7] = bfhi(w.w); }
typedef short v4i16 __attribute__((ext_vector_type(4)));
constexpr float LOG2E = 1.4426950408889634f;
constexpr int AT_K = 0, AT_V = 18432, AT_LUT = 36864, AT_GATE = 45056, AT_SEL = 49152, AT_ANY = 49664, AT_ROW = 144;
constexpr size_t WS_YA = WS_ATT, WS_OB0 = WS_ATT + 16 * MiB, WS_OB1 = WS_ATT + 32 * MiB, WS_OB2 = WS_H, WS_LSE = WS_H + 16 * MiB;

__device__ __forceinline__ unsigned pkbf(float lo, float hi) { bf16x2 t; t.x = (__bf16)lo; t.y = (__bf16)hi; return __builtin_bit_cast(unsigned, t); }
__device__ __forceinline__ bf16x8 mk8(v4i16 a, v4i16 b) { return __builtin_shufflevector(a, b, 0, 1, 2, 3, 4, 5, 6, 7); }
__device__ __forceinline__ v4i16 tr16(const LAS unsigned char* p) { return __builtin_amdgcn_ds_read_tr16_b64_v4i16((LAS v4i16*)p); }

struct AttnState { bf16x8 qf[2]; f32x4 ot[4]; float m, l; };

__device__ __forceinline__ void attn_sub(AttnState& st, const LAS unsigned char* lds, int sub, int lane, int qidx, int k0, int dmax, bool lanesel) {
    const int q15 = lane & 15, g = lane >> 4;
    const LAS unsigned char* kb = lds + AT_K + (sub * 32 + q15) * AT_ROW + g * 16;
    f32x4 s0 = {0.f, 0.f, 0.f, 0.f}, s1 = {0.f, 0.f, 0.f, 0.f};
#pragma unroll
    for (int ks = 0; ks < 2; ++ks) {
        const bf16x8 a0 = *(const LAS bf16x8*)(kb + ks * 64), a1 = *(const LAS bf16x8*)(kb + 16 * AT_ROW + ks * 64);
        s0 = __builtin_amdgcn_mfma_f32_16x16x32_bf16(a0, st.qf[ks], s0, 0, 0, 0);
        s1 = __builtin_amdgcn_mfma_f32_16x16x32_bf16(a1, st.qf[ks], s1, 0, 0, 0);
    }
    const LAS float* lut = (const LAS float*)(lds + AT_LUT);
    float sc[8]; const int dbase = qidx - (k0 + sub * 32 + 4 * g);
#pragma unroll
    for (int r = 0; r < 8; ++r) {
        const int d = dbase - (r & 3) - (r >> 2) * 16;
        const bool ok = lanesel && d >= 0 && d <= dmax;
        const int dc = d < 0 ? 0 : (d > dmax ? dmax : d);
        const float v = ((r < 4) ? s0[r & 3] : s1[r & 3]) * LOG2E + lut[dc];
        sc[r] = ok ? v : -INFINITY;
    }
    float mx = fmaxf(fmaxf(fmaxf(sc[0], sc[1]), fmaxf(sc[2], sc[3])), fmaxf(fmaxf(sc[4], sc[5]), fmaxf(sc[6], sc[7])));
    mx = fmaxf(mx, __shfl_xor(mx, 16)); mx = fmaxf(mx, __shfl_xor(mx, 32));
    const float mn = fmaxf(st.m, mx), mu = (mn == -INFINITY) ? 0.f : mn;
    const float alpha = __builtin_amdgcn_exp2f(st.m - mu);
    float p[8], ps = 0.f;
#pragma unroll
    for (int r = 0; r < 8; ++r) { p[r] = __builtin_amdgcn_exp2f(sc[r] - mu); ps += p[r]; }
    st.l = st.l * alpha + ps; st.m = mn;
    if (!__all(alpha == 1.f)) {
#pragma unroll
        for (int n = 0; n < 4; ++n) st.ot[n] *= alpha;
    }
    v4u pw; pw.x = pkbf(p[0], p[1]); pw.y = pkbf(p[2], p[3]); pw.z = pkbf(p[4], p[5]); pw.w = pkbf(p[6], p[7]);
    const bf16x8 pb = __builtin_bit_cast(bf16x8, pw);
    const LAS unsigned char* vb = lds + AT_V + (sub * 32 + 4 * g + (q15 >> 2)) * AT_ROW + (q15 & 3) * 8;
#pragma unroll
    for (int n = 0; n < 4; ++n) {
        const v4i16 r1 = tr16(vb + n * 32), r2 = tr16(vb + 16 * AT_ROW + n * 32);
        st.ot[n] = __builtin_amdgcn_mfma_f32_16x16x32_bf16(mk8(r1, r2), pb, st.ot[n], 0, 0, 0);
    }
}

struct ChunkRegs { v4u k0, k1, v0, v1; };
__device__ __forceinline__ void chunk_fetch(ChunkRegs& c, const bf16* kbase  , int kstride_tok, int tid) {
    const int r0 = tid >> 3, cc = tid & 7;
    const bf16* p0 = kbase + (size_t)(r0 * kstride_tok) * NQKV + cc * 8; const bf16* p1 = kbase + (size_t)((r0 + 64) * kstride_tok) * NQKV + cc * 8;
    c.k0 = *(const v4u*)p0; c.k1 = *(const v4u*)p1; c.v0 = *(const v4u*)(p0 + 512); c.v1 = *(const v4u*)(p1 + 512);
}
__device__ __forceinline__ void chunk_store(const ChunkRegs& c, LAS unsigned char* lds, int tid) {
    const int r0 = tid >> 3, cc = tid & 7;
    *(LAS v4u*)(lds + AT_K + r0 * AT_ROW + cc * 16) = c.k0; *(LAS v4u*)(lds + AT_K + (r0 + 64) * AT_ROW + cc * 16) = c.k1;
    *(LAS v4u*)(lds + AT_V + r0 * AT_ROW + cc * 16) = c.v0; *(LAS v4u*)(lds + AT_V + (r0 + 64) * AT_ROW + cc * 16) = c.v1;
}
__device__ __forceinline__ void attn_init(AttnState& st, const bf16* qrow  , int lane) {
    const int g = lane >> 4;
    st.qf[0] = *(const bf16x8*)(qrow + 8 * g); st.qf[1] = *(const bf16x8*)(qrow + 32 + 8 * g);
#pragma unroll
    for (int n = 0; n < 4; ++n) st.ot[n] = (f32x4){0.f, 0.f, 0.f, 0.f};
    st.m = -INFINITY; st.l = 0.f;
}
__device__ __forceinline__ float attn_finish(AttnState& st, bf16* orow  , int lane) {
    float l = st.l; l += __shfl_xor(l, 16); l += __shfl_xor(l, 32);
    const float inv = 1.f / l; const int g = lane >> 4;
#pragma unroll
    for (int n = 0; n < 4; ++n) { v2u w; w.x = pkbf(st.ot[n][0] * inv, st.ot[n][1] * inv); w.y = pkbf(st.ot[n][2] * inv, st.ot[n][3] * inv);
        *(v2u*)(orow + 16 * n + 4 * g) = w; }
    return l;
}

__device__ __forceinline__ void moba_item(const Args& a, LAS unsigned char* lds, int item, int tid, int lane, int wave) {
    unsigned char* ws = a.ws; const bf16* QKV = (const bf16*)(ws + WS_QKV);
    const int qblk = 7 - (item >> 7), idx = item & 127, bh = idx >> 1, b = bh >> 3, h = bh & 7, qt = 2 * qblk + (idx & 1);
    const size_t tokb = (size_t)b * SEQ;
    LAS float* lut = (LAS float*)(lds + AT_LUT); LAS float* gates = (LAS float*)(lds + AT_GATE); LAS unsigned* selm = (LAS unsigned*)(lds + AT_SEL); LAS unsigned* anyw = (LAS unsigned*)(lds + AT_ANY);
    __syncthreads();
    for (int d = tid; d < 2048; d += NTHR) lut[d] = a.in[5][h * 32 + t5_bucket(d)] * LOG2E;
    if (tid == 0) *anyw = 0u;
    unsigned anysel;
    if (qblk > 3) {
        {
            const int qi = tid & 127, gi = tid >> 7;
            const bf16* qp = QKV + (tokb + qt * 128 + qi) * NQKV + h * 64;
            float ga = 0.f, gb = 0.f; const float* kma = (const float*)(ws + WS_KMEAN) + ((b * 8 + h) * 8 + gi) * 64; const float* kmb = kma + 4 * 64;
#pragma unroll
            for (int i = 0; i < 8; ++i) { const v4u w = *(const v4u*)(qp + 8 * i); float qv[8]; unpack8(w, qv);
#pragma unroll
                for (int j = 0; j < 8; ++j) { ga += qv[j] * kma[8 * i + j]; gb += qv[j] * kmb[8 * i + j]; } }
            gates[qi * 8 + gi] = ga; gates[qi * 8 + gi + 4] = gb;
        }
        __syncthreads();
        if (tid < 128) {
            float gv[8];
#pragma unroll
            for (int n = 0; n < 8; ++n) gv[n] = (n < qblk) ? gates[tid * 8 + n] : -INFINITY;
            unsigned sel = 0;
#pragma unroll
            for (int r = 0; r < 3; ++r) { float best = -INFINITY; int bi = 0;
#pragma unroll
                for (int n = 0; n < 8; ++n) { const bool take = !((sel >> n) & 1u) && (gv[n] > best); best = take ? gv[n] : best; bi = take ? n : bi; }
                sel |= 1u << bi; }
            selm[tid] = sel; atomicOr((unsigned*)anyw, sel);
        }
        __syncthreads();
        anysel = *anyw;
    } else { anysel = (1u << qblk) - 1u; __syncthreads(); }
    const unsigned mysel = (qblk > 3) ? selm[wave * 16 + (lane & 15)] : anysel;
    unsigned cm = 0;
    for (int n = 0; n < qblk; ++n) if ((anysel >> n) & 1u) cm |= 3u << (2 * n);
    cm |= 1u << (2 * qblk); if (qt & 1) cm |= 2u << (2 * qblk);
    const int qpos = qt * 128 + wave * 16 + (lane & 15), wq_hi = qt * 128 + wave * 16 + 15;
    AttnState st; attn_init(st, QKV + (tokb + qpos) * NQKV + h * 64, lane);
    ChunkRegs cr; const bf16* kcol = QKV + tokb * NQKV + 512 + h * 64;
    { const int c0 = __builtin_ctz(cm); chunk_fetch(cr, kcol + (size_t)(c0 * 128) * NQKV, 1, tid); }
    while (cm) {
        const int cur = __builtin_ctz(cm); cm &= cm - 1u;
        __syncthreads();
        chunk_store(cr, lds, tid);
        __syncthreads();
        if (cm) { const int nx = __builtin_ctz(cm); chunk_fetch(cr, kcol + (size_t)(nx * 128) * NQKV, 1, tid); }
        const int n = cur >> 1, k0 = cur * 128; const bool own = (n == qblk);
        const bool lsel = own || ((mysel >> n) & 1u);
        if (own || __any(lsel)) {
#pragma unroll 1
            for (int sub = 0; sub < 4; ++sub) {
                if (k0 + sub * 32 > wq_hi) break;
                attn_sub(st, lds, sub, lane, qpos, k0, 2047, lsel);
            }
        }
    }
    attn_finish(st, (bf16*)(ws + WS_YA) + (tokb + qpos) * 512 + h * 64, lane);
}

__device__ __forceinline__ void dil_item(const Args& a, LAS unsigned char* lds, int item, int tid, int lane, int wave) {
    unsigned char* ws = a.ws; const bf16* QKV = (const bf16*)(ws + WS_QKV);
    const int grp = item >> 4, sub16 = item & 15, br = grp % 3, bh = grp / 3, b = bh >> 3, h = bh & 7;
    const int dil = (br == 0) ? 1 : (br == 1 ? 4 : 16);
    const int r = (br == 0) ? 0 : (br == 1 ? (sub16 >> 2) : sub16), j = (br == 0) ? sub16 : (br == 1 ? (sub16 & 3) : 0);
    const size_t tokb = (size_t)b * SEQ;
    LAS float* lut = (LAS float*)(lds + AT_LUT);
    __syncthreads();
    for (int d = tid; d <= 128; d += NTHR) lut[d] = a.in[5][(8 + h) * 32 + t5_bucket(d * dil)] * LOG2E;
    const int lq = 128 * j + wave * 16 + (lane & 15);
    const size_t qtok = tokb + (size_t)lq * dil + r;
    AttnState st; attn_init(st, QKV + qtok * NQKV + 1536 + h * 64, lane);
    ChunkRegs cr; const bf16* kcol = QKV + (tokb + r) * NQKV + 2048 + h * 64;
    const int c_first = (j > 0) ? 0 : 1;
    chunk_fetch(cr, kcol + (size_t)((128 * (j - 1 + c_first)) * dil) * NQKV, dil, tid);
#pragma unroll 1
    for (int c = c_first; c < 2; ++c) {
        __syncthreads();
        chunk_store(cr, lds, tid);
        __syncthreads();
        if (c == 0) chunk_fetch(cr, kcol + (size_t)((128 * j) * dil) * NQKV, dil, tid);
        const int k0 = 128 * (j - 1 + c), wh = wave >> 1;
        const int s_lo = (c == 0) ? wh : 0, s_hi = (c == 0) ? 3 : wh;
#pragma unroll 1
        for (int sub = s_lo; sub <= s_hi; ++sub) attn_sub(st, lds, sub, lane, lq, k0, 128, true);
    }
    bf16* ob = (bf16*)(ws + (br == 0 ? WS_OB0 : (br == 1 ? WS_OB1 : WS_OB2)));
    const float l = attn_finish(st, ob + qtok * 512 + h * 64, lane);
    if ((lane >> 4) == 0) ((float*)(ws + WS_LSE))[((size_t)br * T + qtok) * 8 + h] = st.m + __builtin_amdgcn_logf(l);
}

__device__ __forceinline__ void p4_attn(const Args& a, LAS unsigned char* lds, int G, int tid, int lane, int wave) {
    for (int v = blockIdx.x; v < 256; v += G) {
        moba_item(a, lds, v, tid, lane, wave);
        moba_item(a, lds, 256 + v, tid, lane, wave);
        moba_item(a, lds, 767 - v, tid, lane, wave);
        moba_item(a, lds, 1023 - v, tid, lane, wave);
#pragma unroll 1
        for (int i = 0; i < 12; ++i) dil_item(a, lds, v * 12 + i, tid, lane, wave);
    }
}

__device__ __forceinline__ void p5_combine_rms(const Args& a, int G, int lane, int wave) {
    unsigned char* ws = a.ws; const bf16* YA = (const bf16*)(ws + WS_YA);
    const bf16* OB0 = (const bf16*)(ws + WS_OB0); const bf16* OB1 = (const bf16*)(ws + WS_OB1); const bf16* OB2 = (const bf16*)(ws + WS_OB2);
    const float* LSE = (const float*)(ws + WS_LSE); bf16* A2 = (bf16*)a.out;
    for (int row = blockIdx.x * NWAVES + wave; row < T; row += G * NWAVES) {
        float v[8], o0[8], o1[8], o2[8];
        unpack8(*(const v4u*)(YA + (size_t)row * 512 + 8 * lane), v);
        unpack8(*(const v4u*)(OB0 + (size_t)row * 512 + 8 * lane), o0); unpack8(*(const v4u*)(OB1 + (size_t)row * 512 + 8 * lane), o1); unpack8(*(const v4u*)(OB2 + (size_t)row * 512 + 8 * lane), o2);
        const int h = lane >> 3;
        const float l0 = LSE[((size_t)0 * T + row) * 8 + h], l1 = LSE[((size_t)1 * T + row) * 8 + h], l2 = LSE[((size_t)2 * T + row) * 8 + h];
        const float mx = fmaxf(l0, fmaxf(l1, l2));
        float w0 = __builtin_amdgcn_exp2f(l0 - mx), w1 = __builtin_amdgcn_exp2f(l1 - mx), w2 = __builtin_amdgcn_exp2f(l2 - mx);
        const float inv = 1.f / (w0 + w1 + w2); w0 *= inv; w1 *= inv; w2 *= inv;
        float ssa = 0.f, ssb = 0.f;
#pragma unroll
        for (int j = 0; j < 8; ++j) { o0[j] = w0 * o0[j] + w1 * o1[j] + w2 * o2[j]; ssa += v[j] * v[j]; ssb += o0[j] * o0[j]; }
        ssa = wave_sum(ssa); ssb = wave_sum(ssb);
        const float ra = rsqrtf(ssa * (1.f / 512.f) + LN_EPS), rb = rsqrtf(ssb * (1.f / 512.f) + LN_EPS);
        v4u o; o.x = pkbf(v[0] * ra, v[1] * ra); o.y = pkbf(v[2] * ra, v[3] * ra); o.z = pkbf(v[4] * ra, v[5] * ra); o.w = pkbf(v[6] * ra, v[7] * ra);
        *(v4u*)(A2 + (size_t)row * DM + 8 * lane) = o;
        o.x = pkbf(o0[0] * rb, o0[1] * rb); o.y = pkbf(o0[2] * rb, o0[3] * rb); o.z = pkbf(o0[4] * rb, o0[5] * rb); o.w = pkbf(o0[6] * rb, o0[7] * rb);
        *(v4u*)(A2 + (size_t)row * DM + 512 + 8 * lane) = o;
    }
}
__device__ __forceinline__ void load16(const float* p, int lane, float (&v)[16]) {
#pragma unroll
    for (int q = 0; q < 4; ++q) { const f32x4 t = *(const f32x4*)(p + (q >> 1) * 512 + 8 * lane + (q & 1) * 4); v[4 * q] = t.x; v[4 * q + 1] = t.y; v[4 * q + 2] = t.z; v[4 * q + 3] = t.w; }
}
__device__ __forceinline__ void store16(float* p, int lane, const float (&v)[16]) {
#pragma unroll
    for (int q = 0; q < 4; ++q) { f32x4 t; t.x = v[4 * q]; t.y = v[4 * q + 1]; t.z = v[4 * q + 2]; t.w = v[4 * q + 3]; *(f32x4*)(p + (q >> 1) * 512 + 8 * lane + (q & 1) * 4) = t; }
}
__device__ __forceinline__ void layer_norm16(float (&z)[16], const float* g, const float* bta, int lane) {
    float s = 0.f;
#pragma unroll
    for (int j = 0; j < 16; ++j) s += z[j];
    const float mu = wave_sum(s) * (1.f / DM); float q = 0.f;
#pragma unroll
    for (int j = 0; j < 16; ++j) { z[j] -= mu; q += z[j] * z[j]; }
    const float rs = rsqrtf(wave_sum(q) * (1.f / DM) + LN_EPS);
    float gg[16], bb[16]; load16(g, lane, gg); load16(bta, lane, bb);
#pragma unroll
    for (int j = 0; j < 16; ++j) z[j] = z[j] * rs * gg[j] + bb[j];
}

__device__ __forceinline__ void p7_ln1(const Args& a, int G, int lane, int wave) {
    unsigned char* ws = a.ws; const float* x = a.in[0]; const float* Y = (const float*)(ws + WS_QKV); const float* mod = (const float*)(ws + WS_MOD);
    float* x1 = a.out; bf16* H2 = (bf16*)(ws + WS_H);
    for (int row = blockIdx.x * NWAVES + wave; row < T; row += G * NWAVES) {
        const int b = row >> 11; float z[16], y[16], t[16];
        load16(x + (size_t)row * DM, lane, z); load16(Y + (size_t)row * DM, lane, y); load16(mod + b * 6144 + 2048, lane, t);
#pragma unroll
        for (int j = 0; j < 16; ++j) z[j] = DN_ALPHA * z[j] + (1.f + t[j]) * y[j];
        layer_norm16(z, a.in[9], a.in[10], lane);
        store16(x1 + (size_t)row * DM, lane, z);
        load16(mod + b * 6144 + 4096, lane, y); load16(mod + b * 6144 + 3072, lane, t);
#pragma unroll
        for (int j = 0; j < 16; ++j) z[j] = z[j] * (1.f + y[j]) + t[j];
        v4u o0, o1; o0.x = pk2(z[0], z[1]); o0.y = pk2(z[2], z[3]); o0.z = pk2(z[4], z[5]); o0.w = pk2(z[6], z[7]);
        o1.x = pk2(z[8], z[9]); o1.y = pk2(z[10], z[11]); o1.z = pk2(z[12], z[13]); o1.w = pk2(z[14], z[15]);
        *(v4u*)(H2 + (size_t)row * DM + 8 * lane) = o0; *(v4u*)(H2 + (size_t)row * DM + 512 + 8 * lane) = o1;
    }
}

__device__ __forceinline__ unsigned mono(float s) { const unsigned u = __float_as_uint(s); return u ^ ((unsigned)((int)u >> 31) | 0x80000000u); }
__device__ __forceinline__ float unmono(unsigned k) { return __uint_as_float((k & 0x80000000u) ? (k ^ 0x80000000u) : ~k); }
__device__ __forceinline__ void ins16(unsigned (&t)[16], unsigned x) {
#pragma unroll
    for (int j = 0; j < 16; ++j) { const unsigned hi = t[j] > x ? t[j] : x; x = t[j] > x ? x : t[j]; t[j] = hi; }
}
__device__ __forceinline__ unsigned lookup8(unsigned long long lo, unsigned long long hi, int idx) {
    const unsigned long long w = (idx & 8) ? hi : lo;
    return (unsigned)(w >> ((idx & 7) * 8)) & 0xffu;
}
__device__ __forceinline__ void p9_topk(const Args& a, LAS unsigned char* lds, int G, int tid) {
    unsigned char* ws = a.ws; const float* QP = (const float*)(ws + WS_QKV); const float* sub_keys = a.in[12];
    int* elist = (int*)(ws + WS_ATT); float* glist = (float*)(ws + WS_ATT + 8 * MiB);
    LAS f32x4* K4 = (LAS f32x4*)lds;
    for (int i = tid; i < 2 * 128 * 16; i += NTHR) K4[i] = ((const f32x4*)sub_keys)[i];
    __syncthreads();
    for (int p = blockIdx.x * NTHR + tid; p < T * 8; p += G * NTHR) {
        const int tok = p >> 3, head = p & 7;
        float v1[16], v2[16]; unsigned long long i1lo = 0, i1hi = 0, i2lo = 0, i2hi = 0;
#pragma unroll
        for (int hf = 0; hf < 2; ++hf) {
            f32x4 q[16];
#pragma unroll
            for (int d = 0; d < 16; ++d) q[d] = *(const f32x4*)(QP + (size_t)tok * DM + head * 128 + hf * 64 + 4 * d);
            unsigned top[16];
#pragma unroll
            for (int j = 0; j < 16; ++j) top[j] = 0u;
#pragma unroll 1
            for (int n = 0; n < 128; ++n) {
                const LAS f32x4* kr = K4 + (hf * 128 + n) * 16;
                float s0 = 0.f, s1 = 0.f, s2 = 0.f, s3 = 0.f;
#pragma unroll
                for (int d = 0; d < 16; ++d) { const f32x4 k = kr[d]; s0 += q[d].x * k.x; s1 += q[d].y * k.y; s2 += q[d].z * k.z; s3 += q[d].w * k.w; }
                const float s = (s0 + s1) + (s2 + s3);
                ins16(top, (mono(s) & ~127u) | (unsigned)(127 - n));
            }
#pragma unroll
            for (int j = 0; j < 16; ++j) { const float v = unmono(top[j] & ~127u); const unsigned ix = 127u - (top[j] & 127u);
                const unsigned long long sh = (unsigned long long)ix << ((j & 7) * 8);
                if (hf == 0) { v1[j] = v; if (j < 8) i1lo |= sh; else i1hi |= sh; } else { v2[j] = v; if (j < 8) i2lo |= sh; else i2hi |= sh; } }
        }
        unsigned top[16];
#pragma unroll
        for (int j = 0; j < 16; ++j) top[j] = 0u;
#pragma unroll
        for (int aa = 0; aa < 16; ++aa)
#pragma unroll
            for (int bb = 0; bb < 16; ++bb)
                if ((aa + 1) * (bb + 1) <= 16) ins16(top, (mono(v1[aa] + v2[bb]) & ~255u) | (unsigned)(255 - (aa * 16 + bb)));
        float vals[16]; int ex[16]; float sum = 0.f;
        const float vmax = unmono(top[0] & ~255u);
#pragma unroll
        for (int r = 0; r < 16; ++r) { const int pos = 255 - (int)(top[r] & 255u);
            ex[r] = (int)(lookup8(i1lo, i1hi, pos >> 4) * 128u + lookup8(i2lo, i2hi, pos & 15));
            vals[r] = __expf(unmono(top[r] & ~255u) - vmax); sum += vals[r]; }
        const float inv = 1.f / sum;
#pragma unroll
        for (int r = 0; r < 4; ++r) {
            *(int4*)(elist + (size_t)p * 16 + 4 * r) = make_int4(ex[4 * r], ex[4 * r + 1], ex[4 * r + 2], ex[4 * r + 3]);
            f32x4 g; g.x = vals[4 * r] * inv; g.y = vals[4 * r + 1] * inv; g.z = vals[4 * r + 2] * inv; g.w = vals[4 * r + 3] * inv;
            *(f32x4*)(glist + (size_t)p * 16 + 4 * r) = g;
        }
    }
}

__device__ __forceinline__ void p10_peer(const Args& a, int G, int lane, int wave) {
    unsigned char* ws = a.ws; const bf16* H2 = (const bf16*)(ws + WS_H); const bf16* U = (const bf16*)(ws + WS_U); const bf16* V = (const bf16*)(ws + WS_V);
    const int* elist = (const int*)(ws + WS_ATT); const float* glist = (const float*)(ws + WS_ATT + 8 * MiB);
    const float* mod = (const float*)(ws + WS_MOD); float* out = a.out;
    for (int tok = blockIdx.x * NWAVES + wave; tok < T; tok += G * NWAVES) {
        const int b = tok >> 11;
        const v4u xa = *(const v4u*)(H2 + (size_t)tok * DM + 8 * lane), xb = *(const v4u*)(H2 + (size_t)tok * DM + 512 + 8 * lane);
        const int e0 = elist[(size_t)tok * 128 + lane], e1 = elist[(size_t)tok * 128 + 64 + lane];
        const float g0 = glist[(size_t)tok * 128 + lane], g1 = glist[(size_t)tok * 128 + 64 + lane];
        float f[16];
#pragma unroll
        for (int j = 0; j < 16; ++j) f[j] = 0.f;
#pragma unroll 1
        for (int bt = 0; bt < 16; ++bt) {
            const int er = bt < 8 ? e0 : e1; const float gr = bt < 8 ? g0 : g1; const int l0 = (bt & 7) * 8;
            v4u ua[8], ub[8]; int ei[8]; float d[8];
#pragma unroll
            for (int i = 0; i < 8; ++i) { ei[i] = __builtin_amdgcn_readlane(er, l0 + i);
                ua[i] = *(const v4u*)(U + (size_t)ei[i] * DM + 8 * lane); ub[i] = *(const v4u*)(U + (size_t)ei[i] * DM + 512 + 8 * lane); }
#pragma unroll
            for (int i = 0; i < 8; ++i) { float s = 0.f, t = 0.f;
                s = dot2(ua[i].x, xa.x, s); t = dot2(ua[i].y, xa.y, t); s = dot2(ua[i].z, xa.z, s); t = dot2(ua[i].w, xa.w, t);
                s = dot2(ub[i].x, xb.x, s); t = dot2(ub[i].y, xb.y, t); s = dot2(ub[i].z, xb.z, s); t = dot2(ub[i].w, xb.w, t);
                d[i] = s + t; }
#pragma unroll
            for (int i = 0; i < 8; ++i) { ua[i] = *(const v4u*)(V + (size_t)ei[i] * DM + 8 * lane); ub[i] = *(const v4u*)(V + (size_t)ei[i] * DM + 512 + 8 * lane); }
#pragma unroll
            for (int i = 0; i < 8; ++i) d[i] = wave_sum(d[i]);
#pragma unroll
            for (int i = 0; i < 8; ++i) {
                const float gi = __builtin_bit_cast(float, __builtin_amdgcn_readlane(__builtin_bit_cast(int, gr), l0 + i));
                const float pre = d[i]; const float act = 0.5f * pre * (1.f + erff(pre * 0.70710678118654752f)) * gi;
                f[0] += act * bflo(ua[i].x); f[1] += act * bfhi(ua[i].x); f[2] += act * bflo(ua[i].y); f[3] += act * bfhi(ua[i].y);
                f[4] += act * bflo(ua[i].z); f[5] += act * bfhi(ua[i].z); f[6] += act * bflo(ua[i].w); f[7] += act * bfhi(ua[i].w);
                f[8] += act * bflo(ub[i].x); f[9] += act * bfhi(ub[i].x); f[10] += act * bflo(ub[i].y); f[11] += act * bfhi(ub[i].y);
                f[12] += act * bflo(ub[i].z); f[13] += act * bfhi(ub[i].z); f[14] += act * bflo(ub[i].w); f[15] += act * bfhi(ub[i].w);
            }
        }
        float z[16], t[16];
        load16(out + (size_t)tok * DM, lane, z); load16(mod + b * 6144 + 5120, lane, t);
#pragma unroll
        for (int j = 0; j < 16; ++j) z[j] = DN_ALPHA * z[j] + (1.f + t[j]) * f[j];
        layer_norm16(z, a.in[15], a.in[16], lane);
        store16(out + (size_t)tok * DM, lane, z);
    }
}

constexpr int N_PHASES = 11;
__global__ void __launch_bounds__(NTHR, 2) mega(Args args) {
    extern __shared__ __attribute__((aligned(16))) unsigned char lds_raw[];
    LAS unsigned char* lds = (LAS unsigned char*)lds_raw;
    const int tid = threadIdx.x, lane = tid & 63, wave = __builtin_amdgcn_readfirstlane(tid >> 6), G = gridDim.x;
    unsigned char* ws = args.ws;
    volatile LAS unsigned* MISC = (volatile LAS unsigned*)(lds + MISC_OFF);
    for (int u = tid; u < (LDS_BYTES - RING_BYTES) / 4; u += NTHR) ((LAS unsigned*)(lds + RING_BYTES))[u] = 0u;
    __syncthreads();
    const int lo = args.ph_lo, hi = args.ph_hi;
    unsigned* barw = (unsigned*)(ws + WS_CTL) + CW_BAR + args.bar_idx * XCD_BAR_WORDS;
    XcdBarrier bar; bar.bar = barw; bar.x = 0; bar.st = nullptr;
    if (hi - lo > 1) bar = xcd_barrier_post(barw, MISC + 8);
#define IN(k) (lo <= (k) && (k) < hi)
#define SEAM(k) do { if (IN(k) && IN((k) + 1)) xcd_barrier(bar); } while (0)

    if (IN(0)) { p0_prologue(args, lds, G, tid, lane, wave); } SEAM(0);
    if (IN(1)) { p1_mod_h(args, lds, G, tid, lane, wave); } SEAM(1);
    if (IN(2)) {
        __syncthreads();
        pg8::Gemm g{(const pg8::bf16_t*)(ws + WS_H), (const pg8::bf16_t*)(ws + WS_WIN), T, NQKV, DM};
        pg8::StaticOrder S; S.init(T, NQKV, G, (int)blockIdx.x);
        pg8::EpiBf16<0> E{(pg8::bf16_t*)(ws + WS_QKV), NQKV, nullptr, 0, 0};
        pg8::gemm_phase<pg8::EpiBf16<0>, pg8::StaticOrder, false>(lds, g, S, E, nullptr);
    } SEAM(2);
    if (IN(3)) { p3_kmean(args, lds, G, tid); } SEAM(3);
    if (IN(4)) { p4_attn(args, lds, G, tid, lane, wave); } SEAM(4);
    if (IN(5)) { p5_combine_rms(args, G, lane, wave); } SEAM(5);
    if (IN(6)) {
        __syncthreads();
        pg8::Gemm g{(const pg8::bf16_t*)args.out, (const pg8::bf16_t*)(ws + WS_WOUT), T, DM, DM};
        pg8::StaticOrder S; S.init(T, DM, G, (int)blockIdx.x);
        pg8::EpiF32 E{(float*)(ws + WS_QKV), DM, nullptr};
        pg8::gemm_phase<pg8::EpiF32, pg8::StaticOrder, false>(lds, g, S, E, nullptr);
    } SEAM(6);
    if (IN(7)) { p7_ln1(args, G, lane, wave); } SEAM(7);
    if (IN(8)) {
        __syncthreads();
        pg8::Gemm g{(const pg8::bf16_t*)(ws + WS_H), (const pg8::bf16_t*)(ws + WS_WQ), T, DM, DM};
        pg8::StaticOrder S; S.init(T, DM, G, (int)blockIdx.x);
        pg8::EpiF32 E{(float*)(ws + WS_QKV), DM, nullptr};
        pg8::gemm_phase<pg8::EpiF32, pg8::StaticOrder, false>(lds, g, S, E, nullptr);
    } SEAM(8);
    if (IN(9)) { __syncthreads(); p9_topk(args, lds, G, tid); } SEAM(9);
    if (IN(10)) { p10_peer(args, G, lane, wave); }
#undef IN
#undef SEAM
}
}

#ifndef MK_N_LAUNCHES
#define MK_N_LAUNCHES 1
#endif

extern "C" void kernel_launch(void* const* d_in, const int* in_sizes, int n_in, void* d_out, int out_size, void* d_ws, size_t ws_size, hipStream_t stream) {
    static int grid = 0;
    if (!grid) {
        int dev = 0, cus = 0, per_cu = 0;
        if (hipGetDevice(&dev) != hipSuccess || hipDeviceGetAttribute(&cus, hipDeviceAttributeMultiprocessorCount, dev) != hipSuccess) { fprintf(stderr, "kernel_launch: device query failed\n"); return; }
        if (hipFuncSetAttribute((const void*)mk::mega, hipFuncAttributeMaxDynamicSharedMemorySize, mk::LDS_BYTES) != hipSuccess) { fprintf(stderr, "kernel_launch: hipFuncSetAttribute failed\n"); return; }
        if (hipOccupancyMaxActiveBlocksPerMultiprocessor(&per_cu, (const void*)mk::mega, mk::NTHR, mk::LDS_BYTES) != hipSuccess || per_cu < 1) { fprintf(stderr, "kernel_launch: occupancy query says %d\n", per_cu); return; }
        grid = cus;
    }
    if (n_in != 17 || ws_size < mk::WS_END) { fprintf(stderr, "kernel_launch: unexpected n_in %d / ws %zu\n", n_in, ws_size); return; }
    (void)hipMemsetAsync((char*)d_ws + mk::WS_CTL, 0, mk::CTL_ZERO_BYTES, stream);
    mk::Args a{};
    for (int i = 0; i < 17; ++i) a.in[i] = (const float*)d_in[i];
    a.out = (float*)d_out; a.ws = (unsigned char*)d_ws;
    a.ph_lo = 0; a.ph_hi = mk::N_PHASES;
    hipLaunchKernelGGL(mk::mega, dim3(grid), dim3(mk::NTHR), mk::LDS_BYTES, stream, a);
}
```

```cpp
#include <hip/hip_runtime.h>
#include <stdint.h>
#include <math.h>
#include <stdio.h>
namespace pg8 {
#define PG8_LAS __attribute__((address_space(3)))
typedef unsigned short bf16_t;
typedef short bf16x8 __attribute__((ext_vector_type(8)));
typedef float f32x4 __attribute__((ext_vector_type(4)));
typedef unsigned u32x4 __attribute__((ext_vector_type(4)));
constexpr int BM = 256, BK = 64, HALF = 128, HTB = HALF * BK * 2  , STAGE_BYTES = 8 * HTB, NXCD = 8, WGM = 8;

__host__ __device__ __forceinline__ int lds_byte(int r, int c) { const int st = (r >> 4) * 2 + (c >> 5), rr = r & 15, cc = c & 31, ob = rr * 64 + cc * 2; return st * 1024 + (ob ^ (((ob >> 9) & 1) << 5)); }
__host__ __device__ __forceinline__ void stage_rc(int b, int& R, int& C) { const int st = b / 1024, sb = b % 1024, swz = sb ^ (((sb >> 9) & 1) << 5); R = (st >> 1) * 16 + swz / 64; C = (st & 1) * 32 + (swz % 64) / 2; }
__host__ __device__ __forceinline__ int perm32(int rho) { const int n = rho >> 4, i = rho & 15; return 8 * (i >> 2) + 4 * n + (i & 3); }

struct Unit { int pm, pn; };
struct Gemm { const bf16_t* A; const bf16_t* Bt; int M, N, K; };

struct StaticOrder {
    int nM, nN, nwg, G, c;
    __host__ __device__ void init(int M, int N, int G_, int c_) { nM = M / BM; nN = N / BM; nwg = nM * nN; G = G_; c = c_; }
    __host__ __device__ bool next(int i, Unit& u) const {
        const long L = (long)i * G + c; if (L >= nwg) return false;
        int wgid = (int)L; { const int q = nwg / NXCD, r = nwg % NXCD, xcd = wgid % NXCD, off = wgid / NXCD; wgid = (xcd < r ? xcd * (q + 1) : r * (q + 1) + (xcd - r) * q) + off; }
        const int nig = WGM * nN, gid = wgid / nig, fm = gid * WGM, gsz = (nM - fm) < WGM ? (nM - fm) : WGM;
        u.pm = fm + ((wgid % nig) % gsz); u.pn = (wgid % nig) / gsz; return true;
    }
    __device__ __forceinline__ void a_ready(const Unit&) const {}
    __device__ __forceinline__ void done(const Unit&) const {}
};
struct CountedOrder : StaticOrder {
    const unsigned* ready; unsigned need; unsigned* tmo;
    __device__ __forceinline__ void a_ready(const Unit& u) const {
        if (threadIdx.x < 64) {
            const unsigned long long t0 = __builtin_amdgcn_s_memrealtime(); unsigned polls = 0;
            while ((unsigned)__builtin_amdgcn_readfirstlane(__hip_atomic_load(ready + 64 * u.pm, __ATOMIC_RELAXED, __HIP_MEMORY_SCOPE_AGENT)) < need) {
                if ((++polls & 255u) == 0u && __builtin_amdgcn_readfirstlane(__hip_atomic_load(tmo, __ATOMIC_RELAXED, __HIP_MEMORY_SCOPE_AGENT)) != 0u) break;
                if (__builtin_amdgcn_s_memrealtime() - t0 > 2000000ull) {
                    if (threadIdx.x == 0) { unsigned expect = 0u; __hip_atomic_compare_exchange_strong(tmo + 1, &expect, 0x600u | (unsigned)(u.pm & 0xff), __ATOMIC_RELAXED, __ATOMIC_RELAXED, __HIP_MEMORY_SCOPE_AGENT); __hip_atomic_store(tmo, 1u, __ATOMIC_RELAXED, __HIP_MEMORY_SCOPE_AGENT); }
                    break; }
                __builtin_amdgcn_s_sleep(2); }
            __builtin_amdgcn_fence(__ATOMIC_ACQUIRE, "agent");
            asm volatile("s_waitcnt vmcnt(0)" ::: "memory");
        }
#if !defined(BROKEN_HOOK_NO_BARRIER)
        asm volatile("" ::: "memory"); __builtin_amdgcn_s_barrier(); asm volatile("" ::: "memory");
#endif
    }
};

__device__ __forceinline__ unsigned cvt_pk_bf16(float lo, float hi) { unsigned r; asm volatile("v_cvt_pk_bf16_f32 %0, %1, %2" : "=v"(r) : "v"(lo), "v"(hi)); return r; }
typedef float f32x2 __attribute__((ext_vector_type(2)));
__device__ __forceinline__ f32x2 gelu_pk(f32x2 v) {
    const f32x2 av = __builtin_elementwise_abs(v), d = av * 0.2316418882f + 1.0f;
    f32x2 t; t.x = __builtin_amdgcn_rcpf(d.x); t.y = __builtin_amdgcn_rcpf(d.y);
    f32x2 q = t * 0.5307027145f + (-0.7265760135f); q = q * t + 0.7107068705f; q = q * t + (-0.142248368f); q = q * t + 0.127414796f; q = q * t;
    const f32x2 s = (v * v) * (-0.72134752044f);
    f32x2 e; e.x = __builtin_amdgcn_exp2f(s.x); e.y = __builtin_amdgcn_exp2f(s.y);
    const f32x2 m = v * (q * e), r = v - m;
    f32x2 o; o.x = v.x < 0.f ? m.x : r.x; o.y = v.y < 0.f ? m.y : r.y; return o;
}

struct EpiF32 {
    static constexpr bool PERM = false, AFTER_DRAIN = false;
    float* C; int ldc; const float* bias;
    __device__ __forceinline__ void operator()(const f32x4 (&acc)[2][2][4][2], const Unit& u, int wr, int wc, int fr, int fq) const {
        const int row0 = u.pm * BM + wr * 64 + fr, col0 = u.pn * BM + wc * 32 + 4 * fq;
        f32x4 bv[2][2];
#pragma unroll
        for (int bj = 0; bj < 2; ++bj)
#pragma unroll
            for (int n = 0; n < 2; ++n) bv[bj][n] = bias ? *(const f32x4*)(bias + col0 + bj * HALF + n * 16) : (f32x4){0.f, 0.f, 0.f, 0.f};
#pragma unroll
        for (int ai = 0; ai < 2; ++ai)
#pragma unroll
            for (int m = 0; m < 4; ++m) { float* rowp = C + (size_t)(row0 + ai * HALF + m * 16) * ldc + col0;
#pragma unroll
                for (int bj = 0; bj < 2; ++bj)
#pragma unroll
                    for (int n = 0; n < 2; ++n) *(f32x4*)(rowp + bj * HALF + n * 16) = acc[ai][bj][m][n] + bv[bj][n]; }
    }
};
template <int ACT  > struct EpiBf16 {
    static constexpr bool PERM = true, AFTER_DRAIN = false;
    bf16_t* O; int ldc; const float* bias; int split_cols; size_t split_stride;
    __device__ __forceinline__ void operator()(const f32x4 (&acc)[2][2][4][2], const Unit& u, int wr, int wc, int fr, int fq) const {
        const int row0 = u.pm * BM + wr * 64 + fr; int colt = u.pn * BM; bf16_t* base = O;
        if (split_cols) { const int t = colt / split_cols; base += (size_t)t * split_stride; colt -= t * split_cols; }
        const int col0 = colt + wc * 32 + 8 * fq, bcol0 = u.pn * BM + wc * 32 + 8 * fq;
        f32x4 bv[2][2];
#pragma unroll
        for (int bj = 0; bj < 2; ++bj)
#pragma unroll
            for (int n = 0; n < 2; ++n) bv[bj][n] = bias ? *(const f32x4*)(bias + bcol0 + bj * HALF + 4 * n) : (f32x4){0.f, 0.f, 0.f, 0.f};
#pragma unroll
        for (int ai = 0; ai < 2; ++ai)
#pragma unroll
            for (int m = 0; m < 4; ++m) { bf16_t* rowp = base + (size_t)(row0 + ai * HALF + m * 16) * ldc + col0;
#pragma unroll
                for (int bj = 0; bj < 2; ++bj) { f32x4 v0 = acc[ai][bj][m][0] + bv[bj][0], v1 = acc[ai][bj][m][1] + bv[bj][1];
                    if (ACT == 1) { f32x2 a = gelu_pk((f32x2){v0[0], v0[1]}), b = gelu_pk((f32x2){v0[2], v0[3]}), c = gelu_pk((f32x2){v1[0], v1[1]}), d = gelu_pk((f32x2){v1[2], v1[3]});
                        v0 = (f32x4){a.x, a.y, b.x, b.y}; v1 = (f32x4){c.x, c.y, d.x, d.y}; }
                    if (ACT == 2) {
#pragma unroll
                        for (int j = 0; j < 4; ++j) { v0[j] = 0.5f * v0[j] * (1.0f + erff(v0[j] * 0.70710678f)); v1[j] = 0.5f * v1[j] * (1.0f + erff(v1[j] * 0.70710678f)); } }
                    u32x4 w; w.x = cvt_pk_bf16(v0[0], v0[1]); w.y = cvt_pk_bf16(v0[2], v0[3]); w.z = cvt_pk_bf16(v1[0], v1[1]); w.w = cvt_pk_bf16(v1[2], v1[3]);
                    *(u32x4*)(rowp + bj * HALF) = w; } }
    }
};

struct PanelStats {
    unsigned* xbuf;
    unsigned* cnt;
    unsigned* tmo;
    int ntn; float eps;
    unsigned code;
    __device__ __forceinline__ bool run(const f32x4 (&v)[2][2][4][2], const Unit& u, int wr, int wc, int fr, int fq, PG8_LAS unsigned char* lds, int wid, int lane) const {
        typedef float f32x2v __attribute__((ext_vector_type(2)));
        PG8_LAS f32x2v* P = (PG8_LAS f32x2v*)lds;
        PG8_LAS f32x2v* S = (PG8_LAS f32x2v*)(lds + 8192);
        PG8_LAS unsigned* flag = (PG8_LAS unsigned*)(lds + 8192 + 2048);
#pragma unroll
        for (int ai = 0; ai < 2; ++ai)
#pragma unroll
            for (int m = 0; m < 4; ++m) {
                float s = 0.f;
#pragma unroll
                for (int bj = 0; bj < 2; ++bj)
#pragma unroll
                    for (int n = 0; n < 2; ++n) { const f32x4 x = v[ai][bj][m][n]; s += (x[0] + x[1]) + (x[2] + x[3]); }
                s += __shfl_xor(s, 16); s += __shfl_xor(s, 32);
                const float mw = s * (1.0f / 64.0f); float q = 0.f;
#pragma unroll
                for (int bj = 0; bj < 2; ++bj)
#pragma unroll
                    for (int n = 0; n < 2; ++n) { const f32x4 d = v[ai][bj][m][n] - mw; q += (d[0] * d[0] + d[1] * d[1]) + (d[2] * d[2] + d[3] * d[3]); }
                q += __shfl_xor(q, 16); q += __shfl_xor(q, 32);
                if (fq == 0) P[(ai * HALF + wr * 64 + m * 16 + fr) * 4 + wc] = (f32x2v){mw, q};
            }
        asm volatile("s_waitcnt lgkmcnt(0)" ::: "memory"); __builtin_amdgcn_s_barrier(); asm volatile("" ::: "memory");
#if defined(BROKEN_NO_WAIT)
        if (blockIdx.x >= 64) { const long long t0 = clock64(); while (clock64() - t0 < 60000) __builtin_amdgcn_s_sleep(8); }
#endif
        const int row = wid * 32 + (lane & 31);
        if (lane < 32) {
            const f32x2v a = P[row * 4 + 0], b = P[row * 4 + 1], c = P[row * 4 + 2], d = P[row * 4 + 3];
            const float mt = (a.x + b.x + c.x + d.x) * 0.25f;
            const float da = a.x - mt, db = b.x - mt, dc = c.x - mt, dd = d.x - mt;
            const float m2 = (a.y + b.y) + (c.y + d.y) + 64.0f * ((da * da + db * db) + (dc * dc + dd * dd));
            unsigned long long* slot = (unsigned long long*)xbuf + ((size_t)(u.pm * BM + row) * 4 + u.pn);
            __hip_atomic_store(slot, ((unsigned long long)__float_as_uint(m2) << 32) | __float_as_uint(mt), __ATOMIC_RELAXED, __HIP_MEMORY_SCOPE_AGENT);
        }
        asm volatile("s_waitcnt vmcnt(0)" ::: "memory");
        if (lane == 0) __hip_atomic_fetch_add(cnt + 64 * u.pm, 1u, __ATOMIC_RELAXED, __HIP_MEMORY_SCOPE_AGENT);
        if (wid == 0) {
            bool dead = false; const unsigned long long t0 = __builtin_amdgcn_s_memrealtime(); const unsigned want = 8u * (unsigned)ntn;
            for (;;) {
#if defined(BROKEN_NO_WAIT)
                break;
#endif
                if ((unsigned)__builtin_amdgcn_readfirstlane(__hip_atomic_load(cnt + 64 * u.pm, __ATOMIC_RELAXED, __HIP_MEMORY_SCOPE_AGENT)) >= want) break;
                if (__builtin_amdgcn_s_memrealtime() - t0 > 2000000ull) {
                    if (lane == 0) { unsigned expect = 0u; __hip_atomic_compare_exchange_strong(tmo + 1, &expect, code | (unsigned)(u.pm & 0xff), __ATOMIC_RELAXED, __ATOMIC_RELAXED, __HIP_MEMORY_SCOPE_AGENT);
                                     __hip_atomic_store(tmo, 1u, __ATOMIC_RELAXED, __HIP_MEMORY_SCOPE_AGENT); }
                    dead = true; break; }
                __builtin_amdgcn_s_sleep(2);
            }
            __builtin_amdgcn_fence(__ATOMIC_ACQUIRE, "agent");
            if (lane == 0) flag[0] = dead ? 1u : 0u;
        }
        asm volatile("s_waitcnt vmcnt(0) lgkmcnt(0)" ::: "memory"); __builtin_amdgcn_s_barrier(); asm volatile("" ::: "memory");
        const bool bad = flag[0] != 0u;
        if (lane < 32) {
            const unsigned long long* slot = (const unsigned long long*)xbuf + (size_t)(u.pm * BM + row) * 4; float mt[4], m2[4]; float ms = 0.f;
#pragma unroll
            for (int t = 0; t < 4; ++t) { if (t < ntn) { const unsigned long long w = __hip_atomic_load(slot + t, __ATOMIC_RELAXED, __HIP_MEMORY_SCOPE_AGENT); mt[t] = __uint_as_float((unsigned)w); m2[t] = __uint_as_float((unsigned)(w >> 32)); } else { mt[t] = 0.f; m2[t] = 0.f; } ms += mt[t]; }
            const float mean = ms / (float)ntn; float q = 0.f;
#pragma unroll
            for (int t = 0; t < 4; ++t) if (t < ntn) { const float dm = mt[t] - mean; q += m2[t] + 256.0f * dm * dm; }
            S[row] = (f32x2v){mean, 1.0f / sqrtf(q / (256.0f * (float)ntn) + eps)};
        }
        asm volatile("s_waitcnt lgkmcnt(0)" ::: "memory"); __builtin_amdgcn_s_barrier(); asm volatile("" ::: "memory");
        return bad;
    }
};
struct EpiLnRes {
    static constexpr bool PERM = false, AFTER_DRAIN = true;
    const float* base; float* out; int ldc; const float* bias; PanelStats st; unsigned poison;
    __device__ __forceinline__ void refuse(size_t i0, size_t stride, int M, int N) const { const float q = __builtin_nanf(""); for (size_t i = i0; i < (size_t)M * N; i += stride) out[(i / N) * ldc + i % N] = q;
        if (i0 == 0) { unsigned expect = 0u; __hip_atomic_compare_exchange_strong(st.tmo + 1, &expect, 0x7f0u, __ATOMIC_RELAXED, __ATOMIC_RELAXED, __HIP_MEMORY_SCOPE_AGENT); __hip_atomic_store(st.tmo, 1u, __ATOMIC_RELAXED, __HIP_MEMORY_SCOPE_AGENT); } }
    __device__ __forceinline__ void fused(f32x4 (&acc)[2][2][4][2], const Unit& u, int wr, int wc, int fr, int fq, PG8_LAS unsigned char* lds, int wid, int lane) const {
        typedef float f32x2v __attribute__((ext_vector_type(2)));
        const PG8_LAS f32x2v* S = (const PG8_LAS f32x2v*)(lds + 8192);
        const int col0 = u.pn * BM + wc * 32 + 4 * fq;
#pragma unroll
        for (int bj = 0; bj < 2; ++bj)
#pragma unroll
            for (int n = 0; n < 2; ++n) { const f32x4 bv = bias ? *(const f32x4*)(bias + col0 + bj * HALF + n * 16) : (f32x4){0.f, 0.f, 0.f, 0.f};
#pragma unroll
                for (int ai = 0; ai < 2; ++ai)
#pragma unroll
                    for (int m = 0; m < 4; ++m) acc[ai][bj][m][n] += bv; }
        const bool bad = st.run(acc, u, wr, wc, fr, fq, lds, wid, lane) || poison != 0u;
        const float qnan = __builtin_nanf("");
#pragma unroll
        for (int ai = 0; ai < 2; ++ai)
#pragma unroll
            for (int m = 0; m < 4; ++m) { const int r = ai * HALF + wr * 64 + m * 16 + fr; const f32x2v sr = S[r]; const size_t off = (size_t)(u.pm * BM + r) * ldc + col0;
#pragma unroll
                for (int bj = 0; bj < 2; ++bj)
#pragma unroll
                    for (int n = 0; n < 2; ++n) { const f32x4 bs = *(const f32x4*)(base + off + bj * HALF + n * 16); f32x4 o = bs + (acc[ai][bj][m][n] - sr.x) * sr.y;
                        if (bad) o = (f32x4){qnan, qnan, qnan, qnan}; *(f32x4*)(out + off + bj * HALF + n * 16) = o; }
                asm volatile("" ::: "memory"); }
    }
};
struct EpiLnResLn {
    static constexpr bool PERM = false, AFTER_DRAIN = true;
    const float* base; float* out; bf16_t* xn; int ldc; const float* bias; PanelStats st1, st2; unsigned poison;
    __device__ __forceinline__ void refuse(size_t i0, size_t stride, int M, int N) const { const float q = __builtin_nanf(""); for (size_t i = i0; i < (size_t)M * N; i += stride) { const size_t o = (i / N) * ldc + i % N; out[o] = q; xn[o] = (bf16_t)0x7fc0u; }
        if (i0 == 0) { unsigned expect = 0u; __hip_atomic_compare_exchange_strong(st1.tmo + 1, &expect, 0x7f0u, __ATOMIC_RELAXED, __ATOMIC_RELAXED, __HIP_MEMORY_SCOPE_AGENT); __hip_atomic_store(st1.tmo, 1u, __ATOMIC_RELAXED, __HIP_MEMORY_SCOPE_AGENT); } }
    __device__ __forceinline__ void fused(f32x4 (&acc)[2][2][4][2], const Unit& u, int wr, int wc, int fr, int fq, PG8_LAS unsigned char* lds, int wid, int lane) const {
        typedef float f32x2v __attribute__((ext_vector_type(2))); typedef unsigned u32x2v __attribute__((ext_vector_type(2)));
        const PG8_LAS f32x2v* S = (const PG8_LAS f32x2v*)(lds + 8192);
        const int col0 = u.pn * BM + wc * 32 + 4 * fq;
#pragma unroll
        for (int bj = 0; bj < 2; ++bj)
#pragma unroll
            for (int n = 0; n < 2; ++n) { const f32x4 bv = bias ? *(const f32x4*)(bias + col0 + bj * HALF + n * 16) : (f32x4){0.f, 0.f, 0.f, 0.f};
#pragma unroll
                for (int ai = 0; ai < 2; ++ai)
#pragma unroll
                    for (int m = 0; m < 4; ++m) acc[ai][bj][m][n] += bv; }
        bool bad = st1.run(acc, u, wr, wc, fr, fq, lds, wid, lane) || poison != 0u;
        const float qnan = __builtin_nanf("");
#pragma unroll
        for (int ai = 0; ai < 2; ++ai)
#pragma unroll
            for (int m = 0; m < 4; ++m) { const int r = ai * HALF + wr * 64 + m * 16 + fr; const f32x2v sr = S[r]; const size_t off = (size_t)(u.pm * BM + r) * ldc + col0;
#pragma unroll
                for (int bj = 0; bj < 2; ++bj)
#pragma unroll
                    for (int n = 0; n < 2; ++n) { const f32x4 bs = *(const f32x4*)(base + off + bj * HALF + n * 16); acc[ai][bj][m][n] = bs + (acc[ai][bj][m][n] - sr.x) * sr.y; }
                asm volatile("" : "+v"(acc[ai][0][m][0]), "+v"(acc[ai][0][m][1]), "+v"(acc[ai][1][m][0]), "+v"(acc[ai][1][m][1]));
                if (m & 1) asm volatile("" ::: "memory"); }
        const bool bad1 = bad;
        bad = st2.run(acc, u, wr, wc, fr, fq, lds, wid, lane) || bad;
#pragma unroll
        for (int ai = 0; ai < 2; ++ai)
#pragma unroll
            for (int m = 0; m < 4; ++m) { const int r = ai * HALF + wr * 64 + m * 16 + fr; const f32x2v sr = S[r]; const size_t off = (size_t)(u.pm * BM + r) * ldc + col0;
#pragma unroll
                for (int bj = 0; bj < 2; ++bj)
#pragma unroll
                    for (int n = 0; n < 2; ++n) { const f32x4 x1 = acc[ai][bj][m][n]; *(f32x4*)(out + off + bj * HALF + n * 16) = bad1 ? (f32x4){qnan, qnan, qnan, qnan} : x1;
                        const f32x4 o = (x1 - sr.x) * sr.y; u32x2v w; w.x = cvt_pk_bf16(o[0], o[1]); w.y = cvt_pk_bf16(o[2], o[3]);
                        if (bad) { w.x = 0x7fc07fc0u; w.y = 0x7fc07fc0u; } *(u32x2v*)(xn + off + bj * HALF + n * 16) = w; }
                asm volatile("" ::: "memory"); }
    }
};

template <class Epi, class Sched, bool STAMP = false>
__device__ __forceinline__ void gemm_phase(PG8_LAS unsigned char* lds, const Gemm g, const Sched& S, const Epi& E, unsigned long long* stamps) {
    const int tid = threadIdx.x, wid = __builtin_amdgcn_readfirstlane(tid >> 6), lane = tid & 63, wr = wid >> 2, wc = wid & 3, fr = lane & 15, fq = lane >> 4;
    const int K = g.K, nt = K / BK;
    int ts_lo = 0, ts_hi = 0, nts = 0; const unsigned long long rt_entry = STAMP ? (unsigned long long)wall_clock64() : 0ull;
#define PG8_STAMP() do { if (STAMP && wid == 0 && nts < 64) { const unsigned long long _c = (unsigned long long)clock64(); \
        ts_lo = (lane == nts) ? (int)(unsigned)_c : ts_lo; ts_hi = (lane == nts) ? (int)(unsigned)(_c >> 32) : ts_hi; ++nts; } } while (0)
    PG8_STAMP();
    unsigned voffA[2], voffB[2];
#pragma unroll
    for (int i = 0; i < 2; ++i) { int R, C; stage_rc(tid * 16 + i * 8192, R, C); const int Rb = Epi::PERM ? ((R & ~31) + perm32(R & 31)) : R;
        voffA[i] = (unsigned)(R * K + C) * 2u; voffB[i] = (unsigned)(Rb * K + C) * 2u; }
    const size_t kstep = (size_t)(BK * 2);
    const size_t hstep = (size_t)HALF * K * 2;
    const size_t tstep = 2 * hstep;
    const unsigned ldsw = (unsigned)wid * 1024u;
    const int aoff = lds_byte(wr * 64 + fr, fq * 8), boff = lds_byte(wc * 32 + fr, fq * 8);
#define PG8_SA(b, h) (((b) * 2 + (h)) * HTB)
#define PG8_SB(b, h) ((4 + (b) * 2 + (h)) * HTB)
#define PG8_STAGE(bufoff, gbase, voff) do { _Pragma("unroll") for (int _i = 0; _i < 2; ++_i) \
        __builtin_amdgcn_global_load_lds((const unsigned*)((const char*)(gbase) + (voff)[_i]), (PG8_LAS unsigned*)(lds + (bufoff) + ldsw + _i * 8192), 16, 0, 0); } while (0)
#define PG8_LDA(dst, b, h) do { _Pragma("unroll") for (int m = 0; m < 4; ++m) _Pragma("unroll") for (int k = 0; k < 2; ++k) dst[m][k] = *(const PG8_LAS bf16x8*)(lds + PG8_SA(b, h) + aoff + m * 2048 + k * 1024); } while (0)
#define PG8_LDB(dst, b, h) do { _Pragma("unroll") for (int n = 0; n < 2; ++n) _Pragma("unroll") for (int k = 0; k < 2; ++k) dst[n][k] = *(const PG8_LAS bf16x8*)(lds + PG8_SB(b, h) + boff + n * 2048 + k * 1024); } while (0)
#define PG8_MMA(ai, bj, At, Bt) do { __builtin_amdgcn_s_setprio(1); _Pragma("unroll") for (int m = 0; m < 4; ++m) _Pragma("unroll") for (int n = 0; n < 2; ++n) _Pragma("unroll") for (int k = 0; k < 2; ++k) \
        acc[ai][bj][m][n] = __builtin_amdgcn_mfma_f32_16x16x32_bf16(Bt[n][k], At[m][k], acc[ai][bj][m][n], 0, 0, 0); __builtin_amdgcn_s_setprio(0); } while (0)
#define PG8_WAIT_V(n) asm volatile("s_waitcnt vmcnt(" #n ")" ::: "memory")
#define PG8_WAIT_L(n) asm volatile("s_waitcnt lgkmcnt(" #n ")" ::: "memory")
#define PG8_BAR __builtin_amdgcn_s_barrier()
#define PG8_SCHED __builtin_amdgcn_sched_barrier(0)
    Unit cur, nxt; int ui = 0;
    if (!S.next(0, cur)) return;
    f32x4 acc[2][2][4][2];
#pragma unroll
    for (int a = 0; a < 2; ++a)
#pragma unroll
        for (int b = 0; b < 2; ++b)
#pragma unroll
            for (int m = 0; m < 4; ++m)
#pragma unroll
                for (int n = 0; n < 2; ++n) acc[a][b][m][n] = (f32x4){0.f, 0.f, 0.f, 0.f};
    bf16x8 At[4][2], B0[2][2], B1[2][2];
    const char* cA = (const char*)g.A + (size_t)cur.pm * tstep; const char* cB = (const char*)g.Bt + (size_t)cur.pn * tstep;
    S.a_ready(cur);
    PG8_STAGE(PG8_SB(0, 0), cB, voffB); PG8_STAGE(PG8_SA(0, 0), cA, voffA); PG8_STAGE(PG8_SB(0, 1), cB + hstep, voffB); PG8_STAGE(PG8_SA(0, 1), cA + hstep, voffA);
    if (wr == 1) PG8_BAR;
    PG8_WAIT_V(4); PG8_BAR;
    PG8_STAGE(PG8_SB(1, 0), cB + kstep, voffB); PG8_STAGE(PG8_SA(1, 0), cA + kstep, voffA); PG8_STAGE(PG8_SB(1, 1), cB + hstep + kstep, voffB);
    PG8_WAIT_V(6); PG8_BAR;
    PG8_STAMP();
    for (;;) {
        const bool has_next = S.next(ui + 1, nxt);
        const char* nA = has_next ? (const char*)g.A + (size_t)nxt.pm * tstep : cA; const char* nB = has_next ? (const char*)g.Bt + (size_t)nxt.pn * tstep : cB;
        for (int t = 0; t < nt; t += 2) {
            const bool last = (t == nt - 2);
            const char* a1 = cA + (size_t)(t + 1) * kstep;
            const char* a2 = last ? nA : cA + (size_t)(t + 2) * kstep; const char* b2 = last ? nB : cB + (size_t)(t + 2) * kstep;
            const char* a3 = a2 + kstep; const char* b3 = b2 + kstep;
            if (last && has_next) S.a_ready(nxt);
            PG8_LDB(B0, 0, 0); PG8_SCHED; PG8_LDA(At, 0, 0); PG8_STAGE(PG8_SA(1, 1), a1 + hstep, voffA);
            PG8_WAIT_L(8); PG8_BAR; PG8_WAIT_L(0); PG8_MMA(0, 0, At, B0); PG8_BAR; PG8_SCHED;
            PG8_LDB(B1, 0, 1); PG8_STAGE(PG8_SB(0, 0), b2, voffB);
            PG8_BAR; PG8_WAIT_L(0); PG8_MMA(0, 1, At, B1); PG8_BAR;
            PG8_LDA(At, 0, 1); PG8_STAGE(PG8_SA(0, 0), a2, voffA);
            PG8_BAR; PG8_WAIT_L(0); PG8_MMA(1, 0, At, B0); PG8_BAR; PG8_SCHED;
            PG8_STAGE(PG8_SB(0, 1), b2 + hstep, voffB);
            PG8_WAIT_V(6); PG8_BAR; PG8_MMA(1, 1, At, B1); PG8_BAR;
            PG8_LDB(B0, 1, 0); PG8_SCHED; PG8_LDA(At, 1, 0); PG8_STAGE(PG8_SA(0, 1), a2 + hstep, voffA);
            PG8_WAIT_L(8); PG8_BAR; PG8_WAIT_L(0); PG8_MMA(0, 0, At, B0); PG8_BAR; PG8_SCHED;
            PG8_LDB(B1, 1, 1); PG8_STAGE(PG8_SB(1, 0), b3, voffB);
            PG8_BAR; PG8_WAIT_L(0); PG8_MMA(0, 1, At, B1); PG8_BAR;
            PG8_LDA(At, 1, 1); PG8_STAGE(PG8_SA(1, 0), a3, voffA);
            PG8_BAR; PG8_WAIT_L(0); PG8_MMA(1, 0, At, B0); PG8_BAR; PG8_SCHED;
            PG8_STAGE(PG8_SB(1, 1), b3 + hstep, voffB);
            PG8_WAIT_V(6); PG8_BAR; PG8_MMA(1, 1, At, B1); PG8_BAR;
        }
        PG8_STAMP();
        if constexpr (!Epi::AFTER_DRAIN) { E(acc, cur, wr, wc, fr, fq); S.done(cur); }
        PG8_STAMP();
        if (!has_next) break;
#pragma unroll
        for (int a = 0; a < 2; ++a)
#pragma unroll
            for (int b = 0; b < 2; ++b)
#pragma unroll
                for (int m = 0; m < 4; ++m)
#pragma unroll
                    for (int n = 0; n < 2; ++n) acc[a][b][m][n] = (f32x4){0.f, 0.f, 0.f, 0.f};
        cur = nxt; cA = nA; cB = nB; ++ui;
    }
    PG8_WAIT_V(0);
    if (wr == 0) PG8_BAR;
    PG8_BAR;
    if constexpr (Epi::AFTER_DRAIN) { E.fused(acc, cur, wr, wc, fr, fq, lds, wid, lane); S.done(cur); }
    PG8_STAMP();
    if (STAMP && wid == 0) { stamps[lane] = lane < nts ? (((unsigned long long)(unsigned)ts_hi << 32) | (unsigned)ts_lo) : 0ull;
        if (lane == 62) stamps[62] = rt_entry; if (lane == 63) stamps[63] = (unsigned long long)wall_clock64(); }
#undef PG8_STAMP
#undef PG8_SA
#undef PG8_SB
#undef PG8_STAGE
#undef PG8_LDA
#undef PG8_LDB
#undef PG8_MMA
#undef PG8_WAIT_V
#undef PG8_WAIT_L
#undef PG8_BAR
#undef PG8_SCHED
}
}
#define XB_TMO      128
#define XB_XCNT(j)  (256  + 64 * (j))
#define XB_XSUB(j)  (1280 + 64 * (j))
#define XB_XGEN(j)  (2304 + 64 * (j))
#define XB_TOP      3328
#define XB_TOPGEN   3392
#define XCD_BAR_WORDS 3456
#define XB_SPIN_CAP (1u << 18)
#define LAS __attribute__((address_space(3)))

__device__ __forceinline__ unsigned xb_ld(unsigned* p)              { return __hip_atomic_load(p, __ATOMIC_RELAXED, __HIP_MEMORY_SCOPE_AGENT); }
__device__ __forceinline__ unsigned xb_add(unsigned* p, unsigned v) { return __hip_atomic_fetch_add(p, v, __ATOMIC_RELAXED, __HIP_MEMORY_SCOPE_AGENT); }
__device__ __forceinline__ unsigned xb_xcc_id() { return (unsigned)__builtin_amdgcn_s_getreg((3 << 11) | 20) & 0xFu; }
#define XB_SPIN(cond, bar) do { unsigned _sp = 0; while (cond) { __builtin_amdgcn_s_sleep(1); \
    if ((++_sp & 255u) == 0u) { if (xb_ld(&(bar)[XB_TMO])) break; if (_sp > XB_SPIN_CAP) { atomicAdd(&(bar)[XB_TMO], 1u); break; } } } } while (0)

struct XcdBarrier {
    unsigned* bar; unsigned x;
    volatile LAS unsigned* st;
};

__device__ __forceinline__ XcdBarrier xcd_barrier_post(unsigned* bar, volatile LAS unsigned* st) {
    XcdBarrier b; b.bar = bar; b.x = xb_xcc_id(); b.st = st;
    if (threadIdx.x == 0) (void)xb_add(&bar[XB_XCNT(b.x)], 1u);
    return b;
}
__device__ __forceinline__ void xcd_barrier_complete(unsigned* bar, unsigned x, unsigned& nloc, unsigned& nx) {
    const unsigned G = gridDim.x * gridDim.y * gridDim.z;
    unsigned sum, cnt, mine, sp = 0u;
    for (;;) {
        sum = 0u; cnt = 0u; mine = 0u;
#pragma unroll
        for (unsigned j = 0; j < 16; ++j) { const unsigned c = xb_ld(&bar[XB_XCNT(j)]); sum += c; cnt += (c > 0u) ? 1u : 0u; mine = (j == x) ? c : mine; }
        if (sum == G) break;
        __builtin_amdgcn_s_sleep(1);
        if ((++sp & 255u) == 0u) { if (xb_ld(&bar[XB_TMO])) break; if (sp > XB_SPIN_CAP) { atomicAdd(&bar[XB_TMO], 1u); break; } }
    }
    nloc = mine > 0u ? mine : 1u; nx = cnt > 0u ? cnt : 1u;
}

__device__ __forceinline__ void xcd_barrier(const XcdBarrier& b) {
    asm volatile("s_waitcnt vmcnt(0)" ::: "memory");
    __syncthreads();
    if (threadIdx.x == 0) {
        unsigned* bar = b.bar;
        __builtin_amdgcn_s_waitcnt(0);
        unsigned nloc = b.st[0], nx = b.st[1];
        if (nloc == 0u) { xcd_barrier_complete(bar, b.x, nloc, nx); b.st[0] = nloc; b.st[1] = nx; }
        const unsigned old = xb_add(&bar[XB_XSUB(b.x)], 1u);
        const unsigned gen = old / nloc;
        if (old + 1u == (gen + 1u) * nloc) {
            __builtin_amdgcn_fence(__ATOMIC_RELEASE, "agent");
            asm volatile("s_waitcnt vmcnt(0)" ::: "memory");
            const unsigned og = xb_add(&bar[XB_TOP], 1u);
            const unsigned tg = og / nx;
            if (og + 1u == (tg + 1u) * nx) xb_add(&bar[XB_TOPGEN], 1u);
            else XB_SPIN(xb_ld(&bar[XB_TOPGEN]) == tg, bar);
            __builtin_amdgcn_fence(__ATOMIC_ACQUIRE, "agent");
            xb_add(&bar[XB_XGEN(b.x)], 1u);
            asm volatile("s_waitcnt vmcnt(0)" ::: "memory");
        } else {
            XB_SPIN(xb_ld(&bar[XB_XGEN(b.x)]) == gen, bar);
            __builtin_amdgcn_fence(__ATOMIC_ACQUIRE, "agent");
            asm volatile("s_waitcnt vmcnt(0)" ::: "memory");
        }
    }
    __syncthreads();
}

#ifndef PROBE_PH
#define PROBE_PH -1
#define PROBE_N 0
#endif
namespace mk {
typedef unsigned short bf16;
typedef unsigned v4u __attribute__((ext_vector_type(4)));
typedef unsigned v2u __attribute__((ext_vector_type(2)));
typedef float f32x4 __attribute__((ext_vector_type(4)));
typedef short bf16x8 __attribute__((ext_vector_type(8)));
typedef __bf16 bf16x2 __attribute__((ext_vector_type(2)));

constexpr int NB = 8, SEQ = 2048, DM = 1024, T = NB * SEQ, NQKV = 3072;
constexpr float LN_EPS = 1e-5f;
constexpr float DN_ALPHA = 1.189207115002721f;
constexpr int NWAVES = 8, NTHR = 512;

constexpr size_t MiB = 1u << 20;
constexpr size_t WS_CTL = 0;
constexpr size_t CTL_ZERO_BYTES = 64 * 1024;
constexpr size_t WS_MODP = 1 * MiB;
constexpr size_t WS_MOD = 4 * MiB;
constexpr size_t WS_KMEAN = 4 * MiB + 256 * 1024;
constexpr size_t WS_WIN = 5 * MiB;
constexpr size_t WS_WOUT = 11 * MiB;
constexpr size_t WS_WQ = 13 * MiB;
constexpr size_t WS_U = 16 * MiB;
constexpr size_t WS_V = 48 * MiB;
constexpr size_t WS_H = 80 * MiB;
constexpr size_t WS_QKV = 112 * MiB;
constexpr size_t WS_ATT = 208 * MiB;
constexpr size_t WS_END = 256 * MiB;
constexpr int CW_BAR = 4096;
constexpr float PEER_USCALE = 32.f;

constexpr int RING_BYTES = 131072;
constexpr int MISC_OFF = RING_BYTES + 320;
constexpr int LDS_BYTES = 147456;

__device__ __forceinline__ unsigned f2bf(float f) { unsigned u = __float_as_uint(f); return (u + 0x7fffu + ((u >> 16) & 1u)) >> 16; }
__device__ __forceinline__ unsigned pk2(float lo, float hi) { return f2bf(lo) | (f2bf(hi) << 16); }
__device__ __forceinline__ float bflo(unsigned w) { return __uint_as_float(w << 16); }
__device__ __forceinline__ float bfhi(unsigned w) { return __uint_as_float(w & 0xffff0000u); }
__device__ __forceinline__ float dot2(unsigned a, unsigned b, float acc) { return __builtin_amdgcn_fdot2_f32_bf16(__builtin_bit_cast(bf16x2, a), __builtin_bit_cast(bf16x2, b), acc, false); }
__device__ __forceinline__ float wave_sum(float v) {
#pragma unroll
    for (int o = 1; o < 64; o <<= 1) v += __shfl_xor(v, o);
    return v;
}
__device__ __forceinline__ int t5_bucket(int d) {
    if (d < 16) return d;
    int b = 16;
    b += (d >= 22); b += (d >= 30); b += (d >= 40); b += (d >= 54); b += (d >= 73); b += (d >= 99); b += (d >= 134); b += (d >= 182);
    b += (d >= 246); b += (d >= 332); b += (d >= 450); b += (d >= 609); b += (d >= 825); b += (d >= 1117); b += (d >= 1513);
    return b;
}

struct Args {
    const float* in[17]; float* out; unsigned char* ws; int ph_lo, ph_hi, bar_idx, pad;
};

template <int MODE>
__device__ __forceinline__ void transpose_item(const float* W, int K, int N, bf16* WT, LAS float* scr, int item, int lane, const float* gna, const float* gnb) {
    const int nblk = N / 32, kb = item / nblk, nb = item % nblk, k0 = 64 * kb, n0 = 32 * nb;
    float cs = 1.f;
    if (MODE == 1) { if (n0 < 512 || (n0 >= 1536 && n0 < 2048)) cs = 0.125f; }
#pragma unroll 8
    for (int i = 0; i < 32; ++i) { const int kk = 2 * i + (lane >> 5); float v = W[(size_t)(k0 + kk) * N + n0 + (lane & 31)] * cs;
        if (MODE == 2) { const int k = k0 + kk; v *= (k < 512) ? gna[k] : gnb[k - 512]; }
        scr[kk * 33 + (lane & 31)] = v; }
    asm volatile("s_waitcnt lgkmcnt(0)" ::: "memory");
    const int c = lane & 7;
#pragma unroll
    for (int j = 0; j < 4; ++j) { const int n = (lane >> 3) + 8 * j; const LAS float* s = scr + (8 * c) * 33 + n;
        v4u o; o.x = pk2(s[0 * 33], s[1 * 33]); o.y = pk2(s[2 * 33], s[3 * 33]); o.z = pk2(s[4 * 33], s[5 * 33]); o.w = pk2(s[6 * 33], s[7 * 33]);
        *(v4u*)(WT + (size_t)(n0 + n) * K + k0 + 8 * c) = o; }
    asm volatile("s_waitcnt lgkmcnt(0)" ::: "memory");
}

__device__ __forceinline__ void p0_prologue(const Args& a, LAS unsigned char* lds, int G, int tid, int lane, int wave) {
    unsigned char* ws = a.ws;
    {
        const float* c = a.in[1]; const float* w_ada = a.in[2]; float* modp = (float*)(ws + WS_MODP);
        LAS float* sc = (LAS float*)lds;
        for (int item = blockIdx.x; item < 192; item += G) {
            const int ks = item / 12, cb = item % 12;
            { const int b = tid >> 6, i = tid & 63; const float v = c[b * DM + ks * 64 + i]; sc[b * 64 + i] = v / (1.f + __expf(-v)); }
            __syncthreads();
            const int col = cb * 512 + tid;
            float acc[8];
#pragma unroll
            for (int b = 0; b < 8; ++b) acc[b] = 0.f;
#pragma unroll 8
            for (int i = 0; i < 64; ++i) { const float w = w_ada[(size_t)(ks * 64 + i) * 6144 + col];
#pragma unroll
                for (int b = 0; b < 8; ++b) acc[b] += sc[b * 64 + i] * w; }
#pragma unroll
            for (int b = 0; b < 8; ++b) modp[(size_t)(ks * 8 + b) * 6144 + col] = acc[b];
            __syncthreads();
        }
    }
    {
        LAS float* scr = (LAS float*)(lds + wave * 16384);
        const int gw = blockIdx.x * NWAVES + wave, NGW = G * NWAVES;
        constexpr int I_IN = 16 * 96, I_O = 16 * 32, I_Q = 16 * 32;
        for (int it = gw; it < I_IN + I_O + I_Q; it += NGW) {
            int r = it;
            if (r < I_IN) { transpose_item<1>(a.in[4], DM, NQKV, (bf16*)(ws + WS_WIN), scr, r, lane, nullptr, nullptr); continue; } r -= I_IN;
            if (r < I_O) { transpose_item<2>(a.in[8], DM, DM, (bf16*)(ws + WS_WOUT), scr, r, lane, a.in[6], a.in[7]); continue; } r -= I_O;
            transpose_item<0>(a.in[11], DM, DM, (bf16*)(ws + WS_WQ), scr, r, lane, nullptr, nullptr);
        }
    }
    {
        const size_t nthr = (size_t)G * NTHR, gt = (size_t)blockIdx.x * NTHR + tid;
        const size_t per = (size_t)16384 * 1024 / 16;
        for (size_t i = gt; i < 2 * per; i += nthr) {
            const bool second = i >= per; const size_t j = second ? i - per : i; const float sc = second ? 1.f : PEER_USCALE;
            const f32x4* src = (const f32x4*)(second ? a.in[14] : a.in[13]) + 4 * j;
            v4u o;
#pragma unroll
            for (int q = 0; q < 4; ++q) { const f32x4 p = src[q]; int w = 0;
                w = __builtin_amdgcn_cvt_pk_fp8_f32(p.x * sc, p.y * sc, w, false); w = __builtin_amdgcn_cvt_pk_fp8_f32(p.z * sc, p.w * sc, w, true); o[q] = (unsigned)w; }
            ((v4u*)(ws + (second ? WS_V : WS_U)))[j] = o;
        }
        float* km = (float*)(ws + WS_KMEAN);
        for (size_t i = gt; i < 32768; i += nthr) km[i] = 0.f;
    }
}

__device__ __forceinline__ void p1_mod_h(const Args& a, LAS unsigned char* lds, int G, int tid, int lane, int wave) {
    unsigned char* ws = a.ws;
    const float* modp = (const float*)(ws + WS_MODP); const float* b_ada = a.in[3];
    float* mod = (float*)(ws + WS_MOD);
    for (int i = blockIdx.x * NTHR + tid; i < 8 * 6144; i += G * NTHR) {
        const int b = i / 6144, j = i % 6144; float s = b_ada[j];
#pragma unroll
        for (int ks = 0; ks < 16; ++ks) s += modp[(size_t)(ks * 8 + b) * 6144 + j];
        mod[i] = s;
    }
    LAS float* sm = (LAS float*)lds;
    const float* x = a.in[0]; bf16* H = (bf16*)(ws + WS_H);
    int curb = -1;
    for (int rb = blockIdx.x; rb < T / 64; rb += G) {
        const int b = rb >> 5;
        if (b != curb) {
            __syncthreads();
            for (int j = tid; j < 2048; j += NTHR) { float s = b_ada[j];
#pragma unroll
                for (int ks = 0; ks < 16; ++ks) s += modp[(size_t)(ks * 8 + b) * 6144 + j];
                sm[j] = s; }
            __syncthreads();
            curb = b;
        }
#pragma unroll 2
        for (int r = 0; r < 8; ++r) {
            const int row = rb * 64 + wave * 8 + r;
#pragma unroll
            for (int hf = 0; hf < 2; ++hf) {
                const int c0 = hf * 512 + 8 * lane;
                const f32x4 p = *(const f32x4*)(x + (size_t)row * DM + c0), q = *(const f32x4*)(x + (size_t)row * DM + c0 + 4);
                const f32x4 s0 = *(const LAS f32x4*)(sm + 1024 + c0), s1 = *(const LAS f32x4*)(sm + 1024 + c0 + 4);
                const f32x4 h0 = *(const LAS f32x4*)(sm + c0), h1 = *(const LAS f32x4*)(sm + c0 + 4);
                v4u o; o.x = pk2(p.x * (1.f + s0.x) + h0.x, p.y * (1.f + s0.y) + h0.y); o.y = pk2(p.z * (1.f + s0.z) + h0.z, p.w * (1.f + s0.w) + h0.w);
                o.z = pk2(q.x * (1.f + s1.x) + h1.x, q.y * (1.f + s1.y) + h1.y); o.w = pk2(q.z * (1.f + s1.z) + h1.z, q.w * (1.f + s1.w) + h1.w);
                *(v4u*)(H + (size_t)row * DM + c0) = o;
            }
        }
    }
}

__device__ __forceinline__ void p3_kmean(const Args& a, LAS unsigned char* lds, int G, int tid) {
    unsigned char* ws = a.ws; const bf16* QKV = (const bf16*)(ws + WS_QKV); float* km = (float*)(ws + WS_KMEAN);
    LAS float* red = (LAS float*)lds;
    for (int item = blockIdx.x; item < 256; item += G) {
        const int b = item >> 5, n = (item >> 2) & 7, rq = item & 3;
        const int cp = tid & 255, rg = tid >> 8;
        const size_t row0 = (size_t)b * SEQ + n * 256 + rq * 64 + rg * 32;
        float s0 = 0.f, s1 = 0.f;
#pragma unroll 8
        for (int r = 0; r < 32; ++r) { const unsigned w = *(const unsigned*)(QKV + (row0 + r) * NQKV + 512 + 2 * cp); s0 += bflo(w); s1 += bfhi(w); }
        if (rg == 1) { red[2 * cp] = s0; red[2 * cp + 1] = s1; }
        __syncthreads();
        if (rg == 0) { s0 += red[2 * cp]; s1 += red[2 * cp + 1]; const int c = 2 * cp, h = c >> 6, d = c & 63;
            float* dst = km + ((b * 8 + h) * 8 + n) * 64 + d;
            atomicAdd(dst, s0 * (1.f / 256.f)); atomicAdd(dst + 1, s1 * (1.f / 256.f)); }
        __syncthreads();
    }
}

__device__ __forceinline__ void unpack8(const v4u w, float (&v)[8]) { v[0] = bflo(w.x); v[1] = bfhi(w.x); v[2] = bflo(w.y); v[3] = bfhi(w.y); v[4] = bflo(w.z); v[5] = bfhi(w.z); v[6] = bflo(w.w); v[7] = bfhi(w.w); }
typedef short v4i16 __attribute__((ext_vector_type(4)));
constexpr float LOG2E = 1.4426950408889634f;
constexpr int AT_K = 0, AT_V = 18432, AT_LUT = 36864, AT_GATE = 45056, AT_SEL = 49152, AT_ANY = 49664, AT_ROW = 144;
constexpr size_t WS_YA = WS_ATT, WS_OB0 = WS_ATT + 16 * MiB, WS_OB1 = WS_ATT + 32 * MiB, WS_OB2 = WS_H, WS_LSE = WS_H + 16 * MiB;

__device__ __forceinline__ unsigned pkbf(float lo, float hi) { bf16x2 t; t.x = (__bf16)lo; t.y = (__bf16)hi; return __builtin_bit_cast(unsigned, t); }
__device__ __forceinline__ bf16x8 mk8(v4i16 a, v4i16 b) { return __builtin_shufflevector(a, b, 0, 1, 2, 3, 4, 5, 6, 7); }
__device__ __forceinline__ v4i16 tr16(const LAS unsigned char* p) { return __builtin_amdgcn_ds_read_tr16_b64_v4i16((LAS v4i16*)p); }

struct AttnState { bf16x8 qf[2]; f32x4 ot[4]; float m, l; };

__device__ __forceinline__ void attn_sub(AttnState& st, const LAS unsigned char* lds, int sub, int lane, int qidx, int k0, int dmax, bool lanesel) {
    const int q15 = lane & 15, g = lane >> 4;
    const LAS unsigned char* kb = lds + AT_K + (sub * 32 + q15) * AT_ROW + g * 16;
    f32x4 s0 = {0.f, 0.f, 0.f, 0.f}, s1 = {0.f, 0.f, 0.f, 0.f};
#pragma unroll
    for (int ks = 0; ks < 2; ++ks) {
        const bf16x8 a0 = *(const LAS bf16x8*)(kb + ks * 64), a1 = *(const LAS bf16x8*)(kb + 16 * AT_ROW + ks * 64);
        s0 = __builtin_amdgcn_mfma_f32_16x16x32_bf16(a0, st.qf[ks], s0, 0, 0, 0);
        s1 = __builtin_amdgcn_mfma_f32_16x16x32_bf16(a1, st.qf[ks], s1, 0, 0, 0);
    }
    const LAS float* lut = (const LAS float*)(lds + AT_LUT);
    float sc[8]; const int dbase = qidx - (k0 + sub * 32 + 4 * g);
#pragma unroll
    for (int r = 0; r < 8; ++r) {
        const int d = dbase - (r & 3) - (r >> 2) * 16;
        const bool ok = lanesel && d >= 0 && d <= dmax;
        const int dc = d < 0 ? 0 : (d > dmax ? dmax : d);
        const float v = ((r < 4) ? s0[r & 3] : s1[r & 3]) * LOG2E + lut[dc];
        sc[r] = ok ? v : -INFINITY;
    }
    float mx = fmaxf(fmaxf(fmaxf(sc[0], sc[1]), fmaxf(sc[2], sc[3])), fmaxf(fmaxf(sc[4], sc[5]), fmaxf(sc[6], sc[7])));
    mx = fmaxf(mx, __shfl_xor(mx, 16)); mx = fmaxf(mx, __shfl_xor(mx, 32));
    const float mn = fmaxf(st.m, mx), mu = (mn == -INFINITY) ? 0.f : mn;
    const float alpha = __builtin_amdgcn_exp2f(st.m - mu);
    float p[8], ps = 0.f;
#pragma unroll
    for (int r = 0; r < 8; ++r) { p[r] = __builtin_amdgcn_exp2f(sc[r] - mu); ps += p[r]; }
    st.l = st.l * alpha + ps; st.m = mn;
    if (!__all(alpha == 1.f)) {
#pragma unroll
        for (int n = 0; n < 4; ++n) st.ot[n] *= alpha;
    }
    v4u pw; pw.x = pkbf(p[0], p[1]); pw.y = pkbf(p[2], p[3]); pw.z = pkbf(p[4], p[5]); pw.w = pkbf(p[6], p[7]);
    const bf16x8 pb = __builtin_bit_cast(bf16x8, pw);
    const LAS unsigned char* vb = lds + AT_V + (sub * 32 + 4 * g + (q15 >> 2)) * AT_ROW + (q15 & 3) * 8;
#pragma unroll
    for (int n = 0; n < 4; ++n) {
        const v4i16 r1 = tr16(vb + n * 32), r2 = tr16(vb + 16 * AT_ROW + n * 32);
        st.ot[n] = __builtin_amdgcn_mfma_f32_16x16x32_bf16(mk8(r1, r2), pb, st.ot[n], 0, 0, 0);
    }
}

struct ChunkRegs { v4u k0, k1, v0, v1; };
__device__ __forceinline__ void chunk_fetch(ChunkRegs& c, const bf16* kbase  , int kstride_tok, int tid) {
    const int r0 = tid >> 3, cc = tid & 7;
    const bf16* p0 = kbase + (size_t)(r0 * kstride_tok) * NQKV + cc * 8; const bf16* p1 = kbase + (size_t)((r0 + 64) * kstride_tok) * NQKV + cc * 8;
    c.k0 = *(const v4u*)p0; c.k1 = *(const v4u*)p1; c.v0 = *(const v4u*)(p0 + 512); c.v1 = *(const v4u*)(p1 + 512);
}
__device__ __forceinline__ void chunk_store(const ChunkRegs& c, LAS unsigned char* lds, int tid) {
    const int r0 = tid >> 3, cc = tid & 7;
    *(LAS v4u*)(lds + AT_K + r0 * AT_ROW + cc * 16) = c.k0; *(LAS v4u*)(lds + AT_K + (r0 + 64) * AT_ROW + cc * 16) = c.k1;
    *(LAS v4u*)(lds + AT_V + r0 * AT_ROW + cc * 16) = c.v0; *(LAS v4u*)(lds + AT_V + (r0 + 64) * AT_ROW + cc * 16) = c.v1;
}
__device__ __forceinline__ void attn_init(AttnState& st, const bf16* qrow  , int lane) {
    const int g = lane >> 4;
    st.qf[0] = *(const bf16x8*)(qrow + 8 * g); st.qf[1] = *(const bf16x8*)(qrow + 32 + 8 * g);
#pragma unroll
    for (int n = 0; n < 4; ++n) st.ot[n] = (f32x4){0.f, 0.f, 0.f, 0.f};
    st.m = -INFINITY; st.l = 0.f;
}
__device__ __forceinline__ float attn_finish(AttnState& st, bf16* orow  , int lane) {
    float l = st.l; l += __shfl_xor(l, 16); l += __shfl_xor(l, 32);
    const float inv = 1.f / l; const int g = lane >> 4;
#pragma unroll
    for (int n = 0; n < 4; ++n) { v2u w; w.x = pkbf(st.ot[n][0] * inv, st.ot[n][1] * inv); w.y = pkbf(st.ot[n][2] * inv, st.ot[n][3] * inv);
        *(v2u*)(orow + 16 * n + 4 * g) = w; }
    return l;
}

__device__ __forceinline__ void moba_item(const Args& a, LAS unsigned char* lds, int item, int tid, int lane, int wave) {
    unsigned char* ws = a.ws; const bf16* QKV = (const bf16*)(ws + WS_QKV);
    const int qblk = 7 - (item >> 7), idx = item & 127, bh = idx >> 1, b = bh >> 3, h = bh & 7, qt = 2 * qblk + (idx & 1);
    const size_t tokb = (size_t)b * SEQ;
    LAS float* lut = (LAS float*)(lds + AT_LUT); LAS float* gates = (LAS float*)(lds + AT_GATE); LAS unsigned* selm = (LAS unsigned*)(lds + AT_SEL); LAS unsigned* anyw = (LAS unsigned*)(lds + AT_ANY);
    __syncthreads();
    for (int d = tid; d < 2048; d += NTHR) lut[d] = a.in[5][h * 32 + t5_bucket(d)] * LOG2E;
    if (tid == 0) *anyw = 0u;
    unsigned anysel;
    if (qblk > 3) {
        {
            const int qi = tid & 127, gi = tid >> 7;
            const bf16* qp = QKV + (tokb + qt * 128 + qi) * NQKV + h * 64;
            float ga = 0.f, gb = 0.f; const float* kma = (const float*)(ws + WS_KMEAN) + ((b * 8 + h) * 8 + gi) * 64; const float* kmb = kma + 4 * 64;
#pragma unroll
            for (int i = 0; i < 8; ++i) { const v4u w = *(const v4u*)(qp + 8 * i); float qv[8]; unpack8(w, qv);
#pragma unroll
                for (int j = 0; j < 8; ++j) { ga += qv[j] * kma[8 * i + j]; gb += qv[j] * kmb[8 * i + j]; } }
            gates[qi * 8 + gi] = ga; gates[qi * 8 + gi + 4] = gb;
        }
        __syncthreads();
        if (tid < 128) {
            float gv[8];
#pragma unroll
            for (int n = 0; n < 8; ++n) gv[n] = (n < qblk) ? gates[tid * 8 + n] : -INFINITY;
            unsigned sel = 0;
#pragma unroll
            for (int r = 0; r < 3; ++r) { float best = -INFINITY; int bi = 0;
#pragma unroll
                for (int n = 0; n < 8; ++n) { const bool take = !((sel >> n) & 1u) && (gv[n] > best); best = take ? gv[n] : best; bi = take ? n : bi; }
                sel |= 1u << bi; }
            selm[tid] = sel; atomicOr((unsigned*)anyw, sel);
        }
        __syncthreads();
        anysel = *anyw;
    } else { anysel = (1u << qblk) - 1u; __syncthreads(); }
    const unsigned mysel = (qblk > 3) ? selm[wave * 16 + (lane & 15)] : anysel;
    unsigned cm = 0;
    for (int n = 0; n < qblk; ++n) if ((anysel >> n) & 1u) cm |= 3u << (2 * n);
    cm |= 1u << (2 * qblk); if (qt & 1) cm |= 2u << (2 * qblk);
    const int qpos = qt * 128 + wave * 16 + (lane & 15), wq_hi = qt * 128 + wave * 16 + 15;
    AttnState st; attn_init(st, QKV + (tokb + qpos) * NQKV + h * 64, lane);
    ChunkRegs cr; const bf16* kcol = QKV + tokb * NQKV + 512 + h * 64;
    { const int c0 = __builtin_ctz(cm); chunk_fetch(cr, kcol + (size_t)(c0 * 128) * NQKV, 1, tid); }
    while (cm) {
        const int cur = __builtin_ctz(cm); cm &= cm - 1u;
        __syncthreads();
        chunk_store(cr, lds, tid);
        __syncthreads();
        if (cm) { const int nx = __builtin_ctz(cm); chunk_fetch(cr, kcol + (size_t)(nx * 128) * NQKV, 1, tid); }
        const int n = cur >> 1, k0 = cur * 128; const bool own = (n == qblk);
        const bool lsel = own || ((mysel >> n) & 1u);
        if (own || __any(lsel)) {
#pragma unroll 1
            for (int sub = 0; sub < 4; ++sub) {
                if (k0 + sub * 32 > wq_hi) break;
                attn_sub(st, lds, sub, lane, qpos, k0, 2047, lsel);
            }
        }
    }
    attn_finish(st, (bf16*)(ws + WS_YA) + (tokb + qpos) * 512 + h * 64, lane);
}

__device__ __forceinline__ void dil_item(const Args& a, LAS unsigned char* lds, int item, int tid, int lane, int wave) {
    unsigned char* ws = a.ws; const bf16* QKV = (const bf16*)(ws + WS_QKV);
    const int grp = item >> 4, sub16 = item & 15, br = grp % 3, bh = grp / 3, b = bh >> 3, h = bh & 7;
    const int dil = (br == 0) ? 1 : (br == 1 ? 4 : 16);
    const int r = (br == 0) ? 0 : (br == 1 ? (sub16 >> 2) : sub16), j = (br == 0) ? sub16 : (br == 1 ? (sub16 & 3) : 0);
    const size_t tokb = (size_t)b * SEQ;
    LAS float* lut = (LAS float*)(lds + AT_LUT);
    __syncthreads();
    for (int d = tid; d <= 128; d += NTHR) lut[d] = a.in[5][(8 + h) * 32 + t5_bucket(d * dil)] * LOG2E;
    const int lq = 128 * j + wave * 16 + (lane & 15);
    const size_t qtok = tokb + (size_t)lq * dil + r;
    AttnState st; attn_init(st, QKV + qtok * NQKV + 1536 + h * 64, lane);
    ChunkRegs cr; const bf16* kcol = QKV + (tokb + r) * NQKV + 2048 + h * 64;
    const int c_first = (j > 0) ? 0 : 1;
    chunk_fetch(cr, kcol + (size_t)((128 * (j - 1 + c_first)) * dil) * NQKV, dil, tid);
#pragma unroll 1
    for (int c = c_first; c < 2; ++c) {
        __syncthreads();
        chunk_store(cr, lds, tid);
        __syncthreads();
        if (c == 0) chunk_fetch(cr, kcol + (size_t)((128 * j) * dil) * NQKV, dil, tid);
        const int k0 = 128 * (j - 1 + c), wh = wave >> 1;
        const int s_lo = (c == 0) ? wh : 0, s_hi = (c == 0) ? 3 : wh;
#pragma unroll 1
        for (int sub = s_lo; sub <= s_hi; ++sub) attn_sub(st, lds, sub, lane, lq, k0, 128, true);
    }
    bf16* ob = (bf16*)(ws + (br == 0 ? WS_OB0 : (br == 1 ? WS_OB1 : WS_OB2)));
    const float l = attn_finish(st, ob + qtok * 512 + h * 64, lane);
    if ((lane >> 4) == 0) ((float*)(ws + WS_LSE))[((size_t)br * T + qtok) * 8 + h] = st.m + __builtin_amdgcn_logf(l);
}

__device__ __forceinline__ void p4_attn(const Args& a, LAS unsigned char* lds, int G, int tid, int lane, int wave) {
    for (int v = blockIdx.x; v < 256; v += G) {
        moba_item(a, lds, v, tid, lane, wave);
        moba_item(a, lds, 256 + v, tid, lane, wave);
        moba_item(a, lds, 767 - v, tid, lane, wave);
        moba_item(a, lds, 1023 - v, tid, lane, wave);
#pragma unroll 1
        for (int i = 0; i < 12; ++i) dil_item(a, lds, v * 12 + i, tid, lane, wave);
    }
}

__device__ __forceinline__ void p5_combine_rms(const Args& a, int G, int lane, int wave) {
    unsigned char* ws = a.ws; const bf16* YA = (const bf16*)(ws + WS_YA);
    const bf16* OB0 = (const bf16*)(ws + WS_OB0); const bf16* OB1 = (const bf16*)(ws + WS_OB1); const bf16* OB2 = (const bf16*)(ws + WS_OB2);
    const float* LSE = (const float*)(ws + WS_LSE); bf16* A2 = (bf16*)a.out;
    for (int row = blockIdx.x * NWAVES + wave; row < T; row += G * NWAVES) {
        float v[8], o0[8], o1[8], o2[8];
        unpack8(*(const v4u*)(YA + (size_t)row * 512 + 8 * lane), v);
        unpack8(*(const v4u*)(OB0 + (size_t)row * 512 + 8 * lane), o0); unpack8(*(const v4u*)(OB1 + (size_t)row * 512 + 8 * lane), o1); unpack8(*(const v4u*)(OB2 + (size_t)row * 512 + 8 * lane), o2);
        const int h = lane >> 3;
        const float l0 = LSE[((size_t)0 * T + row) * 8 + h], l1 = LSE[((size_t)1 * T + row) * 8 + h], l2 = LSE[((size_t)2 * T + row) * 8 + h];
        const float mx = fmaxf(l0, fmaxf(l1, l2));
        float w0 = __builtin_amdgcn_exp2f(l0 - mx), w1 = __builtin_amdgcn_exp2f(l1 - mx), w2 = __builtin_amdgcn_exp2f(l2 - mx);
        const float inv = 1.f / (w0 + w1 + w2); w0 *= inv; w1 *= inv; w2 *= inv;
        float ssa = 0.f, ssb = 0.f;
#pragma unroll
        for (int j = 0; j < 8; ++j) { o0[j] = w0 * o0[j] + w1 * o1[j] + w2 * o2[j]; ssa += v[j] * v[j]; ssb += o0[j] * o0[j]; }
        ssa = wave_sum(ssa); ssb = wave_sum(ssb);
        const float ra = rsqrtf(ssa * (1.f / 512.f) + LN_EPS), rb = rsqrtf(ssb * (1.f / 512.f) + LN_EPS);
        v4u o; o.x = pkbf(v[0] * ra, v[1] * ra); o.y = pkbf(v[2] * ra, v[3] * ra); o.z = pkbf(v[4] * ra, v[5] * ra); o.w = pkbf(v[6] * ra, v[7] * ra);
        *(v4u*)(A2 + (size_t)row * DM + 8 * lane) = o;
        o.x = pkbf(o0[0] * rb, o0[1] * rb); o.y = pkbf(o0[2] * rb, o0[3] * rb); o.z = pkbf(o0[4] * rb, o0[5] * rb); o.w = pkbf(o0[6] * rb, o0[7] * rb);
        *(v4u*)(A2 + (size_t)row * DM + 512 + 8 * lane) = o;
    }
}
__device__ __forceinline__ void load16(const float* p, int lane, float (&v)[16]) {
#pragma unroll
    for (int q = 0; q < 4; ++q) { const f32x4 t = *(const f32x4*)(p + (q >> 1) * 512 + 8 * lane + (q & 1) * 4); v[4 * q] = t.x; v[4 * q + 1] = t.y; v[4 * q + 2] = t.z; v[4 * q + 3] = t.w; }
}
__device__ __forceinline__ void store16(float* p, int lane, const float (&v)[16]) {
#pragma unroll
    for (int q = 0; q < 4; ++q) { f32x4 t; t.x = v[4 * q]; t.y = v[4 * q + 1]; t.z = v[4 * q + 2]; t.w = v[4 * q + 3]; *(f32x4*)(p + (q >> 1) * 512 + 8 * lane + (q & 1) * 4) = t; }
}
__device__ __forceinline__ void layer_norm16(float (&z)[16], const float* g, const float* bta, int lane) {
    float s = 0.f;
#pragma unroll
    for (int j = 0; j < 16; ++j) s += z[j];
    const float mu = wave_sum(s) * (1.f / DM); float q = 0.f;
#pragma unroll
    for (int j = 0; j < 16; ++j) { z[j] -= mu; q += z[j] * z[j]; }
    const float rs = rsqrtf(wave_sum(q) * (1.f / DM) + LN_EPS);
    float gg[16], bb[16]; load16(g, lane, gg); load16(bta, lane, bb);
#pragma unroll
    for (int j = 0; j < 16; ++j) z[j] = z[j] * rs * gg[j] + bb[j];
}

__device__ __forceinline__ void p7_ln1(const Args& a, int G, int lane, int wave) {
    unsigned char* ws = a.ws; const float* x = a.in[0]; const float* Y = (const float*)(ws + WS_QKV); const float* mod = (const float*)(ws + WS_MOD);
    float* x1 = a.out; bf16* H2 = (bf16*)(ws + WS_H);
    for (int row = blockIdx.x * NWAVES + wave; row < T; row += G * NWAVES) {
        const int b = row >> 11; float z[16], y[16], t[16];
        load16(x + (size_t)row * DM, lane, z); load16(Y + (size_t)row * DM, lane, y); load16(mod + b * 6144 + 2048, lane, t);
#pragma unroll
        for (int j = 0; j < 16; ++j) z[j] = DN_ALPHA * z[j] + (1.f + t[j]) * y[j];
        layer_norm16(z, a.in[9], a.in[10], lane);
        store16(x1 + (size_t)row * DM, lane, z);
        load16(mod + b * 6144 + 4096, lane, y); load16(mod + b * 6144 + 3072, lane, t);
#pragma unroll
        for (int j = 0; j < 16; ++j) z[j] = z[j] * (1.f + y[j]) + t[j];
        v4u o0, o1; o0.x = pk2(z[0], z[1]); o0.y = pk2(z[2], z[3]); o0.z = pk2(z[4], z[5]); o0.w = pk2(z[6], z[7]);
        o1.x = pk2(z[8], z[9]); o1.y = pk2(z[10], z[11]); o1.z = pk2(z[12], z[13]); o1.w = pk2(z[14], z[15]);
        *(v4u*)(H2 + (size_t)row * DM + 8 * lane) = o0; *(v4u*)(H2 + (size_t)row * DM + 512 + 8 * lane) = o1;
    }
}

__device__ __forceinline__ unsigned mono(float s) { const unsigned u = __float_as_uint(s); return u ^ ((unsigned)((int)u >> 31) | 0x80000000u); }
__device__ __forceinline__ float unmono(unsigned k) { return __uint_as_float((k & 0x80000000u) ? (k ^ 0x80000000u) : ~k); }
__device__ __forceinline__ void ins16(unsigned (&t)[16], unsigned x) {
#pragma unroll
    for (int j = 0; j < 16; ++j) { const unsigned hi = t[j] > x ? t[j] : x; x = t[j] > x ? x : t[j]; t[j] = hi; }
}
__device__ __forceinline__ unsigned lookup8(unsigned long long lo, unsigned long long hi, int idx) {
    const unsigned long long w = (idx & 8) ? hi : lo;
    return (unsigned)(w >> ((idx & 7) * 8)) & 0xffu;
}
__device__ __forceinline__ void p9_topk(const Args& a, LAS unsigned char* lds, int G, int tid) {
    unsigned char* ws = a.ws; const float* QP = (const float*)(ws + WS_QKV); const float* sub_keys = a.in[12];
    int* elist = (int*)(ws + WS_ATT); float* glist = (float*)(ws + WS_ATT + 8 * MiB);
    LAS f32x4* K4 = (LAS f32x4*)lds;
    for (int i = tid; i < 2 * 128 * 16; i += NTHR) K4[i] = ((const f32x4*)sub_keys)[i];
    __syncthreads();
    for (int p = blockIdx.x * NTHR + tid; p < T * 8; p += G * NTHR) {
        const int tok = p >> 3, head = p & 7;
        float v1[16], v2[16]; unsigned long long i1lo = 0, i1hi = 0, i2lo = 0, i2hi = 0;
#pragma unroll
        for (int hf = 0; hf < 2; ++hf) {
            f32x4 q[16];
#pragma unroll
            for (int d = 0; d < 16; ++d) q[d] = *(const f32x4*)(QP + (size_t)tok * DM + head * 128 + hf * 64 + 4 * d);
            unsigned top[16];
#pragma unroll
            for (int j = 0; j < 16; ++j) top[j] = 0u;
#pragma unroll 1
            for (int n = 0; n < 128; ++n) {
                const LAS f32x4* kr = K4 + (hf * 128 + n) * 16;
                float s0 = 0.f, s1 = 0.f, s2 = 0.f, s3 = 0.f;
#pragma unroll
                for (int d = 0; d < 16; ++d) { const f32x4 k = kr[d]; s0 += q[d].x * k.x; s1 += q[d].y * k.y; s2 += q[d].z * k.z; s3 += q[d].w * k.w; }
                const float s = (s0 + s1) + (s2 + s3);
                ins16(top, (mono(s) & ~127u) | (unsigned)(127 - n));
            }
#pragma unroll
            for (int j = 0; j < 16; ++j) { const float v = unmono(top[j] & ~127u); const unsigned ix = 127u - (top[j] & 127u);
                const unsigned long long sh = (unsigned long long)ix << ((j & 7) * 8);
                if (hf == 0) { v1[j] = v; if (j < 8) i1lo |= sh; else i1hi |= sh; } else { v2[j] = v; if (j < 8) i2lo |= sh; else i2hi |= sh; } }
        }
        unsigned top[16];
#pragma unroll
        for (int j = 0; j < 16; ++j) top[j] = 0u;
#pragma unroll
        for (int aa = 0; aa < 16; ++aa)
#pragma unroll
            for (int bb = 0; bb < 16; ++bb)
                if ((aa + 1) * (bb + 1) <= 16) ins16(top, (mono(v1[aa] + v2[bb]) & ~255u) | (unsigned)(255 - (aa * 16 + bb)));
        float vals[16]; int ex[16]; float sum = 0.f;
        const float vmax = unmono(top[0] & ~255u);
#pragma unroll
        for (int r = 0; r < 16; ++r) { const int pos = 255 - (int)(top[r] & 255u);
            ex[r] = (int)(lookup8(i1lo, i1hi, pos >> 4) * 128u + lookup8(i2lo, i2hi, pos & 15));
            vals[r] = __expf(unmono(top[r] & ~255u) - vmax); sum += vals[r]; }
        const float inv = 1.f / sum;
#pragma unroll
        for (int r = 0; r < 4; ++r) {
            *(int4*)(elist + (size_t)p * 16 + 4 * r) = make_int4(ex[4 * r], ex[4 * r + 1], ex[4 * r + 2], ex[4 * r + 3]);
            f32x4 g; g.x = vals[4 * r] * inv; g.y = vals[4 * r + 1] * inv; g.z = vals[4 * r + 2] * inv; g.w = vals[4 * r + 3] * inv;
            *(f32x4*)(glist + (size_t)p * 16 + 4 * r) = g;
        }
    }
}

typedef float f32x2 __attribute__((ext_vector_type(2)));
template <int CTRL> __device__ __forceinline__ float dppf(float v) { return __builtin_bit_cast(float, __builtin_amdgcn_update_dpp(0, __builtin_bit_cast(int, v), CTRL, 0xf, 0xf, false)); }
__device__ __forceinline__ float wave_total(float v) {
    v += dppf<0xB1>(v); v += dppf<0x4E>(v); v += dppf<0x141>(v); v += dppf<0x140>(v);
    const int iv = __builtin_bit_cast(int, v);
    return (__builtin_bit_cast(float, __builtin_amdgcn_readlane(iv, 0)) + __builtin_bit_cast(float, __builtin_amdgcn_readlane(iv, 16)))
         + (__builtin_bit_cast(float, __builtin_amdgcn_readlane(iv, 32)) + __builtin_bit_cast(float, __builtin_amdgcn_readlane(iv, 48)));
}
__device__ __forceinline__ float gelu1(float v) {
    const float av = fabsf(v), t = __builtin_amdgcn_rcpf(av * 0.2316418882f + 1.0f);
    float q = t * 0.5307027145f + (-0.7265760135f); q = q * t + 0.7107068705f; q = q * t + (-0.142248368f); q = q * t + 0.127414796f; q = q * t;
    const float e = __builtin_amdgcn_exp2f((v * v) * (-0.72134752044f)), m = v * (q * e);
    return v < 0.f ? m : v - m;
}
__device__ __forceinline__ void peer_slice(const float (&x)[16], float (&f)[16], int e0, int e1, float g0, float g1, int s,
                                           const unsigned char* U8, const unsigned char* V8, int lane) {
    unsigned long long m0 = __ballot((e0 >> 10) == s), m1 = __ballot((e1 >> 10) == s);
    while (m0 | m1) {
        int ee[4]; float gg[4];
#pragma unroll
        for (int k = 0; k < 4; ++k) {
            if (m0) { const int ix = __builtin_ctzll(m0); m0 &= m0 - 1; ee[k] = __builtin_amdgcn_readlane(e0, ix); gg[k] = __builtin_bit_cast(float, __builtin_amdgcn_readlane(__builtin_bit_cast(int, g0), ix)); }
            else if (m1) { const int ix = __builtin_ctzll(m1); m1 &= m1 - 1; ee[k] = __builtin_amdgcn_readlane(e1, ix); gg[k] = __builtin_bit_cast(float, __builtin_amdgcn_readlane(__builtin_bit_cast(int, g1), ix)); }
            else { ee[k] = ee[0]; gg[k] = 0.f; }
        }
        v4u ur[4], vr[4];
#pragma unroll
        for (int k = 0; k < 4; ++k) { ur[k] = *(const v4u*)(U8 + (size_t)ee[k] * 1024 + 16 * lane); vr[k] = *(const v4u*)(V8 + (size_t)ee[k] * 1024 + 16 * lane); }
        float act[4];
#pragma unroll
        for (int k = 0; k < 4; ++k) {
            f32x2 acc = {0.f, 0.f};
#pragma unroll
            for (int q = 0; q < 4; ++q) {
                const f32x2 lo = __builtin_amdgcn_cvt_pk_f32_fp8((int)ur[k][q], false), hi = __builtin_amdgcn_cvt_pk_f32_fp8((int)ur[k][q], true);
                acc += lo * (f32x2){x[4 * q], x[4 * q + 1]}; acc += hi * (f32x2){x[4 * q + 2], x[4 * q + 3]};
            }
            act[k] = acc.x + acc.y;
            __builtin_amdgcn_sched_barrier(0);
        }
#pragma unroll
        for (int k = 0; k < 4; ++k) act[k] = gelu1(wave_total(act[k]) * (1.f / PEER_USCALE)) * gg[k];
#pragma unroll
        for (int k = 0; k < 4; ++k) {
#pragma unroll
            for (int q = 0; q < 4; ++q) {
                const f32x2 lo = __builtin_amdgcn_cvt_pk_f32_fp8((int)vr[k][q], false), hi = __builtin_amdgcn_cvt_pk_f32_fp8((int)vr[k][q], true);
                f[4 * q] += act[k] * lo.x; f[4 * q + 1] += act[k] * lo.y; f[4 * q + 2] += act[k] * hi.x; f[4 * q + 3] += act[k] * hi.y;
            }
            __builtin_amdgcn_sched_barrier(0);
        }
    }
}
__device__ __forceinline__ void ld16c(const float* p, float (&v)[16]) {
#pragma unroll
    for (int q = 0; q < 4; ++q) { const f32x4 t = ((const f32x4*)p)[q]; v[4 * q] = t.x; v[4 * q + 1] = t.y; v[4 * q + 2] = t.z; v[4 * q + 3] = t.w; }
}
__device__ __forceinline__ void p10_peer(const Args& a, int G, int lane, int wave) {
    unsigned char* ws = a.ws; const unsigned char* U8 = ws + WS_U; const unsigned char* V8 = ws + WS_V;
    const int* elist = (const int*)(ws + WS_ATT); const float* glist = (const float*)(ws + WS_ATT + 8 * MiB);
    const float* mod = (const float*)(ws + WS_MOD); float* out = a.out;
    const int NGW = G * NWAVES;
    for (int grp = blockIdx.x * NWAVES + wave; grp < T / 4; grp += NGW) {
        const int tok0 = grp * 4, b = tok0 >> 11;
        float x[4][16], f[4][16]; int e0[4], e1[4]; float g0[4], g1[4];
        {
            float sc[16], sh[16]; ld16c(mod + b * 6144 + 4096 + 16 * lane, sc); ld16c(mod + b * 6144 + 3072 + 16 * lane, sh);
#pragma unroll
            for (int t = 0; t < 4; ++t) {
                ld16c(out + (size_t)(tok0 + t) * DM + 16 * lane, x[t]);
#pragma unroll
                for (int j = 0; j < 16; ++j) { x[t][j] = x[t][j] * (1.f + sc[j]) + sh[j]; f[t][j] = 0.f; }
                e0[t] = elist[(size_t)(tok0 + t) * 128 + lane]; e1[t] = elist[(size_t)(tok0 + t) * 128 + 64 + lane];
                g0[t] = glist[(size_t)(tok0 + t) * 128 + lane]; g1[t] = glist[(size_t)(tok0 + t) * 128 + 64 + lane];
            }
        }
#pragma unroll 1
        for (int s = 0; s < 16; ++s) {
#pragma unroll
            for (int t = 0; t < 4; ++t) peer_slice(x[t], f[t], e0[t], e1[t], g0[t], g1[t], s, U8, V8, lane);
        }
        float g2[16], lg[16], lb[16];
        ld16c(mod + b * 6144 + 5120 + 16 * lane, g2); ld16c(a.in[15] + 16 * lane, lg); ld16c(a.in[16] + 16 * lane, lb);
#pragma unroll
        for (int t = 0; t < 4; ++t) {
            float z[16]; ld16c(out + (size_t)(tok0 + t) * DM + 16 * lane, z);
            float sm = 0.f;
#pragma unroll
            for (int j = 0; j < 16; ++j) { z[j] = DN_ALPHA * z[j] + (1.f + g2[j]) * f[t][j]; sm += z[j]; }
            const float mu = wave_total(sm) * (1.f / DM); float q = 0.f;
#pragma unroll
            for (int j = 0; j < 16; ++j) { z[j] -= mu; q += z[j] * z[j]; }
            const float rs = rsqrtf(wave_total(q) * (1.f / DM) + LN_EPS);
#pragma unroll
            for (int q4 = 0; q4 < 4; ++q4) { f32x4 o; o.x = z[4 * q4] * rs * lg[4 * q4] + lb[4 * q4]; o.y = z[4 * q4 + 1] * rs * lg[4 * q4 + 1] + lb[4 * q4 + 1];
                o.z = z[4 * q4 + 2] * rs * lg[4 * q4 + 2] + lb[4 * q4 + 2]; o.w = z[4 * q4 + 3] * rs * lg[4 * q4 + 3] + lb[4 * q4 + 3];
                ((f32x4*)(out + (size_t)(tok0 + t) * DM + 16 * lane))[q4] = o; }
        }
    }
}

constexpr int N_PHASES = 11;
__global__ void __launch_bounds__(NTHR, 2) mega(Args args) {
    extern __shared__ __attribute__((aligned(16))) unsigned char lds_raw[];
    LAS unsigned char* lds = (LAS unsigned char*)lds_raw;
    const int tid = threadIdx.x, lane = tid & 63, wave = __builtin_amdgcn_readfirstlane(tid >> 6), G = gridDim.x;
    unsigned char* ws = args.ws;
    volatile LAS unsigned* MISC = (volatile LAS unsigned*)(lds + MISC_OFF);
    for (int u = tid; u < (LDS_BYTES - RING_BYTES) / 4; u += NTHR) ((LAS unsigned*)(lds + RING_BYTES))[u] = 0u;
    __syncthreads();
    const int lo = args.ph_lo, hi = args.ph_hi;
    unsigned* barw = (unsigned*)(ws + WS_CTL) + CW_BAR + args.bar_idx * XCD_BAR_WORDS;
    XcdBarrier bar; bar.bar = barw; bar.x = 0; bar.st = nullptr;
    if (hi - lo > 1) bar = xcd_barrier_post(barw, MISC + 8);
#define IN(k) (lo <= (k) && (k) < hi)
#define REPS(k) ((PROBE_PH == (k)) ? 1 + PROBE_N : 1)
#define REPBAR(k, rep) do { if ((rep) + 1 < REPS(k)) xcd_barrier(bar); } while (0)
#define SEAM(k) do { if (IN(k) && IN((k) + 1)) xcd_barrier(bar); } while (0)

    if (IN(0)) { for (int rep = 0; rep < REPS(0); ++rep) { p0_prologue(args, lds, G, tid, lane, wave); REPBAR(0, rep); } } SEAM(0);
    if (IN(1)) { for (int rep = 0; rep < REPS(1); ++rep) { p1_mod_h(args, lds, G, tid, lane, wave); REPBAR(1, rep); } } SEAM(1);
    if (IN(2)) { for (int rep = 0; rep < REPS(2); ++rep) {
        __syncthreads();
        pg8::Gemm g{(const pg8::bf16_t*)(ws + WS_H), (const pg8::bf16_t*)(ws + WS_WIN), T, NQKV, DM};
        pg8::StaticOrder S; S.init(T, NQKV, G, (int)blockIdx.x);
        pg8::EpiBf16<0> E{(pg8::bf16_t*)(ws + WS_QKV), NQKV, nullptr, 0, 0};
        pg8::gemm_phase<pg8::EpiBf16<0>, pg8::StaticOrder, false>(lds, g, S, E, nullptr);
        REPBAR(2, rep); }
    } SEAM(2);
    if (IN(3)) { p3_kmean(args, lds, G, tid); } SEAM(3);
    if (IN(4)) { for (int rep = 0; rep < REPS(4); ++rep) { p4_attn(args, lds, G, tid, lane, wave); REPBAR(4, rep); } } SEAM(4);
    if (IN(5)) { for (int rep = 0; rep < REPS(5); ++rep) { p5_combine_rms(args, G, lane, wave); REPBAR(5, rep); } } SEAM(5);
    if (IN(6)) { for (int rep = 0; rep < REPS(6); ++rep) {
        __syncthreads();
        pg8::Gemm g{(const pg8::bf16_t*)args.out, (const pg8::bf16_t*)(ws + WS_WOUT), T, DM, DM};
        pg8::StaticOrder S; S.init(T, DM, G, (int)blockIdx.x);
        pg8::EpiF32 E{(float*)(ws + WS_QKV), DM, nullptr};
        pg8::gemm_phase<pg8::EpiF32, pg8::StaticOrder, false>(lds, g, S, E, nullptr);
        REPBAR(6, rep); }
    } SEAM(6);
    if (IN(7)) { for (int rep = 0; rep < REPS(7); ++rep) { p7_ln1(args, G, lane, wave); REPBAR(7, rep); } } SEAM(7);
    if (IN(8)) { for (int rep = 0; rep < REPS(8); ++rep) {
        __syncthreads();
        pg8::Gemm g{(const pg8::bf16_t*)(ws + WS_H), (const pg8::bf16_t*)(ws + WS_WQ), T, DM, DM};
        pg8::StaticOrder S; S.init(T, DM, G, (int)blockIdx.x);
        pg8::EpiF32 E{(float*)(ws + WS_QKV), DM, nullptr};
        pg8::gemm_phase<pg8::EpiF32, pg8::StaticOrder, false>(lds, g, S, E, nullptr);
        REPBAR(8, rep); }
    } SEAM(8);
    if (IN(9)) { for (int rep = 0; rep < REPS(9); ++rep) { __syncthreads(); p9_topk(args, lds, G, tid); REPBAR(9, rep); } } SEAM(9);
    if (IN(10)) { p10_peer(args, G, lane, wave); }
#undef IN
#undef SEAM
}
}

#ifndef MK_N_LAUNCHES
#define MK_N_LAUNCHES 1
#endif

extern "C" void kernel_launch(void* const* d_in, const int* in_sizes, int n_in, void* d_out, int out_size, void* d_ws, size_t ws_size, hipStream_t stream) {
    static int grid = 0;
    if (!grid) {
        int dev = 0, cus = 0, per_cu = 0;
        if (hipGetDevice(&dev) != hipSuccess || hipDeviceGetAttribute(&cus, hipDeviceAttributeMultiprocessorCount, dev) != hipSuccess) { fprintf(stderr, "kernel_launch: device query failed\n"); return; }
        if (hipFuncSetAttribute((const void*)mk::mega, hipFuncAttributeMaxDynamicSharedMemorySize, mk::LDS_BYTES) != hipSuccess) { fprintf(stderr, "kernel_launch: hipFuncSetAttribute failed\n"); return; }
        if (hipOccupancyMaxActiveBlocksPerMultiprocessor(&per_cu, (const void*)mk::mega, mk::NTHR, mk::LDS_BYTES) != hipSuccess || per_cu < 1) { fprintf(stderr, "kernel_launch: occupancy query says %d\n", per_cu); return; }
        grid = cus;
    }
    if (n_in != 17 || ws_size < mk::WS_END) { fprintf(stderr, "kernel_launch: unexpected n_in %d / ws %zu\n", n_in, ws_size); return; }
    (void)hipMemsetAsync((char*)d_ws + mk::WS_CTL, 0, mk::CTL_ZERO_BYTES, stream);
    mk::Args a{};
    for (int i = 0; i < 17; ++i) a.in[i] = (const float*)d_in[i];
    a.out = (float*)d_out; a.ws = (unsigned char*)d_ws;
    a.ph_lo = 0; a.ph_hi = mk::N_PHASES;
    hipLaunchKernelGGL(mk::mega, dim3(grid), dim3(mk::NTHR), mk::LDS_BYTES, stream, a);
}
```

```cpp
#include <hip/hip_runtime.h>
#include <stdint.h>
#include <math.h>
#include <stdio.h>
namespace pg8 {
#define PG8_LAS __attribute__((address_space(3)))
typedef unsigned short bf16_t;
typedef short bf16x8 __attribute__((ext_vector_type(8)));
typedef float f32x4 __attribute__((ext_vector_type(4)));
typedef unsigned u32x4 __attribute__((ext_vector_type(4)));
constexpr int BM = 256, BK = 64, HALF = 128, HTB = HALF * BK * 2  , STAGE_BYTES = 8 * HTB, NXCD = 8, WGM = 8;

__host__ __device__ __forceinline__ int lds_byte(int r, int c) { const int st = (r >> 4) * 2 + (c >> 5), rr = r & 15, cc = c & 31, ob = rr * 64 + cc * 2; return st * 1024 + (ob ^ (((ob >> 9) & 1) << 5)); }
__host__ __device__ __forceinline__ void stage_rc(int b, int& R, int& C) { const int st = b / 1024, sb = b % 1024, swz = sb ^ (((sb >> 9) & 1) << 5); R = (st >> 1) * 16 + swz / 64; C = (st & 1) * 32 + (swz % 64) / 2; }
__host__ __device__ __forceinline__ int perm32(int rho) { const int n = rho >> 4, i = rho & 15; return 8 * (i >> 2) + 4 * n + (i & 3); }

struct Unit { int pm, pn; };
struct Gemm { const bf16_t* A; const bf16_t* Bt; int M, N, K; };

struct StaticOrder {
    int nM, nN, nwg, G, c;
    __host__ __device__ void init(int M, int N, int G_, int c_) { nM = M / BM; nN = N / BM; nwg = nM * nN; G = G_; c = c_; }
    __host__ __device__ bool next(int i, Unit& u) const {
        const long L = (long)i * G + c; if (L >= nwg) return false;
        int wgid = (int)L; { const int q = nwg / NXCD, r = nwg % NXCD, xcd = wgid % NXCD, off = wgid / NXCD; wgid = (xcd < r ? xcd * (q + 1) : r * (q + 1) + (xcd - r) * q) + off; }
        const int nig = WGM * nN, gid = wgid / nig, fm = gid * WGM, gsz = (nM - fm) < WGM ? (nM - fm) : WGM;
        u.pm = fm + ((wgid % nig) % gsz); u.pn = (wgid % nig) / gsz; return true;
    }
    __device__ __forceinline__ void a_ready(const Unit&) const {}
    __device__ __forceinline__ void done(const Unit&) const {}
};
struct CountedOrder : StaticOrder {
    const unsigned* ready; unsigned need; unsigned* tmo;
    __device__ __forceinline__ void a_ready(const Unit& u) const {
        if (threadIdx.x < 64) {
            const unsigned long long t0 = __builtin_amdgcn_s_memrealtime(); unsigned polls = 0;
            while ((unsigned)__builtin_amdgcn_readfirstlane(__hip_atomic_load(ready + 64 * u.pm, __ATOMIC_RELAXED, __HIP_MEMORY_SCOPE_AGENT)) < need) {
                if ((++polls & 255u) == 0u && __builtin_amdgcn_readfirstlane(__hip_atomic_load(tmo, __ATOMIC_RELAXED, __HIP_MEMORY_SCOPE_AGENT)) != 0u) break;
                if (__builtin_amdgcn_s_memrealtime() - t0 > 2000000ull) {
                    if (threadIdx.x == 0) { unsigned expect = 0u; __hip_atomic_compare_exchange_strong(tmo + 1, &expect, 0x600u | (unsigned)(u.pm & 0xff), __ATOMIC_RELAXED, __ATOMIC_RELAXED, __HIP_MEMORY_SCOPE_AGENT); __hip_atomic_store(tmo, 1u, __ATOMIC_RELAXED, __HIP_MEMORY_SCOPE_AGENT); }
                    break; }
                __builtin_amdgcn_s_sleep(2); }
            __builtin_amdgcn_fence(__ATOMIC_ACQUIRE, "agent");
            asm volatile("s_waitcnt vmcnt(0)" ::: "memory");
        }
#if !defined(BROKEN_HOOK_NO_BARRIER)
        asm volatile("" ::: "memory"); __builtin_amdgcn_s_barrier(); asm volatile("" ::: "memory");
#endif
    }
};

__device__ __forceinline__ unsigned cvt_pk_bf16(float lo, float hi) { unsigned r; asm volatile("v_cvt_pk_bf16_f32 %0, %1, %2" : "=v"(r) : "v"(lo), "v"(hi)); return r; }
typedef float f32x2 __attribute__((ext_vector_type(2)));
__device__ __forceinline__ f32x2 gelu_pk(f32x2 v) {
    const f32x2 av = __builtin_elementwise_abs(v), d = av * 0.2316418882f + 1.0f;
    f32x2 t; t.x = __builtin_amdgcn_rcpf(d.x); t.y = __builtin_amdgcn_rcpf(d.y);
    f32x2 q = t * 0.5307027145f + (-0.7265760135f); q = q * t + 0.7107068705f; q = q * t + (-0.142248368f); q = q * t + 0.127414796f; q = q * t;
    const f32x2 s = (v * v) * (-0.72134752044f);
    f32x2 e; e.x = __builtin_amdgcn_exp2f(s.x); e.y = __builtin_amdgcn_exp2f(s.y);
    const f32x2 m = v * (q * e), r = v - m;
    f32x2 o; o.x = v.x < 0.f ? m.x : r.x; o.y = v.y < 0.f ? m.y : r.y; return o;
}

struct EpiF32 {
    static constexpr bool PERM = false, AFTER_DRAIN = false;
    float* C; int ldc; const float* bias;
    __device__ __forceinline__ void operator()(const f32x4 (&acc)[2][2][4][2], const Unit& u, int wr, int wc, int fr, int fq) const {
        const int row0 = u.pm * BM + wr * 64 + fr, col0 = u.pn * BM + wc * 32 + 4 * fq;
        f32x4 bv[2][2];
#pragma unroll
        for (int bj = 0; bj < 2; ++bj)
#pragma unroll
            for (int n = 0; n < 2; ++n) bv[bj][n] = bias ? *(const f32x4*)(bias + col0 + bj * HALF + n * 16) : (f32x4){0.f, 0.f, 0.f, 0.f};
#pragma unroll
        for (int ai = 0; ai < 2; ++ai)
#pragma unroll
            for (int m = 0; m < 4; ++m) { float* rowp = C + (size_t)(row0 + ai * HALF + m * 16) * ldc + col0;
#pragma unroll
                for (int bj = 0; bj < 2; ++bj)
#pragma unroll
                    for (int n = 0; n < 2; ++n) *(f32x4*)(rowp + bj * HALF + n * 16) = acc[ai][bj][m][n] + bv[bj][n]; }
    }
};
template <int ACT  > struct EpiBf16 {
    static constexpr bool PERM = true, AFTER_DRAIN = false;
    bf16_t* O; int ldc; const float* bias; int split_cols; size_t split_stride;
    __device__ __forceinline__ void operator()(const f32x4 (&acc)[2][2][4][2], const Unit& u, int wr, int wc, int fr, int fq) const {
        const int row0 = u.pm * BM + wr * 64 + fr; int colt = u.pn * BM; bf16_t* base = O;
        if (split_cols) { const int t = colt / split_cols; base += (size_t)t * split_stride; colt -= t * split_cols; }
        const int col0 = colt + wc * 32 + 8 * fq, bcol0 = u.pn * BM + wc * 32 + 8 * fq;
        f32x4 bv[2][2];
#pragma unroll
        for (int bj = 0; bj < 2; ++bj)
#pragma unroll
            for (int n = 0; n < 2; ++n) bv[bj][n] = bias ? *(const f32x4*)(bias + bcol0 + bj * HALF + 4 * n) : (f32x4){0.f, 0.f, 0.f, 0.f};
#pragma unroll
        for (int ai = 0; ai < 2; ++ai)
#pragma unroll
            for (int m = 0; m < 4; ++m) { bf16_t* rowp = base + (size_t)(row0 + ai * HALF + m * 16) * ldc + col0;
#pragma unroll
                for (int bj = 0; bj < 2; ++bj) { f32x4 v0 = acc[ai][bj][m][0] + bv[bj][0], v1 = acc[ai][bj][m][1] + bv[bj][1];
                    if (ACT == 1) { f32x2 a = gelu_pk((f32x2){v0[0], v0[1]}), b = gelu_pk((f32x2){v0[2], v0[3]}), c = gelu_pk((f32x2){v1[0], v1[1]}), d = gelu_pk((f32x2){v1[2], v1[3]});
                        v0 = (f32x4){a.x, a.y, b.x, b.y}; v1 = (f32x4){c.x, c.y, d.x, d.y}; }
                    if (ACT == 2) {
#pragma unroll
                        for (int j = 0; j < 4; ++j) { v0[j] = 0.5f * v0[j] * (1.0f + erff(v0[j] * 0.70710678f)); v1[j] = 0.5f * v1[j] * (1.0f + erff(v1[j] * 0.70710678f)); } }
                    u32x4 w; w.x = cvt_pk_bf16(v0[0], v0[1]); w.y = cvt_pk_bf16(v0[2], v0[3]); w.z = cvt_pk_bf16(v1[0], v1[1]); w.w = cvt_pk_bf16(v1[2], v1[3]);
                    *(u32x4*)(rowp + bj * HALF) = w; } }
    }
};

struct PanelStats {
    unsigned* xbuf;
    unsigned* cnt;
    unsigned* tmo;
    int ntn; float eps;
    unsigned code;
    __device__ __forceinline__ bool run(const f32x4 (&v)[2][2][4][2], const Unit& u, int wr, int wc, int fr, int fq, PG8_LAS unsigned char* lds, int wid, int lane) const {
        typedef float f32x2v __attribute__((ext_vector_type(2)));
        PG8_LAS f32x2v* P = (PG8_LAS f32x2v*)lds;
        PG8_LAS f32x2v* S = (PG8_LAS f32x2v*)(lds + 8192);
        PG8_LAS unsigned* flag = (PG8_LAS unsigned*)(lds + 8192 + 2048);
#pragma unroll
        for (int ai = 0; ai < 2; ++ai)
#pragma unroll
            for (int m = 0; m < 4; ++m) {
                float s = 0.f;
#pragma unroll
                for (int bj = 0; bj < 2; ++bj)
#pragma unroll
                    for (int n = 0; n < 2; ++n) { const f32x4 x = v[ai][bj][m][n]; s += (x[0] + x[1]) + (x[2] + x[3]); }
                s += __shfl_xor(s, 16); s += __shfl_xor(s, 32);
                const float mw = s * (1.0f / 64.0f); float q = 0.f;
#pragma unroll
                for (int bj = 0; bj < 2; ++bj)
#pragma unroll
                    for (int n = 0; n < 2; ++n) { const f32x4 d = v[ai][bj][m][n] - mw; q += (d[0] * d[0] + d[1] * d[1]) + (d[2] * d[2] + d[3] * d[3]); }
                q += __shfl_xor(q, 16); q += __shfl_xor(q, 32);
                if (fq == 0) P[(ai * HALF + wr * 64 + m * 16 + fr) * 4 + wc] = (f32x2v){mw, q};
            }
        asm volatile("s_waitcnt lgkmcnt(0)" ::: "memory"); __builtin_amdgcn_s_barrier(); asm volatile("" ::: "memory");
#if defined(BROKEN_NO_WAIT)
        if (blockIdx.x >= 64) { const long long t0 = clock64(); while (clock64() - t0 < 60000) __builtin_amdgcn_s_sleep(8); }
#endif
        const int row = wid * 32 + (lane & 31);
        if (lane < 32) {
            const f32x2v a = P[row * 4 + 0], b = P[row * 4 + 1], c = P[row * 4 + 2], d = P[row * 4 + 3];
            const float mt = (a.x + b.x + c.x + d.x) * 0.25f;
            const float da = a.x - mt, db = b.x - mt, dc = c.x - mt, dd = d.x - mt;
            const float m2 = (a.y + b.y) + (c.y + d.y) + 64.0f * ((da * da + db * db) + (dc * dc + dd * dd));
            unsigned long long* slot = (unsigned long long*)xbuf + ((size_t)(u.pm * BM + row) * 4 + u.pn);
            __hip_atomic_store(slot, ((unsigned long long)__float_as_uint(m2) << 32) | __float_as_uint(mt), __ATOMIC_RELAXED, __HIP_MEMORY_SCOPE_AGENT);
        }
        asm volatile("s_waitcnt vmcnt(0)" ::: "memory");
        if (lane == 0) __hip_atomic_fetch_add(cnt + 64 * u.pm, 1u, __ATOMIC_RELAXED, __HIP_MEMORY_SCOPE_AGENT);
        if (wid == 0) {
            bool dead = false; const unsigned long long t0 = __builtin_amdgcn_s_memrealtime(); const unsigned want = 8u * (unsigned)ntn;
            for (;;) {
#if defined(BROKEN_NO_WAIT)
                break;
#endif
                if ((unsigned)__builtin_amdgcn_readfirstlane(__hip_atomic_load(cnt + 64 * u.pm, __ATOMIC_RELAXED, __HIP_MEMORY_SCOPE_AGENT)) >= want) break;
                if (__builtin_amdgcn_s_memrealtime() - t0 > 2000000ull) {
                    if (lane == 0) { unsigned expect = 0u; __hip_atomic_compare_exchange_strong(tmo + 1, &expect, code | (unsigned)(u.pm & 0xff), __ATOMIC_RELAXED, __ATOMIC_RELAXED, __HIP_MEMORY_SCOPE_AGENT);
                                     __hip_atomic_store(tmo, 1u, __ATOMIC_RELAXED, __HIP_MEMORY_SCOPE_AGENT); }
                    dead = true; break; }
                __builtin_amdgcn_s_sleep(2);
            }
            __builtin_amdgcn_fence(__ATOMIC_ACQUIRE, "agent");
            if (lane == 0) flag[0] = dead ? 1u : 0u;
        }
        asm volatile("s_waitcnt vmcnt(0) lgkmcnt(0)" ::: "memory"); __builtin_amdgcn_s_barrier(); asm volatile("" ::: "memory");
        const bool bad = flag[0] != 0u;
        if (lane < 32) {
            const unsigned long long* slot = (const unsigned long long*)xbuf + (size_t)(u.pm * BM + row) * 4; float mt[4], m2[4]; float ms = 0.f;
#pragma unroll
            for (int t = 0; t < 4; ++t) { if (t < ntn) { const unsigned long long w = __hip_atomic_load(slot + t, __ATOMIC_RELAXED, __HIP_MEMORY_SCOPE_AGENT); mt[t] = __uint_as_float((unsigned)w); m2[t] = __uint_as_float((unsigned)(w >> 32)); } else { mt[t] = 0.f; m2[t] = 0.f; } ms += mt[t]; }
            const float mean = ms / (float)ntn; float q = 0.f;
#pragma unroll
            for (int t = 0; t < 4; ++t) if (t < ntn) { const float dm = mt[t] - mean; q += m2[t] + 256.0f * dm * dm; }
            S[row] = (f32x2v){mean, 1.0f / sqrtf(q / (256.0f * (float)ntn) + eps)};
        }
        asm volatile("s_waitcnt lgkmcnt(0)" ::: "memory"); __builtin_amdgcn_s_barrier(); asm volatile("" ::: "memory");
        return bad;
    }
};
struct EpiLnRes {
    static constexpr bool PERM = false, AFTER_DRAIN = true;
    const float* base; float* out; int ldc; const float* bias; PanelStats st; unsigned poison;
    __device__ __forceinline__ void refuse(size_t i0, size_t stride, int M, int N) const { const float q = __builtin_nanf(""); for (size_t i = i0; i < (size_t)M * N; i += stride) out[(i / N) * ldc + i % N] = q;
        if (i0 == 0) { unsigned expect = 0u; __hip_atomic_compare_exchange_strong(st.tmo + 1, &expect, 0x7f0u, __ATOMIC_RELAXED, __ATOMIC_RELAXED, __HIP_MEMORY_SCOPE_AGENT); __hip_atomic_store(st.tmo, 1u, __ATOMIC_RELAXED, __HIP_MEMORY_SCOPE_AGENT); } }
    __device__ __forceinline__ void fused(f32x4 (&acc)[2][2][4][2], const Unit& u, int wr, int wc, int fr, int fq, PG8_LAS unsigned char* lds, int wid, int lane) const {
        typedef float f32x2v __attribute__((ext_vector_type(2)));
        const PG8_LAS f32x2v* S = (const PG8_LAS f32x2v*)(lds + 8192);
        const int col0 = u.pn * BM + wc * 32 + 4 * fq;
#pragma unroll
        for (int bj = 0; bj < 2; ++bj)
#pragma unroll
            for (int n = 0; n < 2; ++n) { const f32x4 bv = bias ? *(const f32x4*)(bias + col0 + bj * HALF + n * 16) : (f32x4){0.f, 0.f, 0.f, 0.f};
#pragma unroll
                for (int ai = 0; ai < 2; ++ai)
#pragma unroll
                    for (int m = 0; m < 4; ++m) acc[ai][bj][m][n] += bv; }
        const bool bad = st.run(acc, u, wr, wc, fr, fq, lds, wid, lane) || poison != 0u;
        const float qnan = __builtin_nanf("");
#pragma unroll
        for (int ai = 0; ai < 2; ++ai)
#pragma unroll
            for (int m = 0; m < 4; ++m) { const int r = ai * HALF + wr * 64 + m * 16 + fr; const f32x2v sr = S[r]; const size_t off = (size_t)(u.pm * BM + r) * ldc + col0;
#pragma unroll
                for (int bj = 0; bj < 2; ++bj)
#pragma unroll
                    for (int n = 0; n < 2; ++n) { const f32x4 bs = *(const f32x4*)(base + off + bj * HALF + n * 16); f32x4 o = bs + (acc[ai][bj][m][n] - sr.x) * sr.y;
                        if (bad) o = (f32x4){qnan, qnan, qnan, qnan}; *(f32x4*)(out + off + bj * HALF + n * 16) = o; }
                asm volatile("" ::: "memory"); }
    }
};
struct EpiLnResLn {
    static constexpr bool PERM = false, AFTER_DRAIN = true;
    const float* base; float* out; bf16_t* xn; int ldc; const float* bias; PanelStats st1, st2; unsigned poison;
    __device__ __forceinline__ void refuse(size_t i0, size_t stride, int M, int N) const { const float q = __builtin_nanf(""); for (size_t i = i0; i < (size_t)M * N; i += stride) { const size_t o = (i / N) * ldc + i % N; out[o] = q; xn[o] = (bf16_t)0x7fc0u; }
        if (i0 == 0) { unsigned expect = 0u; __hip_atomic_compare_exchange_strong(st1.tmo + 1, &expect, 0x7f0u, __ATOMIC_RELAXED, __ATOMIC_RELAXED, __HIP_MEMORY_SCOPE_AGENT); __hip_atomic_store(st1.tmo, 1u, __ATOMIC_RELAXED, __HIP_MEMORY_SCOPE_AGENT); } }
    __device__ __forceinline__ void fused(f32x4 (&acc)[2][2][4][2], const Unit& u, int wr, int wc, int fr, int fq, PG8_LAS unsigned char* lds, int wid, int lane) const {
        typedef float f32x2v __attribute__((ext_vector_type(2))); typedef unsigned u32x2v __attribute__((ext_vector_type(2)));
        const PG8_LAS f32x2v* S = (const PG8_LAS f32x2v*)(lds + 8192);
        const int col0 = u.pn * BM + wc * 32 + 4 * fq;
#pragma unroll
        for (int bj = 0; bj < 2; ++bj)
#pragma unroll
            for (int n = 0; n < 2; ++n) { const f32x4 bv = bias ? *(const f32x4*)(bias + col0 + bj * HALF + n * 16) : (f32x4){0.f, 0.f, 0.f, 0.f};
#pragma unroll
                for (int ai = 0; ai < 2; ++ai)
#pragma unroll
                    for (int m = 0; m < 4; ++m) acc[ai][bj][m][n] += bv; }
        bool bad = st1.run(acc, u, wr, wc, fr, fq, lds, wid, lane) || poison != 0u;
        const float qnan = __builtin_nanf("");
#pragma unroll
        for (int ai = 0; ai < 2; ++ai)
#pragma unroll
            for (int m = 0; m < 4; ++m) { const int r = ai * HALF + wr * 64 + m * 16 + fr; const f32x2v sr = S[r]; const size_t off = (size_t)(u.pm * BM + r) * ldc + col0;
#pragma unroll
                for (int bj = 0; bj < 2; ++bj)
#pragma unroll
                    for (int n = 0; n < 2; ++n) { const f32x4 bs = *(const f32x4*)(base + off + bj * HALF + n * 16); acc[ai][bj][m][n] = bs + (acc[ai][bj][m][n] - sr.x) * sr.y; }
                asm volatile("" : "+v"(acc[ai][0][m][0]), "+v"(acc[ai][0][m][1]), "+v"(acc[ai][1][m][0]), "+v"(acc[ai][1][m][1]));
                if (m & 1) asm volatile("" ::: "memory"); }
        const bool bad1 = bad;
        bad = st2.run(acc, u, wr, wc, fr, fq, lds, wid, lane) || bad;
#pragma unroll
        for (int ai = 0; ai < 2; ++ai)
#pragma unroll
            for (int m = 0; m < 4; ++m) { const int r = ai * HALF + wr * 64 + m * 16 + fr; const f32x2v sr = S[r]; const size_t off = (size_t)(u.pm * BM + r) * ldc + col0;
#pragma unroll
                for (int bj = 0; bj < 2; ++bj)
#pragma unroll
                    for (int n = 0; n < 2; ++n) { const f32x4 x1 = acc[ai][bj][m][n]; *(f32x4*)(out + off + bj * HALF + n * 16) = bad1 ? (f32x4){qnan, qnan, qnan, qnan} : x1;
                        const f32x4 o = (x1 - sr.x) * sr.y; u32x2v w; w.x = cvt_pk_bf16(o[0], o[1]); w.y = cvt_pk_bf16(o[2], o[3]);
                        if (bad) { w.x = 0x7fc07fc0u; w.y = 0x7fc07fc0u; } *(u32x2v*)(xn + off + bj * HALF + n * 16) = w; }
                asm volatile("" ::: "memory"); }
    }
};

template <class Epi, class Sched, bool STAMP = false>
__device__ __forceinline__ void gemm_phase(PG8_LAS unsigned char* lds, const Gemm g, const Sched& S, const Epi& E, unsigned long long* stamps) {
    const int tid = threadIdx.x, wid = __builtin_amdgcn_readfirstlane(tid >> 6), lane = tid & 63, wr = wid >> 2, wc = wid & 3, fr = lane & 15, fq = lane >> 4;
    const int K = g.K, nt = K / BK;
    int ts_lo = 0, ts_hi = 0, nts = 0; const unsigned long long rt_entry = STAMP ? (unsigned long long)wall_clock64() : 0ull;
#define PG8_STAMP() do { if (STAMP && wid == 0 && nts < 64) { const unsigned long long _c = (unsigned long long)clock64(); \
        ts_lo = (lane == nts) ? (int)(unsigned)_c : ts_lo; ts_hi = (lane == nts) ? (int)(unsigned)(_c >> 32) : ts_hi; ++nts; } } while (0)
    PG8_STAMP();
    unsigned voffA[2], voffB[2];
#pragma unroll
    for (int i = 0; i < 2; ++i) { int R, C; stage_rc(tid * 16 + i * 8192, R, C); const int Rb = Epi::PERM ? ((R & ~31) + perm32(R & 31)) : R;
        voffA[i] = (unsigned)(R * K + C) * 2u; voffB[i] = (unsigned)(Rb * K + C) * 2u; }
    const size_t kstep = (size_t)(BK * 2);
    const size_t hstep = (size_t)HALF * K * 2;
    const size_t tstep = 2 * hstep;
    const unsigned ldsw = (unsigned)wid * 1024u;
    const int aoff = lds_byte(wr * 64 + fr, fq * 8), boff = lds_byte(wc * 32 + fr, fq * 8);
#define PG8_SA(b, h) (((b) * 2 + (h)) * HTB)
#define PG8_SB(b, h) ((4 + (b) * 2 + (h)) * HTB)
#define PG8_STAGE(bufoff, gbase, voff) do { _Pragma("unroll") for (int _i = 0; _i < 2; ++_i) \
        __builtin_amdgcn_global_load_lds((const unsigned*)((const char*)(gbase) + (voff)[_i]), (PG8_LAS unsigned*)(lds + (bufoff) + ldsw + _i * 8192), 16, 0, 0); } while (0)
#define PG8_LDA(dst, b, h) do { _Pragma("unroll") for (int m = 0; m < 4; ++m) _Pragma("unroll") for (int k = 0; k < 2; ++k) dst[m][k] = *(const PG8_LAS bf16x8*)(lds + PG8_SA(b, h) + aoff + m * 2048 + k * 1024); } while (0)
#define PG8_LDB(dst, b, h) do { _Pragma("unroll") for (int n = 0; n < 2; ++n) _Pragma("unroll") for (int k = 0; k < 2; ++k) dst[n][k] = *(const PG8_LAS bf16x8*)(lds + PG8_SB(b, h) + boff + n * 2048 + k * 1024); } while (0)
#define PG8_MMA(ai, bj, At, Bt) do { __builtin_amdgcn_s_setprio(1); _Pragma("unroll") for (int m = 0; m < 4; ++m) _Pragma("unroll") for (int n = 0; n < 2; ++n) _Pragma("unroll") for (int k = 0; k < 2; ++k) \
        acc[ai][bj][m][n] = __builtin_amdgcn_mfma_f32_16x16x32_bf16(Bt[n][k], At[m][k], acc[ai][bj][m][n], 0, 0, 0); __builtin_amdgcn_s_setprio(0); } while (0)
#define PG8_WAIT_V(n) asm volatile("s_waitcnt vmcnt(" #n ")" ::: "memory")
#define PG8_WAIT_L(n) asm volatile("s_waitcnt lgkmcnt(" #n ")" ::: "memory")
#define PG8_BAR __builtin_amdgcn_s_barrier()
#define PG8_SCHED __builtin_amdgcn_sched_barrier(0)
    Unit cur, nxt; int ui = 0;
    if (!S.next(0, cur)) return;
    f32x4 acc[2][2][4][2];
#pragma unroll
    for (int a = 0; a < 2; ++a)
#pragma unroll
        for (int b = 0; b < 2; ++b)
#pragma unroll
            for (int m = 0; m < 4; ++m)
#pragma unroll
                for (int n = 0; n < 2; ++n) acc[a][b][m][n] = (f32x4){0.f, 0.f, 0.f, 0.f};
    bf16x8 At[4][2], B0[2][2], B1[2][2];
    const char* cA = (const char*)g.A + (size_t)cur.pm * tstep; const char* cB = (const char*)g.Bt + (size_t)cur.pn * tstep;
    S.a_ready(cur);
    PG8_STAGE(PG8_SB(0, 0), cB, voffB); PG8_STAGE(PG8_SA(0, 0), cA, voffA); PG8_STAGE(PG8_SB(0, 1), cB + hstep, voffB); PG8_STAGE(PG8_SA(0, 1), cA + hstep, voffA);
    if (wr == 1) PG8_BAR;
    PG8_WAIT_V(4); PG8_BAR;
    PG8_STAGE(PG8_SB(1, 0), cB + kstep, voffB); PG8_STAGE(PG8_SA(1, 0), cA + kstep, voffA); PG8_STAGE(PG8_SB(1, 1), cB + hstep + kstep, voffB);
    PG8_WAIT_V(6); PG8_BAR;
    PG8_STAMP();
    for (;;) {
        const bool has_next = S.next(ui + 1, nxt);
        const char* nA = has_next ? (const char*)g.A + (size_t)nxt.pm * tstep : cA; const char* nB = has_next ? (const char*)g.Bt + (size_t)nxt.pn * tstep : cB;
        for (int t = 0; t < nt; t += 2) {
            const bool last = (t == nt - 2);
            const char* a1 = cA + (size_t)(t + 1) * kstep;
            const char* a2 = last ? nA : cA + (size_t)(t + 2) * kstep; const char* b2 = last ? nB : cB + (size_t)(t + 2) * kstep;
            const char* a3 = a2 + kstep; const char* b3 = b2 + kstep;
            if (last && has_next) S.a_ready(nxt);
            PG8_LDB(B0, 0, 0); PG8_SCHED; PG8_LDA(At, 0, 0); PG8_STAGE(PG8_SA(1, 1), a1 + hstep, voffA);
            PG8_WAIT_L(8); PG8_BAR; PG8_WAIT_L(0); PG8_MMA(0, 0, At, B0); PG8_BAR; PG8_SCHED;
            PG8_LDB(B1, 0, 1); PG8_STAGE(PG8_SB(0, 0), b2, voffB);
            PG8_BAR; PG8_WAIT_L(0); PG8_MMA(0, 1, At, B1); PG8_BAR;
            PG8_LDA(At, 0, 1); PG8_STAGE(PG8_SA(0, 0), a2, voffA);
            PG8_BAR; PG8_WAIT_L(0); PG8_MMA(1, 0, At, B0); PG8_BAR; PG8_SCHED;
            PG8_STAGE(PG8_SB(0, 1), b2 + hstep, voffB);
            PG8_WAIT_V(6); PG8_BAR; PG8_MMA(1, 1, At, B1); PG8_BAR;
            PG8_LDB(B0, 1, 0); PG8_SCHED; PG8_LDA(At, 1, 0); PG8_STAGE(PG8_SA(0, 1), a2 + hstep, voffA);
            PG8_WAIT_L(8); PG8_BAR; PG8_WAIT_L(0); PG8_MMA(0, 0, At, B0); PG8_BAR; PG8_SCHED;
            PG8_LDB(B1, 1, 1); PG8_STAGE(PG8_SB(1, 0), b3, voffB);
            PG8_BAR; PG8_WAIT_L(0); PG8_MMA(0, 1, At, B1); PG8_BAR;
            PG8_LDA(At, 1, 1); PG8_STAGE(PG8_SA(1, 0), a3, voffA);
            PG8_BAR; PG8_WAIT_L(0); PG8_MMA(1, 0, At, B0); PG8_BAR; PG8_SCHED;
            PG8_STAGE(PG8_SB(1, 1), b3 + hstep, voffB);
            PG8_WAIT_V(6); PG8_BAR; PG8_MMA(1, 1, At, B1); PG8_BAR;
        }
        PG8_STAMP();
        if constexpr (!Epi::AFTER_DRAIN) { E(acc, cur, wr, wc, fr, fq); S.done(cur); }
        PG8_STAMP();
        if (!has_next) break;
#pragma unroll
        for (int a = 0; a < 2; ++a)
#pragma unroll
            for (int b = 0; b < 2; ++b)
#pragma unroll
                for (int m = 0; m < 4; ++m)
#pragma unroll
                    for (int n = 0; n < 2; ++n) acc[a][b][m][n] = (f32x4){0.f, 0.f, 0.f, 0.f};
        cur = nxt; cA = nA; cB = nB; ++ui;
    }
    PG8_WAIT_V(0);
    if (wr == 0) PG8_BAR;
    PG8_BAR;
    if constexpr (Epi::AFTER_DRAIN) { E.fused(acc, cur, wr, wc, fr, fq, lds, wid, lane); S.done(cur); }
    PG8_STAMP();
    if (STAMP && wid == 0) { stamps[lane] = lane < nts ? (((unsigned long long)(unsigned)ts_hi << 32) | (unsigned)ts_lo) : 0ull;
        if (lane == 62) stamps[62] = rt_entry; if (lane == 63) stamps[63] = (unsigned long long)wall_clock64(); }
#undef PG8_STAMP
#undef PG8_SA
#undef PG8_SB
#undef PG8_STAGE
#undef PG8_LDA
#undef PG8_LDB
#undef PG8_MMA
#undef PG8_WAIT_V
#undef PG8_WAIT_L
#undef PG8_BAR
#undef PG8_SCHED
}
}
#define XB_TMO      128
#define XB_XCNT(j)  (256  + 64 * (j))
#define XB_XSUB(j)  (1280 + 64 * (j))
#define XB_XGEN(j)  (2304 + 64 * (j))
#define XB_TOP      3328
#define XB_TOPGEN   3392
#define XCD_BAR_WORDS 3456
#define XB_SPIN_CAP (1u << 18)
#define LAS __attribute__((address_space(3)))

__device__ __forceinline__ unsigned xb_ld(unsigned* p)              { return __hip_atomic_load(p, __ATOMIC_RELAXED, __HIP_MEMORY_SCOPE_AGENT); }
__device__ __forceinline__ unsigned xb_add(unsigned* p, unsigned v) { return __hip_atomic_fetch_add(p, v, __ATOMIC_RELAXED, __HIP_MEMORY_SCOPE_AGENT); }
__device__ __forceinline__ unsigned xb_xcc_id() { return (unsigned)__builtin_amdgcn_s_getreg((3 << 11) | 20) & 0xFu; }
#define XB_SPIN(cond, bar) do { unsigned _sp = 0; while (cond) { __builtin_amdgcn_s_sleep(1); \
    if ((++_sp & 255u) == 0u) { if (xb_ld(&(bar)[XB_TMO])) break; if (_sp > XB_SPIN_CAP) { atomicAdd(&(bar)[XB_TMO], 1u); break; } } } } while (0)

struct XcdBarrier {
    unsigned* bar; unsigned x;
    volatile LAS unsigned* st;
};

__device__ __forceinline__ XcdBarrier xcd_barrier_post(unsigned* bar, volatile LAS unsigned* st) {
    XcdBarrier b; b.bar = bar; b.x = xb_xcc_id(); b.st = st;
    if (threadIdx.x == 0) (void)xb_add(&bar[XB_XCNT(b.x)], 1u);
    return b;
}
__device__ __forceinline__ void xcd_barrier_complete(unsigned* bar, unsigned x, unsigned& nloc, unsigned& nx) {
    const unsigned G = gridDim.x * gridDim.y * gridDim.z;
    unsigned sum, cnt, mine, sp = 0u;
    for (;;) {
        sum = 0u; cnt = 0u; mine = 0u;
#pragma unroll
        for (unsigned j = 0; j < 16; ++j) { const unsigned c = xb_ld(&bar[XB_XCNT(j)]); sum += c; cnt += (c > 0u) ? 1u : 0u; mine = (j == x) ? c : mine; }
        if (sum == G) break;
        __builtin_amdgcn_s_sleep(1);
        if ((++sp & 255u) == 0u) { if (xb_ld(&bar[XB_TMO])) break; if (sp > XB_SPIN_CAP) { atomicAdd(&bar[XB_TMO], 1u); break; } }
    }
    nloc = mine > 0u ? mine : 1u; nx = cnt > 0u ? cnt : 1u;
}

__device__ __forceinline__ void xcd_barrier(const XcdBarrier& b) {
    asm volatile("s_waitcnt vmcnt(0)" ::: "memory");
    __syncthreads();
    if (threadIdx.x == 0) {
        unsigned* bar = b.bar;
        __builtin_amdgcn_s_waitcnt(0);
        unsigned nloc = b.st[0], nx = b.st[1];
        if (nloc == 0u) { xcd_barrier_complete(bar, b.x, nloc, nx); b.st[0] = nloc; b.st[1] = nx; }
        const unsigned old = xb_add(&bar[XB_XSUB(b.x)], 1u);
        const unsigned gen = old / nloc;
        if (old + 1u == (gen + 1u) * nloc) {
            __builtin_amdgcn_fence(__ATOMIC_RELEASE, "agent");
            asm volatile("s_waitcnt vmcnt(0)" ::: "memory");
            const unsigned og = xb_add(&bar[XB_TOP], 1u);
            const unsigned tg = og / nx;
            if (og + 1u == (tg + 1u) * nx) xb_add(&bar[XB_TOPGEN], 1u);
            else XB_SPIN(xb_ld(&bar[XB_TOPGEN]) == tg, bar);
            __builtin_amdgcn_fence(__ATOMIC_ACQUIRE, "agent");
            xb_add(&bar[XB_XGEN(b.x)], 1u);
            asm volatile("s_waitcnt vmcnt(0)" ::: "memory");
        } else {
            XB_SPIN(xb_ld(&bar[XB_XGEN(b.x)]) == gen, bar);
            __builtin_amdgcn_fence(__ATOMIC_ACQUIRE, "agent");
            asm volatile("s_waitcnt vmcnt(0)" ::: "memory");
        }
    }
    __syncthreads();
}

#ifndef PROBE_PH
#define PROBE_PH -1
#define PROBE_N 0
#endif
namespace mk {
typedef unsigned short bf16;
typedef unsigned v4u __attribute__((ext_vector_type(4)));
typedef unsigned v2u __attribute__((ext_vector_type(2)));
typedef float f32x4 __attribute__((ext_vector_type(4)));
typedef short bf16x8 __attribute__((ext_vector_type(8)));
typedef __bf16 bf16x2 __attribute__((ext_vector_type(2)));

constexpr int NB = 8, SEQ = 2048, DM = 1024, T = NB * SEQ, NQKV = 3072;
constexpr float LN_EPS = 1e-5f;
constexpr float DN_ALPHA = 1.189207115002721f;
constexpr int NWAVES = 8, NTHR = 512;

constexpr size_t MiB = 1u << 20;
constexpr size_t WS_CTL = 0;
constexpr size_t CTL_ZERO_BYTES = 64 * 1024;
constexpr size_t WS_MODP = 1 * MiB;
constexpr size_t WS_MOD = 4 * MiB;
constexpr size_t WS_KMEAN = 4 * MiB + 256 * 1024;
constexpr size_t WS_WIN = 5 * MiB;
constexpr size_t WS_WOUT = 11 * MiB;
constexpr size_t WS_WQ = 13 * MiB;
constexpr size_t WS_U = 16 * MiB;
constexpr size_t WS_V = 48 * MiB;
constexpr size_t WS_H = 80 * MiB;
constexpr size_t WS_QKV = 112 * MiB;
constexpr size_t WS_ATT = 208 * MiB;
constexpr size_t WS_END = 256 * MiB;
constexpr int CW_BAR = 4096;
constexpr float PEER_USCALE = 32.f;

constexpr int RING_BYTES = 131072;
constexpr int MISC_OFF = RING_BYTES + 320;
constexpr int LDS_BYTES = 147456;

__device__ __forceinline__ unsigned f2bf(float f) { unsigned u = __float_as_uint(f); return (u + 0x7fffu + ((u >> 16) & 1u)) >> 16; }
__device__ __forceinline__ unsigned pk2(float lo, float hi) { return f2bf(lo) | (f2bf(hi) << 16); }
__device__ __forceinline__ float bflo(unsigned w) { return __uint_as_float(w << 16); }
__device__ __forceinline__ float bfhi(unsigned w) { return __uint_as_float(w & 0xffff0000u); }
__device__ __forceinline__ float dot2(unsigned a, unsigned b, float acc) { return __builtin_amdgcn_fdot2_f32_bf16(__builtin_bit_cast(bf16x2, a), __builtin_bit_cast(bf16x2, b), acc, false); }
__device__ __forceinline__ float wave_sum(float v) {
#pragma unroll
    for (int o = 1; o < 64; o <<= 1) v += __shfl_xor(v, o);
    return v;
}
__device__ __forceinline__ int t5_bucket(int d) {
    if (d < 16) return d;
    int b = 16;
    b += (d >= 22); b += (d >= 30); b += (d >= 40); b += (d >= 54); b += (d >= 73); b += (d >= 99); b += (d >= 134); b += (d >= 182);
    b += (d >= 246); b += (d >= 332); b += (d >= 450); b += (d >= 609); b += (d >= 825); b += (d >= 1117); b += (d >= 1513);
    return b;
}

struct Args {
    const float* in[17]; float* out; unsigned char* ws; int ph_lo, ph_hi, bar_idx, pad;
};

template <int MODE>
__device__ __forceinline__ void transpose_item(const float* W, int K, int N, bf16* WT, LAS float* scr, int item, int lane, const float* gna, const float* gnb) {
    const int nblk = N / 32, kb = item / nblk, nb = item % nblk, k0 = 64 * kb, n0 = 32 * nb;
    float cs = 1.f;
    if (MODE == 1) { if (n0 < 512 || (n0 >= 1536 && n0 < 2048)) cs = 0.125f; }
#pragma unroll 8
    for (int i = 0; i < 32; ++i) { const int kk = 2 * i + (lane >> 5); float v = W[(size_t)(k0 + kk) * N + n0 + (lane & 31)] * cs;
        if (MODE == 2) { const int k = k0 + kk; v *= (k < 512) ? gna[k] : gnb[k - 512]; }
        scr[kk * 33 + (lane & 31)] = v; }
    asm volatile("s_waitcnt lgkmcnt(0)" ::: "memory");
    const int c = lane & 7;
#pragma unroll
    for (int j = 0; j < 4; ++j) { const int n = (lane >> 3) + 8 * j; const LAS float* s = scr + (8 * c) * 33 + n;
        v4u o; o.x = pk2(s[0 * 33], s[1 * 33]); o.y = pk2(s[2 * 33], s[3 * 33]); o.z = pk2(s[4 * 33], s[5 * 33]); o.w = pk2(s[6 * 33], s[7 * 33]);
        *(v4u*)(WT + (size_t)(n0 + n) * K + k0 + 8 * c) = o; }
    asm volatile("s_waitcnt lgkmcnt(0)" ::: "memory");
}

__device__ __forceinline__ void p0_prologue(const Args& a, LAS unsigned char* lds, int G, int tid, int lane, int wave) {
    unsigned char* ws = a.ws;
    {
        const float* c = a.in[1]; const float* w_ada = a.in[2]; float* modp = (float*)(ws + WS_MODP);
        LAS float* sc = (LAS float*)lds;
        for (int item = blockIdx.x; item < 192; item += G) {
            const int ks = item / 12, cb = item % 12;
            { const int b = tid >> 6, i = tid & 63; const float v = c[b * DM + ks * 64 + i]; sc[b * 64 + i] = v / (1.f + __expf(-v)); }
            __syncthreads();
            const int col = cb * 512 + tid;
            float acc[8];
#pragma unroll
            for (int b = 0; b < 8; ++b) acc[b] = 0.f;
#pragma unroll 8
            for (int i = 0; i < 64; ++i) { const float w = w_ada[(size_t)(ks * 64 + i) * 6144 + col];
#pragma unroll
                for (int b = 0; b < 8; ++b) acc[b] += sc[b * 64 + i] * w; }
#pragma unroll
            for (int b = 0; b < 8; ++b) modp[(size_t)(ks * 8 + b) * 6144 + col] = acc[b];
            __syncthreads();
        }
    }
    {
        LAS float* scr = (LAS float*)(lds + wave * 16384);
        const int gw = blockIdx.x * NWAVES + wave, NGW = G * NWAVES;
        constexpr int I_IN = 16 * 96, I_O = 16 * 32, I_Q = 16 * 32;
        for (int it = gw; it < I_IN + I_O + I_Q; it += NGW) {
            int r = it;
            if (r < I_IN) { transpose_item<1>(a.in[4], DM, NQKV, (bf16*)(ws + WS_WIN), scr, r, lane, nullptr, nullptr); continue; } r -= I_IN;
            if (r < I_O) { transpose_item<2>(a.in[8], DM, DM, (bf16*)(ws + WS_WOUT), scr, r, lane, a.in[6], a.in[7]); continue; } r -= I_O;
            transpose_item<0>(a.in[11], DM, DM, (bf16*)(ws + WS_WQ), scr, r, lane, nullptr, nullptr);
        }
    }
    {
        const size_t nthr = (size_t)G * NTHR, gt = (size_t)blockIdx.x * NTHR + tid;
        const size_t per = (size_t)16384 * 1024 / 16;
        for (size_t i = gt; i < 2 * per; i += nthr) {
            const bool second = i >= per; const size_t j = second ? i - per : i; const float sc = second ? 1.f : PEER_USCALE;
            const f32x4* src = (const f32x4*)(second ? a.in[14] : a.in[13]) + 4 * j;
            v4u o;
#pragma unroll
            for (int q = 0; q < 4; ++q) { const f32x4 p = src[q]; int w = 0;
                w = __builtin_amdgcn_cvt_pk_fp8_f32(p.x * sc, p.y * sc, w, false); w = __builtin_amdgcn_cvt_pk_fp8_f32(p.z * sc, p.w * sc, w, true); o[q] = (unsigned)w; }
            ((v4u*)(ws + (second ? WS_V : WS_U)))[j] = o;
        }
        float* km = (float*)(ws + WS_KMEAN);
        for (size_t i = gt; i < 32768; i += nthr) km[i] = 0.f;
    }
}

__device__ __forceinline__ void p1_mod_h(const Args& a, LAS unsigned char* lds, int G, int tid, int lane, int wave) {
    unsigned char* ws = a.ws;
    const float* modp = (const float*)(ws + WS_MODP); const float* b_ada = a.in[3];
    float* mod = (float*)(ws + WS_MOD);
    for (int i = blockIdx.x * NTHR + tid; i < 8 * 6144; i += G * NTHR) {
        const int b = i / 6144, j = i % 6144; float s = b_ada[j];
#pragma unroll
        for (int ks = 0; ks < 16; ++ks) s += modp[(size_t)(ks * 8 + b) * 6144 + j];
        mod[i] = s;
    }
    LAS float* sm = (LAS float*)lds;
    const float* x = a.in[0]; bf16* H = (bf16*)(ws + WS_H);
    int curb = -1;
    for (int rb = blockIdx.x; rb < T / 64; rb += G) {
        const int b = rb >> 5;
        if (b != curb) {
            __syncthreads();
            for (int j = tid; j < 2048; j += NTHR) { float s = b_ada[j];
#pragma unroll
                for (int ks = 0; ks < 16; ++ks) s += modp[(size_t)(ks * 8 + b) * 6144 + j];
                sm[j] = s; }
            __syncthreads();
            curb = b;
        }
#pragma unroll 2
        for (int r = 0; r < 8; ++r) {
            const int row = rb * 64 + wave * 8 + r;
#pragma unroll
            for (int hf = 0; hf < 2; ++hf) {
                const int c0 = hf * 512 + 8 * lane;
                const f32x4 p = *(const f32x4*)(x + (size_t)row * DM + c0), q = *(const f32x4*)(x + (size_t)row * DM + c0 + 4);
                const f32x4 s0 = *(const LAS f32x4*)(sm + 1024 + c0), s1 = *(const LAS f32x4*)(sm + 1024 + c0 + 4);
                const f32x4 h0 = *(const LAS f32x4*)(sm + c0), h1 = *(const LAS f32x4*)(sm + c0 + 4);
                v4u o; o.x = pk2(p.x * (1.f + s0.x) + h0.x, p.y * (1.f + s0.y) + h0.y); o.y = pk2(p.z * (1.f + s0.z) + h0.z, p.w * (1.f + s0.w) + h0.w);
                o.z = pk2(q.x * (1.f + s1.x) + h1.x, q.y * (1.f + s1.y) + h1.y); o.w = pk2(q.z * (1.f + s1.z) + h1.z, q.w * (1.f + s1.w) + h1.w);
                *(v4u*)(H + (size_t)row * DM + c0) = o;
            }
        }
    }
}

__device__ __forceinline__ void p3_kmean(const Args& a, LAS unsigned char* lds, int G, int tid) {
    unsigned char* ws = a.ws; const bf16* QKV = (const bf16*)(ws + WS_QKV); float* km = (float*)(ws + WS_KMEAN);
    LAS float* red = (LAS float*)lds;
    for (int item = blockIdx.x; item < 256; item += G) {
        const int b = item >> 5, n = (item >> 2) & 7, rq = item & 3;
        const int cp = tid & 255, rg = tid >> 8;
        const size_t row0 = (size_t)b * SEQ + n * 256 + rq * 64 + rg * 32;
        float s0 = 0.f, s1 = 0.f;
#pragma unroll 8
        for (int r = 0; r < 32; ++r) { const unsigned w = *(const unsigned*)(QKV + (row0 + r) * NQKV + 512 + 2 * cp); s0 += bflo(w); s1 += bfhi(w); }
        if (rg == 1) { red[2 * cp] = s0; red[2 * cp + 1] = s1; }
        __syncthreads();
        if (rg == 0) { s0 += red[2 * cp]; s1 += red[2 * cp + 1]; const int c = 2 * cp, h = c >> 6, d = c & 63;
            float* dst = km + ((b * 8 + h) * 8 + n) * 64 + d;
            atomicAdd(dst, s0 * (1.f / 256.f)); atomicAdd(dst + 1, s1 * (1.f / 256.f)); }
        __syncthreads();
    }
}

__device__ __forceinline__ void unpack8(const v4u w, float (&v)[8]) { v[0] = bflo(w.x); v[1] = bfhi(w.x); v[2] = bflo(w.y); v[3] = bfhi(w.y); v[4] = bflo(w.z); v[5] = bfhi(w.z); v[6] = bflo(w.w); v[7] = bfhi(w.w); }
typedef short v4i16 __attribute__((ext_vector_type(4)));
constexpr float LOG2E = 1.4426950408889634f;
constexpr int AT_K = 0, AT_V = 18432, AT_LUT = 36864, AT_GATE = 45056, AT_SEL = 49152, AT_ANY = 49664, AT_ROW = 144;
constexpr size_t WS_YA = WS_ATT, WS_OB0 = WS_ATT + 16 * MiB, WS_OB1 = WS_ATT + 32 * MiB, WS_OB2 = WS_H, WS_LSE = WS_H + 16 * MiB;

__device__ __forceinline__ unsigned pkbf(float lo, float hi) { bf16x2 t; t.x = (__bf16)lo; t.y = (__bf16)hi; return __builtin_bit_cast(unsigned, t); }
__device__ __forceinline__ bf16x8 mk8(v4i16 a, v4i16 b) { return __builtin_shufflevector(a, b, 0, 1, 2, 3, 4, 5, 6, 7); }
__device__ __forceinline__ v4i16 tr16(const LAS unsigned char* p) { return __builtin_amdgcn_ds_read_tr16_b64_v4i16((LAS v4i16*)p); }

struct AttnState { bf16x8 qf[2]; f32x4 ot[4]; float m, l; };

__device__ __forceinline__ void attn_sub(AttnState& st, const LAS unsigned char* lds, int sub, int lane, int qidx, int k0, int dmax, bool lanesel) {
    const int q15 = lane & 15, g = lane >> 4;
    const LAS unsigned char* kb = lds + AT_K + (sub * 32 + q15) * AT_ROW + g * 16;
    f32x4 s0 = {0.f, 0.f, 0.f, 0.f}, s1 = {0.f, 0.f, 0.f, 0.f};
#pragma unroll
    for (int ks = 0; ks < 2; ++ks) {
        const bf16x8 a0 = *(const LAS bf16x8*)(kb + ks * 64), a1 = *(const LAS bf16x8*)(kb + 16 * AT_ROW + ks * 64);
        s0 = __builtin_amdgcn_mfma_f32_16x16x32_bf16(a0, st.qf[ks], s0, 0, 0, 0);
        s1 = __builtin_amdgcn_mfma_f32_16x16x32_bf16(a1, st.qf[ks], s1, 0, 0, 0);
    }
    const LAS float* lut = (const LAS float*)(lds + AT_LUT);
    float sc[8]; const int dbase = qidx - (k0 + sub * 32 + 4 * g);
#pragma unroll
    for (int r = 0; r < 8; ++r) {
        const int d = dbase - (r & 3) - (r >> 2) * 16;
        const bool ok = lanesel && d >= 0 && d <= dmax;
        const int dc = d < 0 ? 0 : (d > dmax ? dmax : d);
        const float v = ((r < 4) ? s0[r & 3] : s1[r & 3]) * LOG2E + lut[dc];
        sc[r] = ok ? v : -INFINITY;
    }
    float mx = fmaxf(fmaxf(fmaxf(sc[0], sc[1]), fmaxf(sc[2], sc[3])), fmaxf(fmaxf(sc[4], sc[5]), fmaxf(sc[6], sc[7])));
    mx = fmaxf(mx, __shfl_xor(mx, 16)); mx = fmaxf(mx, __shfl_xor(mx, 32));
    const float mn = fmaxf(st.m, mx), mu = (mn == -INFINITY) ? 0.f : mn;
    const float alpha = __builtin_amdgcn_exp2f(st.m - mu);
    float p[8], ps = 0.f;
#pragma unroll
    for (int r = 0; r < 8; ++r) { p[r] = __builtin_amdgcn_exp2f(sc[r] - mu); ps += p[r]; }
    st.l = st.l * alpha + ps; st.m = mn;
    if (!__all(alpha == 1.f)) {
#pragma unroll
        for (int n = 0; n < 4; ++n) st.ot[n] *= alpha;
    }
    v4u pw; pw.x = pkbf(p[0], p[1]); pw.y = pkbf(p[2], p[3]); pw.z = pkbf(p[4], p[5]); pw.w = pkbf(p[6], p[7]);
    const bf16x8 pb = __builtin_bit_cast(bf16x8, pw);
    const LAS unsigned char* vb = lds + AT_V + (sub * 32 + 4 * g + (q15 >> 2)) * AT_ROW + (q15 & 3) * 8;
#pragma unroll
    for (int n = 0; n < 4; ++n) {
        const v4i16 r1 = tr16(vb + n * 32), r2 = tr16(vb + 16 * AT_ROW + n * 32);
        st.ot[n] = __builtin_amdgcn_mfma_f32_16x16x32_bf16(mk8(r1, r2), pb, st.ot[n], 0, 0, 0);
    }
}

struct ChunkRegs { v4u k0, k1, v0, v1; };
__device__ __forceinline__ void chunk_fetch(ChunkRegs& c, const bf16* kbase  , int kstride_tok, int tid) {
    const int r0 = tid >> 3, cc = tid & 7;
    const bf16* p0 = kbase + (size_t)(r0 * kstride_tok) * NQKV + cc * 8; const bf16* p1 = kbase + (size_t)((r0 + 64) * kstride_tok) * NQKV + cc * 8;
    c.k0 = *(const v4u*)p0; c.k1 = *(const v4u*)p1; c.v0 = *(const v4u*)(p0 + 512); c.v1 = *(const v4u*)(p1 + 512);
}
__device__ __forceinline__ void chunk_store(const ChunkRegs& c, LAS unsigned char* lds, int tid) {
    const int r0 = tid >> 3, cc = tid & 7;
    *(LAS v4u*)(lds + AT_K + r0 * AT_ROW + cc * 16) = c.k0; *(LAS v4u*)(lds + AT_K + (r0 + 64) * AT_ROW + cc * 16) = c.k1;
    *(LAS v4u*)(lds + AT_V + r0 * AT_ROW + cc * 16) = c.v0; *(LAS v4u*)(lds + AT_V + (r0 + 64) * AT_ROW + cc * 16) = c.v1;
}
__device__ __forceinline__ void attn_init(AttnState& st, const bf16* qrow  , int lane) {
    const int g = lane >> 4;
    st.qf[0] = *(const bf16x8*)(qrow + 8 * g); st.qf[1] = *(const bf16x8*)(qrow + 32 + 8 * g);
#pragma unroll
    for (int n = 0; n < 4; ++n) st.ot[n] = (f32x4){0.f, 0.f, 0.f, 0.f};
    st.m = -INFINITY; st.l = 0.f;
}
__device__ __forceinline__ float attn_finish(AttnState& st, bf16* orow  , int lane) {
    float l = st.l; l += __shfl_xor(l, 16); l += __shfl_xor(l, 32);
    const float inv = 1.f / l; const int g = lane >> 4;
#pragma unroll
    for (int n = 0; n < 4; ++n) { v2u w; w.x = pkbf(st.ot[n][0] * inv, st.ot[n][1] * inv); w.y = pkbf(st.ot[n][2] * inv, st.ot[n][3] * inv);
        *(v2u*)(orow + 16 * n + 4 * g) = w; }
    return l;
}

__device__ __forceinline__ void moba_item(const Args& a, LAS unsigned char* lds, int item, int tid, int lane, int wave) {
    unsigned char* ws = a.ws; const bf16* QKV = (const bf16*)(ws + WS_QKV);
    const int qblk = 7 - (item >> 7), idx = item & 127, bh = idx >> 1, b = bh >> 3, h = bh & 7, qt = 2 * qblk + (idx & 1);
    const size_t tokb = (size_t)b * SEQ;
    LAS float* lut = (LAS float*)(lds + AT_LUT); LAS float* gates = (LAS float*)(lds + AT_GATE); LAS unsigned* selm = (LAS unsigned*)(lds + AT_SEL); LAS unsigned* anyw = (LAS unsigned*)(lds + AT_ANY);
    __syncthreads();
    for (int d = tid; d < 2048; d += NTHR) lut[d] = a.in[5][h * 32 + t5_bucket(d)] * LOG2E;
    if (tid == 0) *anyw = 0u;
    unsigned anysel;
    if (qblk > 3) {
        {
            const int qi = tid & 127, gi = tid >> 7;
            const bf16* qp = QKV + (tokb + qt * 128 + qi) * NQKV + h * 64;
            float ga = 0.f, gb = 0.f; const float* kma = (const float*)(ws + WS_KMEAN) + ((b * 8 + h) * 8 + gi) * 64; const float* kmb = kma + 4 * 64;
#pragma unroll
            for (int i = 0; i < 8; ++i) { const v4u w = *(const v4u*)(qp + 8 * i); float qv[8]; unpack8(w, qv);
#pragma unroll
                for (int j = 0; j < 8; ++j) { ga += qv[j] * kma[8 * i + j]; gb += qv[j] * kmb[8 * i + j]; } }
            gates[qi * 8 + gi] = ga; gates[qi * 8 + gi + 4] = gb;
        }
        __syncthreads();
        if (tid < 128) {
            float gv[8];
#pragma unroll
            for (int n = 0; n < 8; ++n) gv[n] = (n < qblk) ? gates[tid * 8 + n] : -INFINITY;
            unsigned sel = 0;
#pragma unroll
            for (int r = 0; r < 3; ++r) { float best = -INFINITY; int bi = 0;
#pragma unroll
                for (int n = 0; n < 8; ++n) { const bool take = !((sel >> n) & 1u) && (gv[n] > best); best = take ? gv[n] : best; bi = take ? n : bi; }
                sel |= 1u << bi; }
            selm[tid] = sel; atomicOr((unsigned*)anyw, sel);
        }
        __syncthreads();
        anysel = *anyw;
    } else { anysel = (1u << qblk) - 1u; __syncthreads(); }
    const unsigned mysel = (qblk > 3) ? selm[wave * 16 + (lane & 15)] : anysel;
    unsigned cm = 0;
    for (int n = 0; n < qblk; ++n) if ((anysel >> n) & 1u) cm |= 3u << (2 * n);
    cm |= 1u << (2 * qblk); if (qt & 1) cm |= 2u << (2 * qblk);
    const int qpos = qt * 128 + wave * 16 + (lane & 15), wq_hi = qt * 128 + wave * 16 + 15;
    AttnState st; attn_init(st, QKV + (tokb + qpos) * NQKV + h * 64, lane);
    ChunkRegs cr; const bf16* kcol = QKV + tokb * NQKV + 512 + h * 64;
    { const int c0 = __builtin_ctz(cm); chunk_fetch(cr, kcol + (size_t)(c0 * 128) * NQKV, 1, tid); }
    while (cm) {
        const int cur = __builtin_ctz(cm); cm &= cm - 1u;
        __syncthreads();
        chunk_store(cr, lds, tid);
        __syncthreads();
        if (cm) { const int nx = __builtin_ctz(cm); chunk_fetch(cr, kcol + (size_t)(nx * 128) * NQKV, 1, tid); }
        const int n = cur >> 1, k0 = cur * 128; const bool own = (n == qblk);
        const bool lsel = own || ((mysel >> n) & 1u);
        if (own || __any(lsel)) {
#pragma unroll 1
            for (int sub = 0; sub < 4; ++sub) {
                if (k0 + sub * 32 > wq_hi) break;
                attn_sub(st, lds, sub, lane, qpos, k0, 2047, lsel);
            }
        }
    }
    attn_finish(st, (bf16*)(ws + WS_YA) + (tokb + qpos) * 512 + h * 64, lane);
}

__device__ __forceinline__ void dil_item(const Args& a, LAS unsigned char* lds, int item, int tid, int lane, int wave) {
    unsigned char* ws = a.ws; const bf16* QKV = (const bf16*)(ws + WS_QKV);
    const int grp = item >> 4, sub16 = item & 15, br = grp % 3, bh = grp / 3, b = bh >> 3, h = bh & 7;
    const int dil = (br == 0) ? 1 : (br == 1 ? 4 : 16);
    const int r = (br == 0) ? 0 : (br == 1 ? (sub16 >> 2) : sub16), j = (br == 0) ? sub16 : (br == 1 ? (sub16 & 3) : 0);
    const size_t tokb = (size_t)b * SEQ;
    LAS float* lut = (LAS float*)(lds + AT_LUT);
    __syncthreads();
    for (int d = tid; d <= 128; d += NTHR) lut[d] = a.in[5][(8 + h) * 32 + t5_bucket(d * dil)] * LOG2E;
    const int lq = 128 * j + wave * 16 + (lane & 15);
    const size_t qtok = tokb + (size_t)lq * dil + r;
    AttnState st; attn_init(st, QKV + qtok * NQKV + 1536 + h * 64, lane);
    ChunkRegs cr; const bf16* kcol = QKV + (tokb + r) * NQKV + 2048 + h * 64;
    const int c_first = (j > 0) ? 0 : 1;
    chunk_fetch(cr, kcol + (size_t)((128 * (j - 1 + c_first)) * dil) * NQKV, dil, tid);
#pragma unroll 1
    for (int c = c_first; c < 2; ++c) {
        __syncthreads();
        chunk_store(cr, lds, tid);
        __syncthreads();
        if (c == 0) chunk_fetch(cr, kcol + (size_t)((128 * j) * dil) * NQKV, dil, tid);
        const int k0 = 128 * (j - 1 + c), wh = wave >> 1;
        const int s_lo = (c == 0) ? wh : 0, s_hi = (c == 0) ? 3 : wh;
#pragma unroll 1
        for (int sub = s_lo; sub <= s_hi; ++sub) attn_sub(st, lds, sub, lane, lq, k0, 128, true);
    }
    bf16* ob = (bf16*)(ws + (br == 0 ? WS_OB0 : (br == 1 ? WS_OB1 : WS_OB2)));
    const float l = attn_finish(st, ob + qtok * 512 + h * 64, lane);
    if ((lane >> 4) == 0) ((float*)(ws + WS_LSE))[((size_t)br * T + qtok) * 8 + h] = st.m + __builtin_amdgcn_logf(l);
}

__device__ __forceinline__ void p4_attn(const Args& a, LAS unsigned char* lds, int G, int tid, int lane, int wave) {
    for (int v = blockIdx.x; v < 256; v += G) {
        moba_item(a, lds, v, tid, lane, wave);
        moba_item(a, lds, 256 + v, tid, lane, wave);
        moba_item(a, lds, 767 - v, tid, lane, wave);
        moba_item(a, lds, 1023 - v, tid, lane, wave);
#pragma unroll 1
        for (int i = 0; i < 12; ++i) dil_item(a, lds, v * 12 + i, tid, lane, wave);
    }
}

__device__ __forceinline__ void p5_combine_rms(const Args& a, int G, int lane, int wave) {
    unsigned char* ws = a.ws; const bf16* YA = (const bf16*)(ws + WS_YA);
    const bf16* OB0 = (const bf16*)(ws + WS_OB0); const bf16* OB1 = (const bf16*)(ws + WS_OB1); const bf16* OB2 = (const bf16*)(ws + WS_OB2);
    const float* LSE = (const float*)(ws + WS_LSE); bf16* A2 = (bf16*)a.out;
    for (int row = blockIdx.x * NWAVES + wave; row < T; row += G * NWAVES) {
        float v[8], o0[8], o1[8], o2[8];
        unpack8(*(const v4u*)(YA + (size_t)row * 512 + 8 * lane), v);
        unpack8(*(const v4u*)(OB0 + (size_t)row * 512 + 8 * lane), o0); unpack8(*(const v4u*)(OB1 + (size_t)row * 512 + 8 * lane), o1); unpack8(*(const v4u*)(OB2 + (size_t)row * 512 + 8 * lane), o2);
        const int h = lane >> 3;
        const float l0 = LSE[((size_t)0 * T + row) * 8 + h], l1 = LSE[((size_t)1 * T + row) * 8 + h], l2 = LSE[((size_t)2 * T + row) * 8 + h];
        const float mx = fmaxf(l0, fmaxf(l1, l2));
        float w0 = __builtin_amdgcn_exp2f(l0 - mx), w1 = __builtin_amdgcn_exp2f(l1 - mx), w2 = __builtin_amdgcn_exp2f(l2 - mx);
        const float inv = 1.f / (w0 + w1 + w2); w0 *= inv; w1 *= inv; w2 *= inv;
        float ssa = 0.f, ssb = 0.f;
#pragma unroll
        for (int j = 0; j < 8; ++j) { o0[j] = w0 * o0[j] + w1 * o1[j] + w2 * o2[j]; ssa += v[j] * v[j]; ssb += o0[j] * o0[j]; }
        ssa = wave_sum(ssa); ssb = wave_sum(ssb);
        const float ra = rsqrtf(ssa * (1.f / 512.f) + LN_EPS), rb = rsqrtf(ssb * (1.f / 512.f) + LN_EPS);
        v4u o; o.x = pkbf(v[0] * ra, v[1] * ra); o.y = pkbf(v[2] * ra, v[3] * ra); o.z = pkbf(v[4] * ra, v[5] * ra); o.w = pkbf(v[6] * ra, v[7] * ra);
        *(v4u*)(A2 + (size_t)row * DM + 8 * lane) = o;
        o.x = pkbf(o0[0] * rb, o0[1] * rb); o.y = pkbf(o0[2] * rb, o0[3] * rb); o.z = pkbf(o0[4] * rb, o0[5] * rb); o.w = pkbf(o0[6] * rb, o0[7] * rb);
        *(v4u*)(A2 + (size_t)row * DM + 512 + 8 * lane) = o;
    }
}
__device__ __forceinline__ void load16(const float* p, int lane, float (&v)[16]) {
#pragma unroll
    for (int q = 0; q < 4; ++q) { const f32x4 t = *(const f32x4*)(p + (q >> 1) * 512 + 8 * lane + (q & 1) * 4); v[4 * q] = t.x; v[4 * q + 1] = t.y; v[4 * q + 2] = t.z; v[4 * q + 3] = t.w; }
}
__device__ __forceinline__ void store16(float* p, int lane, const float (&v)[16]) {
#pragma unroll
    for (int q = 0; q < 4; ++q) { f32x4 t; t.x = v[4 * q]; t.y = v[4 * q + 1]; t.z = v[4 * q + 2]; t.w = v[4 * q + 3]; *(f32x4*)(p + (q >> 1) * 512 + 8 * lane + (q & 1) * 4) = t; }
}
__device__ __forceinline__ void layer_norm16(float (&z)[16], const float* g, const float* bta, int lane) {
    float s = 0.f;
#pragma unroll
    for (int j = 0; j < 16; ++j) s += z[j];
    const float mu = wave_sum(s) * (1.f / DM); float q = 0.f;
#pragma unroll
    for (int j = 0; j < 16; ++j) { z[j] -= mu; q += z[j] * z[j]; }
    const float rs = rsqrtf(wave_sum(q) * (1.f / DM) + LN_EPS);
    float gg[16], bb[16]; load16(g, lane, gg); load16(bta, lane, bb);
#pragma unroll
    for (int j = 0; j < 16; ++j) z[j] = z[j] * rs * gg[j] + bb[j];
}

__device__ __forceinline__ void p7_ln1(const Args& a, int G, int lane, int wave) {
    unsigned char* ws = a.ws; const float* x = a.in[0]; const float* Y = (const float*)(ws + WS_QKV); const float* mod = (const float*)(ws + WS_MOD);
    float* x1 = a.out; bf16* H2 = (bf16*)(ws + WS_H);
    for (int row = blockIdx.x * NWAVES + wave; row < T; row += G * NWAVES) {
        const int b = row >> 11; float z[16], y[16], t[16];
        load16(x + (size_t)row * DM, lane, z); load16(Y + (size_t)row * DM, lane, y); load16(mod + b * 6144 + 2048, lane, t);
#pragma unroll
        for (int j = 0; j < 16; ++j) z[j] = DN_ALPHA * z[j] + (1.f + t[j]) * y[j];
        layer_norm16(z, a.in[9], a.in[10], lane);
        store16(x1 + (size_t)row * DM, lane, z);
        load16(mod + b * 6144 + 4096, lane, y); load16(mod + b * 6144 + 3072, lane, t);
#pragma unroll
        for (int j = 0; j < 16; ++j) z[j] = z[j] * (1.f + y[j]) + t[j];
        v4u o0, o1; o0.x = pk2(z[0], z[1]); o0.y = pk2(z[2], z[3]); o0.z = pk2(z[4], z[5]); o0.w = pk2(z[6], z[7]);
        o1.x = pk2(z[8], z[9]); o1.y = pk2(z[10], z[11]); o1.z = pk2(z[12], z[13]); o1.w = pk2(z[14], z[15]);
        *(v4u*)(H2 + (size_t)row * DM + 8 * lane) = o0; *(v4u*)(H2 + (size_t)row * DM + 512 + 8 * lane) = o1;
    }
}

__device__ __forceinline__ unsigned mono(float s) { const unsigned u = __float_as_uint(s); return u ^ ((unsigned)((int)u >> 31) | 0x80000000u); }
__device__ __forceinline__ float unmono(unsigned k) { return __uint_as_float((k & 0x80000000u) ? (k ^ 0x80000000u) : ~k); }
__device__ __forceinline__ void ins16(unsigned (&t)[16], unsigned x) {
#pragma unroll
    for (int j = 0; j < 16; ++j) { const unsigned hi = t[j] > x ? t[j] : x; x = t[j] > x ? x : t[j]; t[j] = hi; }
}
__device__ __forceinline__ unsigned lookup8(unsigned long long lo, unsigned long long hi, int idx) {
    const unsigned long long w = (idx & 8) ? hi : lo;
    return (unsigned)(w >> ((idx & 7) * 8)) & 0xffu;
}
template <int N> __device__ __forceinline__ void sort_desc(unsigned (&a)[N]) {
#pragma unroll
    for (int k = 2; k <= N; k <<= 1)
#pragma unroll
        for (int j = k >> 1; j > 0; j >>= 1)
#pragma unroll
            for (int i = 0; i < N; ++i) { const int l = i ^ j;
                if (l > i) { const unsigned x = a[i], y = a[l], hi = x > y ? x : y, lo = x > y ? y : x;
                    if ((i & k) == 0) { a[i] = hi; a[l] = lo; } else { a[i] = lo; a[l] = hi; } } }
}
__device__ __forceinline__ void merge_top16(unsigned (&a)[16], const unsigned (&b)[16]) {
#pragma unroll
    for (int i = 0; i < 16; ++i) a[i] = a[i] > b[15 - i] ? a[i] : b[15 - i];
#pragma unroll
    for (int j = 8; j > 0; j >>= 1)
#pragma unroll
        for (int i = 0; i < 16; ++i) { const int l = i ^ j; if (l > i) { const unsigned x = a[i], y = a[l]; a[i] = x > y ? x : y; a[l] = x > y ? y : x; } }
}
__device__ __forceinline__ void xmerge(unsigned (&a)[16], int mask) {
    unsigned b[16];
#pragma unroll
    for (int i = 0; i < 16; ++i) b[i] = (unsigned)__shfl_xor((int)a[i], mask);
    merge_top16(a, b);
}
constexpr int TK_ROW = 144;
__device__ __forceinline__ void p9_topk(const Args& a, LAS unsigned char* lds, int G, int tid) {
    unsigned char* ws = a.ws; const float* QP = (const float*)(ws + WS_QKV); const float* sub_keys = a.in[12];
    int* elist = (int*)(ws + WS_ATT); float* glist = (float*)(ws + WS_ATT + 8 * MiB);
    const int lane = tid & 63, wave = tid >> 6, c = lane & 15, g = lane >> 4;
    for (int i = tid; i < 256 * 8; i += NTHR) { const int row = i >> 3, ch = i & 7;
        const f32x4 p = *(const f32x4*)(sub_keys + row * 64 + ch * 8), q = *(const f32x4*)(sub_keys + row * 64 + ch * 8 + 4);
        const float v[8] = {p.x, p.y, p.z, p.w, q.x, q.y, q.z, q.w}; float r[8]; v4u hi, lo;
        hi.x = pkbf(v[0], v[1]); hi.y = pkbf(v[2], v[3]); hi.z = pkbf(v[4], v[5]); hi.w = pkbf(v[6], v[7]);
        r[0] = v[0] - bflo(hi.x); r[1] = v[1] - bfhi(hi.x); r[2] = v[2] - bflo(hi.y); r[3] = v[3] - bfhi(hi.y);
        r[4] = v[4] - bflo(hi.z); r[5] = v[5] - bfhi(hi.z); r[6] = v[6] - bflo(hi.w); r[7] = v[7] - bfhi(hi.w);
        lo.x = pkbf(r[0], r[1]); lo.y = pkbf(r[2], r[3]); lo.z = pkbf(r[4], r[5]); lo.w = pkbf(r[6], r[7]);
        *(LAS v4u*)(lds + row * TK_ROW + ch * 16) = hi; *(LAS v4u*)(lds + 256 * TK_ROW + row * TK_ROW + ch * 16) = lo; }
    __syncthreads();
    for (int task = blockIdx.x * NWAVES + wave; task < T / 2; task += G * NWAVES) {
        const int tok = task * 2 + (c >> 3), head = c & 7;
        unsigned T1[16], T2[16];
#pragma unroll 1
        for (int hf = 0; hf < 2; ++hf) {
            bf16x8 qh[2], ql[2];
#pragma unroll
            for (int ks = 0; ks < 2; ++ks) {
                const float* qp = QP + (size_t)tok * DM + head * 128 + hf * 64 + ks * 32 + 8 * g;
                const f32x4 p = *(const f32x4*)qp, q = *(const f32x4*)(qp + 4);
                v4u hi, lo; hi.x = pkbf(p.x, p.y); hi.y = pkbf(p.z, p.w); hi.z = pkbf(q.x, q.y); hi.w = pkbf(q.z, q.w);
                lo.x = pkbf(p.x - bflo(hi.x), p.y - bfhi(hi.x)); lo.y = pkbf(p.z - bflo(hi.y), p.w - bfhi(hi.y));
                lo.z = pkbf(q.x - bflo(hi.z), q.y - bfhi(hi.z)); lo.w = pkbf(q.z - bflo(hi.w), q.w - bfhi(hi.w));
                qh[ks] = __builtin_bit_cast(bf16x8, hi); ql[ks] = __builtin_bit_cast(bf16x8, lo);
            }
            unsigned P[32];
#pragma unroll
            for (int kt = 0; kt < 8; ++kt) {
                f32x4 acc = {0.f, 0.f, 0.f, 0.f};
#pragma unroll
                for (int ks = 0; ks < 2; ++ks) {
                    const LAS unsigned char* kp = lds + (hf * 128 + kt * 16 + c) * TK_ROW + ks * 64 + g * 16;
                    const bf16x8 kh = *(const LAS bf16x8*)kp, kl = *(const LAS bf16x8*)(kp + 256 * TK_ROW);
                    acc = __builtin_amdgcn_mfma_f32_16x16x32_bf16(kh, qh[ks], acc, 0, 0, 0);
                    acc = __builtin_amdgcn_mfma_f32_16x16x32_bf16(kl, qh[ks], acc, 0, 0, 0);
                    acc = __builtin_amdgcn_mfma_f32_16x16x32_bf16(kh, ql[ks], acc, 0, 0, 0);
                }
#pragma unroll
                for (int r = 0; r < 4; ++r) P[kt * 4 + r] = (mono(acc[r]) & ~127u) | (unsigned)(127 - (kt * 16 + r)) ;
            }
#pragma unroll
            for (int i = 0; i < 32; ++i) P[i] -= (unsigned)(4 * g);
            unsigned A[16], B[16];
#pragma unroll
            for (int i = 0; i < 16; ++i) { A[i] = P[i]; B[i] = P[16 + i]; }
            __builtin_amdgcn_sched_barrier(0);
            sort_desc<16>(A); __builtin_amdgcn_sched_barrier(0); sort_desc<16>(B); __builtin_amdgcn_sched_barrier(0); merge_top16(A, B);
            __builtin_amdgcn_sched_barrier(0);
            xmerge(A, 16); __builtin_amdgcn_sched_barrier(0); xmerge(A, 32); __builtin_amdgcn_sched_barrier(0);
#pragma unroll
            for (int i = 0; i < 16; ++i) { if (hf == 0) T1[i] = A[i]; else T2[i] = A[i]; }
        }
        float v1[16], v2[16]; unsigned long long i1lo = 0, i1hi = 0, i2lo = 0, i2hi = 0;
#pragma unroll
        for (int j = 0; j < 16; ++j) {
            v1[j] = unmono(T1[j] & ~127u); v2[j] = unmono(T2[j] & ~127u);
            const unsigned long long s1 = (unsigned long long)(127u - (T1[j] & 127u)) << ((j & 7) * 8), s2 = (unsigned long long)(127u - (T2[j] & 127u)) << ((j & 7) * 8);
            if (j < 8) { i1lo |= s1; i2lo |= s2; } else { i1hi |= s1; i2hi |= s2; }
        }
        unsigned top[16];
#pragma unroll
        for (int j = 0; j < 16; ++j) top[j] = (mono(v1[0] + v2[j]) & ~255u) | (unsigned)(255 - j);
#pragma unroll
        for (int aa = 1; aa < 16; ++aa)
#pragma unroll
            for (int bb = 0; bb < 16; ++bb)
                if ((aa + 1) * (bb + 1) <= 16) ins16(top, (mono(v1[aa] + v2[bb]) & ~255u) | (unsigned)(255 - (aa * 16 + bb)));
        if (g == 0) {
            float vals[16]; int ex[16]; float sum = 0.f;
            const float vmax = unmono(top[0] & ~255u);
#pragma unroll
            for (int r = 0; r < 16; ++r) { const int pos = 255 - (int)(top[r] & 255u);
                ex[r] = (int)(lookup8(i1lo, i1hi, pos >> 4) * 128u + lookup8(i2lo, i2hi, pos & 15));
                vals[r] = __expf(unmono(top[r] & ~255u) - vmax); sum += vals[r]; }
            const float inv = 1.f / sum; const size_t p = (size_t)tok * 8 + head;
#pragma unroll
            for (int r = 0; r < 4; ++r) {
                *(int4*)(elist + p * 16 + 4 * r) = make_int4(ex[4 * r], ex[4 * r + 1], ex[4 * r + 2], ex[4 * r + 3]);
                f32x4 gg; gg.x = vals[4 * r] * inv; gg.y = vals[4 * r + 1] * inv; gg.z = vals[4 * r + 2] * inv; gg.w = vals[4 * r + 3] * inv;
                *(f32x4*)(glist + p * 16 + 4 * r) = gg;
            }
        }
    }
}

typedef float f32x2 __attribute__((ext_vector_type(2)));
template <int CTRL> __device__ __forceinline__ float dppf(float v) { return __builtin_bit_cast(float, __builtin_amdgcn_update_dpp(0, __builtin_bit_cast(int, v), CTRL, 0xf, 0xf, false)); }
__device__ __forceinline__ float wave_total(float v) {
    v += dppf<0xB1>(v); v += dppf<0x4E>(v); v += dppf<0x141>(v); v += dppf<0x140>(v);
    const int iv = __builtin_bit_cast(int, v);
    return (__builtin_bit_cast(float, __builtin_amdgcn_readlane(iv, 0)) + __builtin_bit_cast(float, __builtin_amdgcn_readlane(iv, 16)))
         + (__builtin_bit_cast(float, __builtin_amdgcn_readlane(iv, 32)) + __builtin_bit_cast(float, __builtin_amdgcn_readlane(iv, 48)));
}
__device__ __forceinline__ float gelu1(float v) {
    const float av = fabsf(v), t = __builtin_amdgcn_rcpf(av * 0.2316418882f + 1.0f);
    float q = t * 0.5307027145f + (-0.7265760135f); q = q * t + 0.7107068705f; q = q * t + (-0.142248368f); q = q * t + 0.127414796f; q = q * t;
    const float e = __builtin_amdgcn_exp2f((v * v) * (-0.72134752044f)), m = v * (q * e);
    return v < 0.f ? m : v - m;
}
__device__ __forceinline__ void peer_slice(const float (&x)[16], float (&f)[16], int e0, int e1, float g0, float g1, int s,
                                           const unsigned char* U8, const unsigned char* V8, int lane) {
    unsigned long long m0 = __ballot((e0 >> 10) == s), m1 = __ballot((e1 >> 10) == s);
    while (m0 | m1) {
        int ee[4]; float gg[4];
#pragma unroll
        for (int k = 0; k < 4; ++k) {
            if (m0) { const int ix = __builtin_ctzll(m0); m0 &= m0 - 1; ee[k] = __builtin_amdgcn_readlane(e0, ix); gg[k] = __builtin_bit_cast(float, __builtin_amdgcn_readlane(__builtin_bit_cast(int, g0), ix)); }
            else if (m1) { const int ix = __builtin_ctzll(m1); m1 &= m1 - 1; ee[k] = __builtin_amdgcn_readlane(e1, ix); gg[k] = __builtin_bit_cast(float, __builtin_amdgcn_readlane(__builtin_bit_cast(int, g1), ix)); }
            else { ee[k] = ee[0]; gg[k] = 0.f; }
        }
        v4u ur[4], vr[4];
#pragma unroll
        for (int k = 0; k < 4; ++k) { ur[k] = *(const v4u*)(U8 + (size_t)ee[k] * 1024 + 16 * lane); vr[k] = *(const v4u*)(V8 + (size_t)ee[k] * 1024 + 16 * lane); }
        float act[4];
#pragma unroll
        for (int k = 0; k < 4; ++k) {
            f32x2 acc = {0.f, 0.f};
#pragma unroll
            for (int q = 0; q < 4; ++q) {
                const f32x2 lo = __builtin_amdgcn_cvt_pk_f32_fp8((int)ur[k][q], false), hi = __builtin_amdgcn_cvt_pk_f32_fp8((int)ur[k][q], true);
                acc += lo * (f32x2){x[4 * q], x[4 * q + 1]}; acc += hi * (f32x2){x[4 * q + 2], x[4 * q + 3]};
            }
            act[k] = acc.x + acc.y;
            __builtin_amdgcn_sched_barrier(0);
        }
#pragma unroll
        for (int k = 0; k < 4; ++k) act[k] = gelu1(wave_total(act[k]) * (1.f / PEER_USCALE)) * gg[k];
#pragma unroll
        for (int k = 0; k < 4; ++k) {
#pragma unroll
            for (int q = 0; q < 4; ++q) {
                const f32x2 lo = __builtin_amdgcn_cvt_pk_f32_fp8((int)vr[k][q], false), hi = __builtin_amdgcn_cvt_pk_f32_fp8((int)vr[k][q], true);
                f[4 * q] += act[k] * lo.x; f[4 * q + 1] += act[k] * lo.y; f[4 * q + 2] += act[k] * hi.x; f[4 * q + 3] += act[k] * hi.y;
            }
            __builtin_amdgcn_sched_barrier(0);
        }
    }
}
__device__ __forceinline__ void ld16c(const float* p, float (&v)[16]) {
#pragma unroll
    for (int q = 0; q < 4; ++q) { const f32x4 t = ((const f32x4*)p)[q]; v[4 * q] = t.x; v[4 * q + 1] = t.y; v[4 * q + 2] = t.z; v[4 * q + 3] = t.w; }
}
__device__ __forceinline__ void p10_peer(const Args& a, int G, int lane, int wave) {
    unsigned char* ws = a.ws; const unsigned char* U8 = ws + WS_U; const unsigned char* V8 = ws + WS_V;
    const int* elist = (const int*)(ws + WS_ATT); const float* glist = (const float*)(ws + WS_ATT + 8 * MiB);
    const float* mod = (const float*)(ws + WS_MOD); float* out = a.out;
    const int NGW = G * NWAVES;
    for (int grp = blockIdx.x * NWAVES + wave; grp < T / 4; grp += NGW) {
        const int tok0 = grp * 4, b = tok0 >> 11;
        float x[4][16], f[4][16]; int e0[4], e1[4]; float g0[4], g1[4];
        {
            float sc[16], sh[16]; ld16c(mod + b * 6144 + 4096 + 16 * lane, sc); ld16c(mod + b * 6144 + 3072 + 16 * lane, sh);
#pragma unroll
            for (int t = 0; t < 4; ++t) {
                ld16c(out + (size_t)(tok0 + t) * DM + 16 * lane, x[t]);
#pragma unroll
                for (int j = 0; j < 16; ++j) { x[t][j] = x[t][j] * (1.f + sc[j]) + sh[j]; f[t][j] = 0.f; }
                e0[t] = elist[(size_t)(tok0 + t) * 128 + lane]; e1[t] = elist[(size_t)(tok0 + t) * 128 + 64 + lane];
                g0[t] = glist[(size_t)(tok0 + t) * 128 + lane]; g1[t] = glist[(size_t)(tok0 + t) * 128 + 64 + lane];
            }
        }
#pragma unroll 1
        for (int s = 0; s < 16; ++s) {
#pragma unroll
            for (int t = 0; t < 4; ++t) peer_slice(x[t], f[t], e0[t], e1[t], g0[t], g1[t], s, U8, V8, lane);
        }
        float g2[16], lg[16], lb[16];
        ld16c(mod + b * 6144 + 5120 + 16 * lane, g2); ld16c(a.in[15] + 16 * lane, lg); ld16c(a.in[16] + 16 * lane, lb);
#pragma unroll
        for (int t = 0; t < 4; ++t) {
            float z[16]; ld16c(out + (size_t)(tok0 + t) * DM + 16 * lane, z);
            float sm = 0.f;
#pragma unroll
            for (int j = 0; j < 16; ++j) { z[j] = DN_ALPHA * z[j] + (1.f + g2[j]) * f[t][j]; sm += z[j]; }
            const float mu = wave_total(sm) * (1.f / DM); float q = 0.f;
#pragma unroll
            for (int j = 0; j < 16; ++j) { z[j] -= mu; q += z[j] * z[j]; }
            const float rs = rsqrtf(wave_total(q) * (1.f / DM) + LN_EPS);
#pragma unroll
            for (int q4 = 0; q4 < 4; ++q4) { f32x4 o; o.x = z[4 * q4] * rs * lg[4 * q4] + lb[4 * q4]; o.y = z[4 * q4 + 1] * rs * lg[4 * q4 + 1] + lb[4 * q4 + 1];
                o.z = z[4 * q4 + 2] * rs * lg[4 * q4 + 2] + lb[4 * q4 + 2]; o.w = z[4 * q4 + 3] * rs * lg[4 * q4 + 3] + lb[4 * q4 + 3];
                ((f32x4*)(out + (size_t)(tok0 + t) * DM + 16 * lane))[q4] = o; }
        }
    }
}

constexpr int N_PHASES = 11;
__global__ void __launch_bounds__(NTHR, 2) mega(Args args) {
    extern __shared__ __attribute__((aligned(16))) unsigned char lds_raw[];
    LAS unsigned char* lds = (LAS unsigned char*)lds_raw;
    const int tid = threadIdx.x, lane = tid & 63, wave = __builtin_amdgcn_readfirstlane(tid >> 6), G = gridDim.x;
    unsigned char* ws = args.ws;
    volatile LAS unsigned* MISC = (volatile LAS unsigned*)(lds + MISC_OFF);
    for (int u = tid; u < (LDS_BYTES - RING_BYTES) / 4; u += NTHR) ((LAS unsigned*)(lds + RING_BYTES))[u] = 0u;
    __syncthreads();
    const int lo = args.ph_lo, hi = args.ph_hi;
    unsigned* barw = (unsigned*)(ws + WS_CTL) + CW_BAR + args.bar_idx * XCD_BAR_WORDS;
    XcdBarrier bar; bar.bar = barw; bar.x = 0; bar.st = nullptr;
    if (hi - lo > 1) bar = xcd_barrier_post(barw, MISC + 8);
#define IN(k) (lo <= (k) && (k) < hi)
#define REPS(k) ((PROBE_PH == (k)) ? 1 + PROBE_N : 1)
#define REPBAR(k, rep) do { if ((rep) + 1 < REPS(k)) xcd_barrier(bar); } while (0)
#define SEAM(k) do { if (IN(k) && IN((k) + 1)) xcd_barrier(bar); } while (0)

    if (IN(0)) { for (int rep = 0; rep < REPS(0); ++rep) { p0_prologue(args, lds, G, tid, lane, wave); REPBAR(0, rep); } } SEAM(0);
    if (IN(1)) { for (int rep = 0; rep < REPS(1); ++rep) { p1_mod_h(args, lds, G, tid, lane, wave); REPBAR(1, rep); } } SEAM(1);
    if (IN(2)) { for (int rep = 0; rep < REPS(2); ++rep) {
        __syncthreads();
        pg8::Gemm g{(const pg8::bf16_t*)(ws + WS_H), (const pg8::bf16_t*)(ws + WS_WIN), T, NQKV, DM};
        pg8::StaticOrder S; S.init(T, NQKV, G, (int)blockIdx.x);
        pg8::EpiBf16<0> E{(pg8::bf16_t*)(ws + WS_QKV), NQKV, nullptr, 0, 0};
        pg8::gemm_phase<pg8::EpiBf16<0>, pg8::StaticOrder, false>(lds, g, S, E, nullptr);
        REPBAR(2, rep); }
    } SEAM(2);
    if (IN(3)) { p3_kmean(args, lds, G, tid); } SEAM(3);
    if (IN(4)) { for (int rep = 0; rep < REPS(4); ++rep) { p4_attn(args, lds, G, tid, lane, wave); REPBAR(4, rep); } } SEAM(4);
    if (IN(5)) { for (int rep = 0; rep < REPS(5); ++rep) { p5_combine_rms(args, G, lane, wave); REPBAR(5, rep); } } SEAM(5);
    if (IN(6)) { for (int rep = 0; rep < REPS(6); ++rep) {
        __syncthreads();
        pg8::Gemm g{(const pg8::bf16_t*)args.out, (const pg8::bf16_t*)(ws + WS_WOUT), T, DM, DM};
        pg8::StaticOrder S; S.init(T, DM, G, (int)blockIdx.x);
        pg8::EpiF32 E{(float*)(ws + WS_QKV), DM, nullptr};
        pg8::gemm_phase<pg8::EpiF32, pg8::StaticOrder, false>(lds, g, S, E, nullptr);
        REPBAR(6, rep); }
    } SEAM(6);
    if (IN(7)) { for (int rep = 0; rep < REPS(7); ++rep) { p7_ln1(args, G, lane, wave); REPBAR(7, rep); } } SEAM(7);
    if (IN(8)) { for (int rep = 0; rep < REPS(8); ++rep) {
        __syncthreads();
        pg8::Gemm g{(const pg8::bf16_t*)(ws + WS_H), (const pg8::bf16_t*)(ws + WS_WQ), T, DM, DM};
        pg8::StaticOrder S; S.init(T, DM, G, (int)blockIdx.x);
        pg8::EpiF32 E{(float*)(ws + WS_QKV), DM, nullptr};
        pg8::gemm_phase<pg8::EpiF32, pg8::StaticOrder, false>(lds, g, S, E, nullptr);
        REPBAR(8, rep); }
    } SEAM(8);
    if (IN(9)) { for (int rep = 0; rep < REPS(9); ++rep) { __syncthreads(); p9_topk(args, lds, G, tid); REPBAR(9, rep); } } SEAM(9);
    if (IN(10)) { p10_peer(args, G, lane, wave); }
#undef IN
#undef SEAM
}
}

#ifndef MK_N_LAUNCHES
#define MK_N_LAUNCHES 1
#endif

extern "C" void kernel_launch(void* const* d_in, const int* in_sizes, int n_in, void* d_out, int out_size, void* d_ws, size_t ws_size, hipStream_t stream) {
    static int grid = 0;
    if (!grid) {
        int dev = 0, cus = 0, per_cu = 0;
        if (hipGetDevice(&dev) != hipSuccess || hipDeviceGetAttribute(&cus, hipDeviceAttributeMultiprocessorCount, dev) != hipSuccess) { fprintf(stderr, "kernel_launch: device query failed\n"); return; }
        if (hipFuncSetAttribute((const void*)mk::mega, hipFuncAttributeMaxDynamicSharedMemorySize, mk::LDS_BYTES) != hipSuccess) { fprintf(stderr, "kernel_launch: hipFuncSetAttribute failed\n"); return; }
        if (hipOccupancyMaxActiveBlocksPerMultiprocessor(&per_cu, (const void*)mk::mega, mk::NTHR, mk::LDS_BYTES) != hipSuccess || per_cu < 1) { fprintf(stderr, "kernel_launch: occupancy query says %d\n", per_cu); return; }
        grid = cus;
    }
    if (n_in != 17 || ws_size < mk::WS_END) { fprintf(stderr, "kernel_launch: unexpected n_in %d / ws %zu\n", n_in, ws_size); return; }
    (void)hipMemsetAsync((char*)d_ws + mk::WS_CTL, 0, mk::CTL_ZERO_BYTES, stream);
    mk::Args a{};
    for (int i = 0; i < 17; ++i) a.in[i] = (const float*)d_in[i];
    a.out = (float*)d_out; a.ws = (unsigned char*)d_ws;
    a.ph_lo = 0; a.ph_hi = mk::N_PHASES;
    hipLaunchKernelGGL(mk::mega, dim3(grid), dim3(mk::NTHR), mk::LDS_BYTES, stream, a);
}
```

```cpp
#include <hip/hip_runtime.h>
#include <stdint.h>
#include <math.h>
#include <stdio.h>
namespace pg8 {
#define PG8_LAS __attribute__((address_space(3)))
typedef unsigned short bf16_t;
typedef short bf16x8 __attribute__((ext_vector_type(8)));
typedef float f32x4 __attribute__((ext_vector_type(4)));
typedef unsigned u32x4 __attribute__((ext_vector_type(4)));
constexpr int BM = 256, BK = 64, HALF = 128, HTB = HALF * BK * 2  , STAGE_BYTES = 8 * HTB, NXCD = 8, WGM = 8;

__host__ __device__ __forceinline__ int lds_byte(int r, int c) { const int st = (r >> 4) * 2 + (c >> 5), rr = r & 15, cc = c & 31, ob = rr * 64 + cc * 2; return st * 1024 + (ob ^ (((ob >> 9) & 1) << 5)); }
__host__ __device__ __forceinline__ void stage_rc(int b, int& R, int& C) { const int st = b / 1024, sb = b % 1024, swz = sb ^ (((sb >> 9) & 1) << 5); R = (st >> 1) * 16 + swz / 64; C = (st & 1) * 32 + (swz % 64) / 2; }
__host__ __device__ __forceinline__ int perm32(int rho) { const int n = rho >> 4, i = rho & 15; return 8 * (i >> 2) + 4 * n + (i & 3); }

struct Unit { int pm, pn; };
struct Gemm { const bf16_t* A; const bf16_t* Bt; int M, N, K; };

struct StaticOrder {
    int nM, nN, nwg, G, c;
    __host__ __device__ void init(int M, int N, int G_, int c_) { nM = M / BM; nN = N / BM; nwg = nM * nN; G = G_; c = c_; }
    __host__ __device__ bool next(int i, Unit& u) const {
        const long L = (long)i * G + c; if (L >= nwg) return false;
        int wgid = (int)L; { const int q = nwg / NXCD, r = nwg % NXCD, xcd = wgid % NXCD, off = wgid / NXCD; wgid = (xcd < r ? xcd * (q + 1) : r * (q + 1) + (xcd - r) * q) + off; }
        const int nig = WGM * nN, gid = wgid / nig, fm = gid * WGM, gsz = (nM - fm) < WGM ? (nM - fm) : WGM;
        u.pm = fm + ((wgid % nig) % gsz); u.pn = (wgid % nig) / gsz; return true;
    }
    __device__ __forceinline__ void a_ready(const Unit&) const {}
    __device__ __forceinline__ void done(const Unit&) const {}
};
struct CountedOrder : StaticOrder {
    const unsigned* ready; unsigned need; unsigned* tmo;
    __device__ __forceinline__ void a_ready(const Unit& u) const {
        if (threadIdx.x < 64) {
            const unsigned long long t0 = __builtin_amdgcn_s_memrealtime(); unsigned polls = 0;
            while ((unsigned)__builtin_amdgcn_readfirstlane(__hip_atomic_load(ready + 64 * u.pm, __ATOMIC_RELAXED, __HIP_MEMORY_SCOPE_AGENT)) < need) {
                if ((++polls & 255u) == 0u && __builtin_amdgcn_readfirstlane(__hip_atomic_load(tmo, __ATOMIC_RELAXED, __HIP_MEMORY_SCOPE_AGENT)) != 0u) break;
                if (__builtin_amdgcn_s_memrealtime() - t0 > 2000000ull) {
                    if (threadIdx.x == 0) { unsigned expect = 0u; __hip_atomic_compare_exchange_strong(tmo + 1, &expect, 0x600u | (unsigned)(u.pm & 0xff), __ATOMIC_RELAXED, __ATOMIC_RELAXED, __HIP_MEMORY_SCOPE_AGENT); __hip_atomic_store(tmo, 1u, __ATOMIC_RELAXED, __HIP_MEMORY_SCOPE_AGENT); }
                    break; }
                __builtin_amdgcn_s_sleep(2); }
            __builtin_amdgcn_fence(__ATOMIC_ACQUIRE, "agent");
            asm volatile("s_waitcnt vmcnt(0)" ::: "memory");
        }
#if !defined(BROKEN_HOOK_NO_BARRIER)
        asm volatile("" ::: "memory"); __builtin_amdgcn_s_barrier(); asm volatile("" ::: "memory");
#endif
    }
};

__device__ __forceinline__ unsigned cvt_pk_bf16(float lo, float hi) { unsigned r; asm volatile("v_cvt_pk_bf16_f32 %0, %1, %2" : "=v"(r) : "v"(lo), "v"(hi)); return r; }
typedef float f32x2 __attribute__((ext_vector_type(2)));
__device__ __forceinline__ f32x2 gelu_pk(f32x2 v) {
    const f32x2 av = __builtin_elementwise_abs(v), d = av * 0.2316418882f + 1.0f;
    f32x2 t; t.x = __builtin_amdgcn_rcpf(d.x); t.y = __builtin_amdgcn_rcpf(d.y);
    f32x2 q = t * 0.5307027145f + (-0.7265760135f); q = q * t + 0.7107068705f; q = q * t + (-0.142248368f); q = q * t + 0.127414796f; q = q * t;
    const f32x2 s = (v * v) * (-0.72134752044f);
    f32x2 e; e.x = __builtin_amdgcn_exp2f(s.x); e.y = __builtin_amdgcn_exp2f(s.y);
    const f32x2 m = v * (q * e), r = v - m;
    f32x2 o; o.x = v.x < 0.f ? m.x : r.x; o.y = v.y < 0.f ? m.y : r.y; return o;
}

struct EpiF32 {
    static constexpr bool PERM = false, AFTER_DRAIN = false;
    float* C; int ldc; const float* bias;
    __device__ __forceinline__ void operator()(const f32x4 (&acc)[2][2][4][2], const Unit& u, int wr, int wc, int fr, int fq) const {
        const int row0 = u.pm * BM + wr * 64 + fr, col0 = u.pn * BM + wc * 32 + 4 * fq;
        f32x4 bv[2][2];
#pragma unroll
        for (int bj = 0; bj < 2; ++bj)
#pragma unroll
            for (int n = 0; n < 2; ++n) bv[bj][n] = bias ? *(const f32x4*)(bias + col0 + bj * HALF + n * 16) : (f32x4){0.f, 0.f, 0.f, 0.f};
#pragma unroll
        for (int ai = 0; ai < 2; ++ai)
#pragma unroll
            for (int m = 0; m < 4; ++m) { float* rowp = C + (size_t)(row0 + ai * HALF + m * 16) * ldc + col0;
#pragma unroll
                for (int bj = 0; bj < 2; ++bj)
#pragma unroll
                    for (int n = 0; n < 2; ++n) *(f32x4*)(rowp + bj * HALF + n * 16) = acc[ai][bj][m][n] + bv[bj][n]; }
    }
};
template <int ACT  > struct EpiBf16 {
    static constexpr bool PERM = true, AFTER_DRAIN = false;
    bf16_t* O; int ldc; const float* bias; int split_cols; size_t split_stride;
    __device__ __forceinline__ void operator()(const f32x4 (&acc)[2][2][4][2], const Unit& u, int wr, int wc, int fr, int fq) const {
        const int row0 = u.pm * BM + wr * 64 + fr; int colt = u.pn * BM; bf16_t* base = O;
        if (split_cols) { const int t = colt / split_cols; base += (size_t)t * split_stride; colt -= t * split_cols; }
        const int col0 = colt + wc * 32 + 8 * fq, bcol0 = u.pn * BM + wc * 32 + 8 * fq;
        f32x4 bv[2][2];
#pragma unroll
        for (int bj = 0; bj < 2; ++bj)
#pragma unroll
            for (int n = 0; n < 2; ++n) bv[bj][n] = bias ? *(const f32x4*)(bias + bcol0 + bj * HALF + 4 * n) : (f32x4){0.f, 0.f, 0.f, 0.f};
#pragma unroll
        for (int ai = 0; ai < 2; ++ai)
#pragma unroll
            for (int m = 0; m < 4; ++m) { bf16_t* rowp = base + (size_t)(row0 + ai * HALF + m * 16) * ldc + col0;
#pragma unroll
                for (int bj = 0; bj < 2; ++bj) { f32x4 v0 = acc[ai][bj][m][0] + bv[bj][0], v1 = acc[ai][bj][m][1] + bv[bj][1];
                    if (ACT == 1) { f32x2 a = gelu_pk((f32x2){v0[0], v0[1]}), b = gelu_pk((f32x2){v0[2], v0[3]}), c = gelu_pk((f32x2){v1[0], v1[1]}), d = gelu_pk((f32x2){v1[2], v1[3]});
                        v0 = (f32x4){a.x, a.y, b.x, b.y}; v1 = (f32x4){c.x, c.y, d.x, d.y}; }
                    if (ACT == 2) {
#pragma unroll
                        for (int j = 0; j < 4; ++j) { v0[j] = 0.5f * v0[j] * (1.0f + erff(v0[j] * 0.70710678f)); v1[j] = 0.5f * v1[j] * (1.0f + erff(v1[j] * 0.70710678f)); } }
                    u32x4 w; w.x = cvt_pk_bf16(v0[0], v0[1]); w.y = cvt_pk_bf16(v0[2], v0[3]); w.z = cvt_pk_bf16(v1[0], v1[1]); w.w = cvt_pk_bf16(v1[2], v1[3]);
                    *(u32x4*)(rowp + bj * HALF) = w; } }
    }
};

struct PanelStats {
    unsigned* xbuf;
    unsigned* cnt;
    unsigned* tmo;
    int ntn; float eps;
    unsigned code;
    __device__ __forceinline__ bool run(const f32x4 (&v)[2][2][4][2], const Unit& u, int wr, int wc, int fr, int fq, PG8_LAS unsigned char* lds, int wid, int lane) const {
        typedef float f32x2v __attribute__((ext_vector_type(2)));
        PG8_LAS f32x2v* P = (PG8_LAS f32x2v*)lds;
        PG8_LAS f32x2v* S = (PG8_LAS f32x2v*)(lds + 8192);
        PG8_LAS unsigned* flag = (PG8_LAS unsigned*)(lds + 8192 + 2048);
#pragma unroll
        for (int ai = 0; ai < 2; ++ai)
#pragma unroll
            for (int m = 0; m < 4; ++m) {
                float s = 0.f;
#pragma unroll
                for (int bj = 0; bj < 2; ++bj)
#pragma unroll
                    for (int n = 0; n < 2; ++n) { const f32x4 x = v[ai][bj][m][n]; s += (x[0] + x[1]) + (x[2] + x[3]); }
                s += __shfl_xor(s, 16); s += __shfl_xor(s, 32);
                const float mw = s * (1.0f / 64.0f); float q = 0.f;
#pragma unroll
                for (int bj = 0; bj < 2; ++bj)
#pragma unroll
                    for (int n = 0; n < 2; ++n) { const f32x4 d = v[ai][bj][m][n] - mw; q += (d[0] * d[0] + d[1] * d[1]) + (d[2] * d[2] + d[3] * d[3]); }
                q += __shfl_xor(q, 16); q += __shfl_xor(q, 32);
                if (fq == 0) P[(ai * HALF + wr * 64 + m * 16 + fr) * 4 + wc] = (f32x2v){mw, q};
            }
        asm volatile("s_waitcnt lgkmcnt(0)" ::: "memory"); __builtin_amdgcn_s_barrier(); asm volatile("" ::: "memory");
#if defined(BROKEN_NO_WAIT)
        if (blockIdx.x >= 64) { const long long t0 = clock64(); while (clock64() - t0 < 60000) __builtin_amdgcn_s_sleep(8); }
#endif
        const int row = wid * 32 + (lane & 31);
        if (lane < 32) {
            const f32x2v a = P[row * 4 + 0], b = P[row * 4 + 1], c = P[row * 4 + 2], d = P[row * 4 + 3];
            const float mt = (a.x + b.x + c.x + d.x) * 0.25f;
            const float da = a.x - mt, db = b.x - mt, dc = c.x - mt, dd = d.x - mt;
            const float m2 = (a.y + b.y) + (c.y + d.y) + 64.0f * ((da * da + db * db) + (dc * dc + dd * dd));
            unsigned long long* slot = (unsigned long long*)xbuf + ((size_t)(u.pm * BM + row) * 4 + u.pn);
            __hip_atomic_store(slot, ((unsigned long long)__float_as_uint(m2) << 32) | __float_as_uint(mt), __ATOMIC_RELAXED, __HIP_MEMORY_SCOPE_AGENT);
        }
        asm volatile("s_waitcnt vmcnt(0)" ::: "memory");
        if (lane == 0) __hip_atomic_fetch_add(cnt + 64 * u.pm, 1u, __ATOMIC_RELAXED, __HIP_MEMORY_SCOPE_AGENT);
        if (wid == 0) {
            bool dead = false; const unsigned long long t0 = __builtin_amdgcn_s_memrealtime(); const unsigned want = 8u * (unsigned)ntn;
            for (;;) {
#if defined(BROKEN_NO_WAIT)
                break;
#endif
                if ((unsigned)__builtin_amdgcn_readfirstlane(__hip_atomic_load(cnt + 64 * u.pm, __ATOMIC_RELAXED, __HIP_MEMORY_SCOPE_AGENT)) >= want) break;
                if (__builtin_amdgcn_s_memrealtime() - t0 > 2000000ull) {
                    if (lane == 0) { unsigned expect = 0u; __hip_atomic_compare_exchange_strong(tmo + 1, &expect, code | (unsigned)(u.pm & 0xff), __ATOMIC_RELAXED, __ATOMIC_RELAXED, __HIP_MEMORY_SCOPE_AGENT);
                                     __hip_atomic_store(tmo, 1u, __ATOMIC_RELAXED, __HIP_MEMORY_SCOPE_AGENT); }
                    dead = true; break; }
                __builtin_amdgcn_s_sleep(2);
            }
            __builtin_amdgcn_fence(__ATOMIC_ACQUIRE, "agent");
            if (lane == 0) flag[0] = dead ? 1u : 0u;
        }
        asm volatile("s_waitcnt vmcnt(0) lgkmcnt(0)" ::: "memory"); __builtin_amdgcn_s_barrier(); asm volatile("" ::: "memory");
        const bool bad = flag[0] != 0u;
        if (lane < 32) {
            const unsigned long long* slot = (const unsigned long long*)xbuf + (size_t)(u.pm * BM + row) * 4; float mt[4], m2[4]; float ms = 0.f;
#pragma unroll
            for (int t = 0; t < 4; ++t) { if (t < ntn) { const unsigned long long w = __hip_atomic_load(slot + t, __ATOMIC_RELAXED, __HIP_MEMORY_SCOPE_AGENT); mt[t] = __uint_as_float((unsigned)w); m2[t] = __uint_as_float((unsigned)(w >> 32)); } else { mt[t] = 0.f; m2[t] = 0.f; } ms += mt[t]; }
            const float mean = ms / (float)ntn; float q = 0.f;
#pragma unroll
            for (int t = 0; t < 4; ++t) if (t < ntn) { const float dm = mt[t] - mean; q += m2[t] + 256.0f * dm * dm; }
            S[row] = (f32x2v){mean, 1.0f / sqrtf(q / (256.0f * (float)ntn) + eps)};
        }
        asm volatile("s_waitcnt lgkmcnt(0)" ::: "memory"); __builtin_amdgcn_s_barrier(); asm volatile("" ::: "memory");
        return bad;
    }
};
struct EpiLnRes {
    static constexpr bool PERM = false, AFTER_DRAIN = true;
    const float* base; float* out; int ldc; const float* bias; PanelStats st; unsigned poison;
    __device__ __forceinline__ void refuse(size_t i0, size_t stride, int M, int N) const { const float q = __builtin_nanf(""); for (size_t i = i0; i < (size_t)M * N; i += stride) out[(i / N) * ldc + i % N] = q;
        if (i0 == 0) { unsigned expect = 0u; __hip_atomic_compare_exchange_strong(st.tmo + 1, &expect, 0x7f0u, __ATOMIC_RELAXED, __ATOMIC_RELAXED, __HIP_MEMORY_SCOPE_AGENT); __hip_atomic_store(st.tmo, 1u, __ATOMIC_RELAXED, __HIP_MEMORY_SCOPE_AGENT); } }
    __device__ __forceinline__ void fused(f32x4 (&acc)[2][2][4][2], const Unit& u, int wr, int wc, int fr, int fq, PG8_LAS unsigned char* lds, int wid, int lane) const {
        typedef float f32x2v __attribute__((ext_vector_type(2)));
        const PG8_LAS f32x2v* S = (const PG8_LAS f32x2v*)(lds + 8192);
        const int col0 = u.pn * BM + wc * 32 + 4 * fq;
#pragma unroll
        for (int bj = 0; bj < 2; ++bj)
#pragma unroll
            for (int n = 0; n < 2; ++n) { const f32x4 bv = bias ? *(const f32x4*)(bias + col0 + bj * HALF + n * 16) : (f32x4){0.f, 0.f, 0.f, 0.f};
#pragma unroll
                for (int ai = 0; ai < 2; ++ai)
#pragma unroll
                    for (int m = 0; m < 4; ++m) acc[ai][bj][m][n] += bv; }
        const bool bad = st.run(acc, u, wr, wc, fr, fq, lds, wid, lane) || poison != 0u;
        const float qnan = __builtin_nanf("");
#pragma unroll
        for (int ai = 0; ai < 2; ++ai)
#pragma unroll
            for (int m = 0; m < 4; ++m) { const int r = ai * HALF + wr * 64 + m * 16 + fr; const f32x2v sr = S[r]; const size_t off = (size_t)(u.pm * BM + r) * ldc + col0;
#pragma unroll
                for (int bj = 0; bj < 2; ++bj)
#pragma unroll
                    for (int n = 0; n < 2; ++n) { const f32x4 bs = *(const f32x4*)(base + off + bj * HALF + n * 16); f32x4 o = bs + (acc[ai][bj][m][n] - sr.x) * sr.y;
                        if (bad) o = (f32x4){qnan, qnan, qnan, qnan}; *(f32x4*)(out + off + bj * HALF + n * 16) = o; }
                asm volatile("" ::: "memory"); }
    }
};
struct EpiLnResLn {
    static constexpr bool PERM = false, AFTER_DRAIN = true;
    const float* base; float* out; bf16_t* xn; int ldc; const float* bias; PanelStats st1, st2; unsigned poison;
    __device__ __forceinline__ void refuse(size_t i0, size_t stride, int M, int N) const { const float q = __builtin_nanf(""); for (size_t i = i0; i < (size_t)M * N; i += stride) { const size_t o = (i / N) * ldc + i % N; out[o] = q; xn[o] = (bf16_t)0x7fc0u; }
        if (i0 == 0) { unsigned expect = 0u; __hip_atomic_compare_exchange_strong(st1.tmo + 1, &expect, 0x7f0u, __ATOMIC_RELAXED, __ATOMIC_RELAXED, __HIP_MEMORY_SCOPE_AGENT); __hip_atomic_store(st1.tmo, 1u, __ATOMIC_RELAXED, __HIP_MEMORY_SCOPE_AGENT); } }
    __device__ __forceinline__ void fused(f32x4 (&acc)[2][2][4][2], const Unit& u, int wr, int wc, int fr, int fq, PG8_LAS unsigned char* lds, int wid, int lane) const {
        typedef float f32x2v __attribute__((ext_vector_type(2))); typedef unsigned u32x2v __attribute__((ext_vector_type(2)));
        const PG8_LAS f32x2v* S = (const PG8_LAS f32x2v*)(lds + 8192);
        const int col0 = u.pn * BM + wc * 32 + 4 * fq;
#pragma unroll
        for (int bj = 0; bj < 2; ++bj)
#pragma unroll
            for (int n = 0; n < 2; ++n) { const f32x4 bv = bias ? *(const f32x4*)(bias + col0 + bj * HALF + n * 16) : (f32x4){0.f, 0.f, 0.f, 0.f};
#pragma unroll
                for (int ai = 0; ai < 2; ++ai)
#pragma unroll
                    for (int m = 0; m < 4; ++m) acc[ai][bj][m][n] += bv; }
        bool bad = st1.run(acc, u, wr, wc, fr, fq, lds, wid, lane) || poison != 0u;
        const float qnan = __builtin_nanf("");
#pragma unroll
        for (int ai = 0; ai < 2; ++ai)
#pragma unroll
            for (int m = 0; m < 4; ++m) { const int r = ai * HALF + wr * 64 + m * 16 + fr; const f32x2v sr = S[r]; const size_t off = (size_t)(u.pm * BM + r) * ldc + col0;
#pragma unroll
                for (int bj = 0; bj < 2; ++bj)
#pragma unroll
                    for (int n = 0; n < 2; ++n) { const f32x4 bs = *(const f32x4*)(base + off + bj * HALF + n * 16); acc[ai][bj][m][n] = bs + (acc[ai][bj][m][n] - sr.x) * sr.y; }
                asm volatile("" : "+v"(acc[ai][0][m][0]), "+v"(acc[ai][0][m][1]), "+v"(acc[ai][1][m][0]), "+v"(acc[ai][1][m][1]));
                if (m & 1) asm volatile("" ::: "memory"); }
        const bool bad1 = bad;
        bad = st2.run(acc, u, wr, wc, fr, fq, lds, wid, lane) || bad;
#pragma unroll
        for (int ai = 0; ai < 2; ++ai)
#pragma unroll
            for (int m = 0; m < 4; ++m) { const int r = ai * HALF + wr * 64 + m * 16 + fr; const f32x2v sr = S[r]; const size_t off = (size_t)(u.pm * BM + r) * ldc + col0;
#pragma unroll
                for (int bj = 0; bj < 2; ++bj)
#pragma unroll
                    for (int n = 0; n < 2; ++n) { const f32x4 x1 = acc[ai][bj][m][n]; *(f32x4*)(out + off + bj * HALF + n * 16) = bad1 ? (f32x4){qnan, qnan, qnan, qnan} : x1;
                        const f32x4 o = (x1 - sr.x) * sr.y; u32x2v w; w.x = cvt_pk_bf16(o[0], o[1]); w.y = cvt_pk_bf16(o[2], o[3]);
                        if (bad) { w.x = 0x7fc07fc0u; w.y = 0x7fc07fc0u; } *(u32x2v*)(xn + off + bj * HALF + n * 16) = w; }
                asm volatile("" ::: "memory"); }
    }
};

template <class Epi, class Sched, bool STAMP = false>
__device__ __forceinline__ void gemm_phase(PG8_LAS unsigned char* lds, const Gemm g, const Sched& S, const Epi& E, unsigned long long* stamps) {
    const int tid = threadIdx.x, wid = __builtin_amdgcn_readfirstlane(tid >> 6), lane = tid & 63, wr = wid >> 2, wc = wid & 3, fr = lane & 15, fq = lane >> 4;
    const int K = g.K, nt = K / BK;
    int ts_lo = 0, ts_hi = 0, nts = 0; const unsigned long long rt_entry = STAMP ? (unsigned long long)wall_clock64() : 0ull;
#define PG8_STAMP() do { if (STAMP && wid == 0 && nts < 64) { const unsigned long long _c = (unsigned long long)clock64(); \
        ts_lo = (lane == nts) ? (int)(unsigned)_c : ts_lo; ts_hi = (lane == nts) ? (int)(unsigned)(_c >> 32) : ts_hi; ++nts; } } while (0)
    PG8_STAMP();
    unsigned voffA[2], voffB[2];
#pragma unroll
    for (int i = 0; i < 2; ++i) { int R, C; stage_rc(tid * 16 + i * 8192, R, C); const int Rb = Epi::PERM ? ((R & ~31) + perm32(R & 31)) : R;
        voffA[i] = (unsigned)(R * K + C) * 2u; voffB[i] = (unsigned)(Rb * K + C) * 2u; }
    const size_t kstep = (size_t)(BK * 2);
    const size_t hstep = (size_t)HALF * K * 2;
    const size_t tstep = 2 * hstep;
    const unsigned ldsw = (unsigned)wid * 1024u;
    const int aoff = lds_byte(wr * 64 + fr, fq * 8), boff = lds_byte(wc * 32 + fr, fq * 8);
#define PG8_SA(b, h) (((b) * 2 + (h)) * HTB)
#define PG8_SB(b, h) ((4 + (b) * 2 + (h)) * HTB)
#define PG8_STAGE(bufoff, gbase, voff) do { _Pragma("unroll") for (int _i = 0; _i < 2; ++_i) \
        __builtin_amdgcn_global_load_lds((const unsigned*)((const char*)(gbase) + (voff)[_i]), (PG8_LAS unsigned*)(lds + (bufoff) + ldsw + _i * 8192), 16, 0, 0); } while (0)
#define PG8_LDA(dst, b, h) do { _Pragma("unroll") for (int m = 0; m < 4; ++m) _Pragma("unroll") for (int k = 0; k < 2; ++k) dst[m][k] = *(const PG8_LAS bf16x8*)(lds + PG8_SA(b, h) + aoff + m * 2048 + k * 1024); } while (0)
#define PG8_LDB(dst, b, h) do { _Pragma("unroll") for (int n = 0; n < 2; ++n) _Pragma("unroll") for (int k = 0; k < 2; ++k) dst[n][k] = *(const PG8_LAS bf16x8*)(lds + PG8_SB(b, h) + boff + n * 2048 + k * 1024); } while (0)
#define PG8_MMA(ai, bj, At, Bt) do { __builtin_amdgcn_s_setprio(1); _Pragma("unroll") for (int m = 0; m < 4; ++m) _Pragma("unroll") for (int n = 0; n < 2; ++n) _Pragma("unroll") for (int k = 0; k < 2; ++k) \
        acc[ai][bj][m][n] = __builtin_amdgcn_mfma_f32_16x16x32_bf16(Bt[n][k], At[m][k], acc[ai][bj][m][n], 0, 0, 0); __builtin_amdgcn_s_setprio(0); } while (0)
#define PG8_WAIT_V(n) asm volatile("s_waitcnt vmcnt(" #n ")" ::: "memory")
#define PG8_WAIT_L(n) asm volatile("s_waitcnt lgkmcnt(" #n ")" ::: "memory")
#define PG8_BAR __builtin_amdgcn_s_barrier()
#define PG8_SCHED __builtin_amdgcn_sched_barrier(0)
    Unit cur, nxt; int ui = 0;
    if (!S.next(0, cur)) return;
    f32x4 acc[2][2][4][2];
#pragma unroll
    for (int a = 0; a < 2; ++a)
#pragma unroll
        for (int b = 0; b < 2; ++b)
#pragma unroll
            for (int m = 0; m < 4; ++m)
#pragma unroll
                for (int n = 0; n < 2; ++n) acc[a][b][m][n] = (f32x4){0.f, 0.f, 0.f, 0.f};
    bf16x8 At[4][2], B0[2][2], B1[2][2];
    const char* cA = (const char*)g.A + (size_t)cur.pm * tstep; const char* cB = (const char*)g.Bt + (size_t)cur.pn * tstep;
    S.a_ready(cur);
    PG8_STAGE(PG8_SB(0, 0), cB, voffB); PG8_STAGE(PG8_SA(0, 0), cA, voffA); PG8_STAGE(PG8_SB(0, 1), cB + hstep, voffB); PG8_STAGE(PG8_SA(0, 1), cA + hstep, voffA);
    if (wr == 1) PG8_BAR;
    PG8_WAIT_V(4); PG8_BAR;
    PG8_STAGE(PG8_SB(1, 0), cB + kstep, voffB); PG8_STAGE(PG8_SA(1, 0), cA + kstep, voffA); PG8_STAGE(PG8_SB(1, 1), cB + hstep + kstep, voffB);
    PG8_WAIT_V(6); PG8_BAR;
    PG8_STAMP();
    for (;;) {
        const bool has_next = S.next(ui + 1, nxt);
        const char* nA = has_next ? (const char*)g.A + (size_t)nxt.pm * tstep : cA; const char* nB = has_next ? (const char*)g.Bt + (size_t)nxt.pn * tstep : cB;
        for (int t = 0; t < nt; t += 2) {
            const bool last = (t == nt - 2);
            const char* a1 = cA + (size_t)(t + 1) * kstep;
            const char* a2 = last ? nA : cA + (size_t)(t + 2) * kstep; const char* b2 = last ? nB : cB + (size_t)(t + 2) * kstep;
            const char* a3 = a2 + kstep; const char* b3 = b2 + kstep;
            if (last && has_next) S.a_ready(nxt);
            PG8_LDB(B0, 0, 0); PG8_SCHED; PG8_LDA(At, 0, 0); PG8_STAGE(PG8_SA(1, 1), a1 + hstep, voffA);
            PG8_WAIT_L(8); PG8_BAR; PG8_WAIT_L(0); PG8_MMA(0, 0, At, B0); PG8_BAR; PG8_SCHED;
            PG8_LDB(B1, 0, 1); PG8_STAGE(PG8_SB(0, 0), b2, voffB);
            PG8_BAR; PG8_WAIT_L(0); PG8_MMA(0, 1, At, B1); PG8_BAR;
            PG8_LDA(At, 0, 1); PG8_STAGE(PG8_SA(0, 0), a2, voffA);
            PG8_BAR; PG8_WAIT_L(0); PG8_MMA(1, 0, At, B0); PG8_BAR; PG8_SCHED;
            PG8_STAGE(PG8_SB(0, 1), b2 + hstep, voffB);
            PG8_WAIT_V(6); PG8_BAR; PG8_MMA(1, 1, At, B1); PG8_BAR;
            PG8_LDB(B0, 1, 0); PG8_SCHED; PG8_LDA(At, 1, 0); PG8_STAGE(PG8_SA(0, 1), a2 + hstep, voffA);
            PG8_WAIT_L(8); PG8_BAR; PG8_WAIT_L(0); PG8_MMA(0, 0, At, B0); PG8_BAR; PG8_SCHED;
            PG8_LDB(B1, 1, 1); PG8_STAGE(PG8_SB(1, 0), b3, voffB);
            PG8_BAR; PG8_WAIT_L(0); PG8_MMA(0, 1, At, B1); PG8_BAR;
            PG8_LDA(At, 1, 1); PG8_STAGE(PG8_SA(1, 0), a3, voffA);
            PG8_BAR; PG8_WAIT_L(0); PG8_MMA(1, 0, At, B0); PG8_BAR; PG8_SCHED;
            PG8_STAGE(PG8_SB(1, 1), b3 + hstep, voffB);
            PG8_WAIT_V(6); PG8_BAR; PG8_MMA(1, 1, At, B1); PG8_BAR;
        }
        PG8_STAMP();
        if constexpr (!Epi::AFTER_DRAIN) { E(acc, cur, wr, wc, fr, fq); S.done(cur); }
        PG8_STAMP();
        if (!has_next) break;
#pragma unroll
        for (int a = 0; a < 2; ++a)
#pragma unroll
            for (int b = 0; b < 2; ++b)
#pragma unroll
                for (int m = 0; m < 4; ++m)
#pragma unroll
                    for (int n = 0; n < 2; ++n) acc[a][b][m][n] = (f32x4){0.f, 0.f, 0.f, 0.f};
        cur = nxt; cA = nA; cB = nB; ++ui;
    }
    PG8_WAIT_V(0);
    if (wr == 0) PG8_BAR;
    PG8_BAR;
    if constexpr (Epi::AFTER_DRAIN) { E.fused(acc, cur, wr, wc, fr, fq, lds, wid, lane); S.done(cur); }
    PG8_STAMP();
    if (STAMP && wid == 0) { stamps[lane] = lane < nts ? (((unsigned long long)(unsigned)ts_hi << 32) | (unsigned)ts_lo) : 0ull;
        if (lane == 62) stamps[62] = rt_entry; if (lane == 63) stamps[63] = (unsigned long long)wall_clock64(); }
#undef PG8_STAMP
#undef PG8_SA
#undef PG8_SB
#undef PG8_STAGE
#undef PG8_LDA
#undef PG8_LDB
#undef PG8_MMA
#undef PG8_WAIT_V
#undef PG8_WAIT_L
#undef PG8_BAR
#undef PG8_SCHED
}
}
#define XB_TMO      128
#define XB_XCNT(j)  (256  + 64 * (j))
#define XB_XSUB(j)  (1280 + 64 * (j))
#define XB_XGEN(j)  (2304 + 64 * (j))
#define XB_TOP      3328
#define XB_TOPGEN   3392
#define XCD_BAR_WORDS 3456
#define XB_SPIN_CAP (1u << 18)
#define LAS __attribute__((address_space(3)))

__device__ __forceinline__ unsigned xb_ld(unsigned* p)              { return __hip_atomic_load(p, __ATOMIC_RELAXED, __HIP_MEMORY_SCOPE_AGENT); }
__device__ __forceinline__ unsigned xb_add(unsigned* p, unsigned v) { return __hip_atomic_fetch_add(p, v, __ATOMIC_RELAXED, __HIP_MEMORY_SCOPE_AGENT); }
__device__ __forceinline__ unsigned xb_xcc_id() { return (unsigned)__builtin_amdgcn_s_getreg((3 << 11) | 20) & 0xFu; }
#define XB_SPIN(cond, bar) do { unsigned _sp = 0; while (cond) { __builtin_amdgcn_s_sleep(1); \
    if ((++_sp & 255u) == 0u) { if (xb_ld(&(bar)[XB_TMO])) break; if (_sp > XB_SPIN_CAP) { atomicAdd(&(bar)[XB_TMO], 1u); break; } } } } while (0)

struct XcdBarrier {
    unsigned* bar; unsigned x;
    volatile LAS unsigned* st;
};

__device__ __forceinline__ XcdBarrier xcd_barrier_post(unsigned* bar, volatile LAS unsigned* st) {
    XcdBarrier b; b.bar = bar; b.x = xb_xcc_id(); b.st = st;
    if (threadIdx.x == 0) (void)xb_add(&bar[XB_XCNT(b.x)], 1u);
    return b;
}
__device__ __forceinline__ void xcd_barrier_complete(unsigned* bar, unsigned x, unsigned& nloc, unsigned& nx) {
    const unsigned G = gridDim.x * gridDim.y * gridDim.z;
    unsigned sum, cnt, mine, sp = 0u;
    for (;;) {
        sum = 0u; cnt = 0u; mine = 0u;
#pragma unroll
        for (unsigned j = 0; j < 16; ++j) { const unsigned c = xb_ld(&bar[XB_XCNT(j)]); sum += c; cnt += (c > 0u) ? 1u : 0u; mine = (j == x) ? c : mine; }
        if (sum == G) break;
        __builtin_amdgcn_s_sleep(1);
        if ((++sp & 255u) == 0u) { if (xb_ld(&bar[XB_TMO])) break; if (sp > XB_SPIN_CAP) { atomicAdd(&bar[XB_TMO], 1u); break; } }
    }
    nloc = mine > 0u ? mine : 1u; nx = cnt > 0u ? cnt : 1u;
}

__device__ __forceinline__ void xcd_barrier(const XcdBarrier& b) {
    asm volatile("s_waitcnt vmcnt(0)" ::: "memory");
    __syncthreads();
    if (threadIdx.x == 0) {
        unsigned* bar = b.bar;
        __builtin_amdgcn_s_waitcnt(0);
        unsigned nloc = b.st[0], nx = b.st[1];
        if (nloc == 0u) { xcd_barrier_complete(bar, b.x, nloc, nx); b.st[0] = nloc; b.st[1] = nx; }
        const unsigned old = xb_add(&bar[XB_XSUB(b.x)], 1u);
        const unsigned gen = old / nloc;
        if (old + 1u == (gen + 1u) * nloc) {
            __builtin_amdgcn_fence(__ATOMIC_RELEASE, "agent");
            asm volatile("s_waitcnt vmcnt(0)" ::: "memory");
            const unsigned og = xb_add(&bar[XB_TOP], 1u);
            const unsigned tg = og / nx;
            if (og + 1u == (tg + 1u) * nx) xb_add(&bar[XB_TOPGEN], 1u);
            else XB_SPIN(xb_ld(&bar[XB_TOPGEN]) == tg, bar);
            __builtin_amdgcn_fence(__ATOMIC_ACQUIRE, "agent");
            xb_add(&bar[XB_XGEN(b.x)], 1u);
            asm volatile("s_waitcnt vmcnt(0)" ::: "memory");
        } else {
            XB_SPIN(xb_ld(&bar[XB_XGEN(b.x)]) == gen, bar);
            __builtin_amdgcn_fence(__ATOMIC_ACQUIRE, "agent");
            asm volatile("s_waitcnt vmcnt(0)" ::: "memory");
        }
    }
    __syncthreads();
}

#ifndef PROBE_PH
#define PROBE_PH -1
#define PROBE_N 0
#endif
namespace mk {
typedef unsigned short bf16;
typedef unsigned v4u __attribute__((ext_vector_type(4)));
typedef unsigned v2u __attribute__((ext_vector_type(2)));
typedef float f32x4 __attribute__((ext_vector_type(4)));
typedef short bf16x8 __attribute__((ext_vector_type(8)));
typedef __bf16 bf16x2 __attribute__((ext_vector_type(2)));

constexpr int NB = 8, SEQ = 2048, DM = 1024, T = NB * SEQ, NQKV = 3072;
constexpr float LN_EPS = 1e-5f;
constexpr float DN_ALPHA = 1.189207115002721f;
constexpr int NWAVES = 8, NTHR = 512;

constexpr size_t MiB = 1u << 20;
constexpr size_t WS_CTL = 0;
constexpr size_t CTL_ZERO_BYTES = 64 * 1024;
constexpr size_t WS_MODP = 1 * MiB;
constexpr size_t WS_MOD = 4 * MiB;
constexpr size_t WS_KMEAN = 4 * MiB + 256 * 1024;
constexpr size_t WS_WIN = 5 * MiB;
constexpr size_t WS_WOUT = 11 * MiB;
constexpr size_t WS_WQ = 13 * MiB;
constexpr size_t WS_U = 16 * MiB;
constexpr size_t WS_V = 48 * MiB;
constexpr size_t WS_H = 80 * MiB;
constexpr size_t WS_QKV = 112 * MiB;
constexpr size_t WS_ATT = 208 * MiB;
constexpr size_t WS_END = 256 * MiB;
constexpr int CW_BAR = 4096;
constexpr float PEER_USCALE = 32.f;

constexpr int RING_BYTES = 131072;
constexpr int MISC_OFF = RING_BYTES + 320;
constexpr int LDS_BYTES = 147456;

__device__ __forceinline__ unsigned f2bf(float f) { unsigned u = __float_as_uint(f); return (u + 0x7fffu + ((u >> 16) & 1u)) >> 16; }
__device__ __forceinline__ unsigned pk2(float lo, float hi) { return f2bf(lo) | (f2bf(hi) << 16); }
__device__ __forceinline__ float bflo(unsigned w) { return __uint_as_float(w << 16); }
__device__ __forceinline__ float bfhi(unsigned w) { return __uint_as_float(w & 0xffff0000u); }
__device__ __forceinline__ float dot2(unsigned a, unsigned b, float acc) { return __builtin_amdgcn_fdot2_f32_bf16(__builtin_bit_cast(bf16x2, a), __builtin_bit_cast(bf16x2, b), acc, false); }
__device__ __forceinline__ float wave_sum(float v) {
#pragma unroll
    for (int o = 1; o < 64; o <<= 1) v += __shfl_xor(v, o);
    return v;
}
__device__ __forceinline__ int t5_bucket(int d) {
    if (d < 16) return d;
    int b = 16;
    b += (d >= 22); b += (d >= 30); b += (d >= 40); b += (d >= 54); b += (d >= 73); b += (d >= 99); b += (d >= 134); b += (d >= 182);
    b += (d >= 246); b += (d >= 332); b += (d >= 450); b += (d >= 609); b += (d >= 825); b += (d >= 1117); b += (d >= 1513);
    return b;
}

struct Args {
    const float* in[17]; float* out; unsigned char* ws; int ph_lo, ph_hi, bar_idx, pad;
};

template <int MODE>
__device__ __forceinline__ void transpose_item(const float* W, int K, int N, bf16* WT, LAS float* scr, int item, int lane, const float* gna, const float* gnb) {
    const int nblk = N / 32, kb = item / nblk, nb = item % nblk, k0 = 64 * kb, n0 = 32 * nb;
    float cs = 1.f;
    if (MODE == 1) { if (n0 < 512 || (n0 >= 1536 && n0 < 2048)) cs = 0.125f; }
#pragma unroll 8
    for (int i = 0; i < 32; ++i) { const int kk = 2 * i + (lane >> 5); float v = W[(size_t)(k0 + kk) * N + n0 + (lane & 31)] * cs;
        if (MODE == 2) { const int k = k0 + kk; v *= (k < 512) ? gna[k] : gnb[k - 512]; }
        scr[kk * 33 + (lane & 31)] = v; }
    asm volatile("s_waitcnt lgkmcnt(0)" ::: "memory");
    const int c = lane & 7;
#pragma unroll
    for (int j = 0; j < 4; ++j) { const int n = (lane >> 3) + 8 * j; const LAS float* s = scr + (8 * c) * 33 + n;
        v4u o; o.x = pk2(s[0 * 33], s[1 * 33]); o.y = pk2(s[2 * 33], s[3 * 33]); o.z = pk2(s[4 * 33], s[5 * 33]); o.w = pk2(s[6 * 33], s[7 * 33]);
        *(v4u*)(WT + (size_t)(n0 + n) * K + k0 + 8 * c) = o; }
    asm volatile("s_waitcnt lgkmcnt(0)" ::: "memory");
}

__device__ __forceinline__ void p0_prologue(const Args& a, LAS unsigned char* lds, int G, int tid, int lane, int wave) {
    unsigned char* ws = a.ws;
    {
        const float* c = a.in[1]; const float* w_ada = a.in[2]; float* modp = (float*)(ws + WS_MODP);
        LAS float* sc = (LAS float*)lds;
        for (int item = blockIdx.x; item < 192; item += G) {
            const int ks = item / 12, cb = item % 12;
            { const int b = tid >> 6, i = tid & 63; const float v = c[b * DM + ks * 64 + i]; sc[b * 64 + i] = v / (1.f + __expf(-v)); }
            __syncthreads();
            const int col = cb * 512 + tid;
            float acc[8];
#pragma unroll
            for (int b = 0; b < 8; ++b) acc[b] = 0.f;
#pragma unroll 8
            for (int i = 0; i < 64; ++i) { const float w = w_ada[(size_t)(ks * 64 + i) * 6144 + col];
#pragma unroll
                for (int b = 0; b < 8; ++b) acc[b] += sc[b * 64 + i] * w; }
#pragma unroll
            for (int b = 0; b < 8; ++b) modp[(size_t)(ks * 8 + b) * 6144 + col] = acc[b];
            __syncthreads();
        }
    }
    {
        LAS float* scr = (LAS float*)(lds + wave * 16384);
        const int gw = blockIdx.x * NWAVES + wave, NGW = G * NWAVES;
        constexpr int I_IN = 16 * 96, I_O = 16 * 32, I_Q = 16 * 32;
        for (int it = gw; it < I_IN + I_O + I_Q; it += NGW) {
            int r = it;
            if (r < I_IN) { transpose_item<1>(a.in[4], DM, NQKV, (bf16*)(ws + WS_WIN), scr, r, lane, nullptr, nullptr); continue; } r -= I_IN;
            if (r < I_O) { transpose_item<2>(a.in[8], DM, DM, (bf16*)(ws + WS_WOUT), scr, r, lane, a.in[6], a.in[7]); continue; } r -= I_O;
            transpose_item<0>(a.in[11], DM, DM, (bf16*)(ws + WS_WQ), scr, r, lane, nullptr, nullptr);
        }
    }
    {
        const size_t nthr = (size_t)G * NTHR, gt = (size_t)blockIdx.x * NTHR + tid;
        const size_t per = (size_t)16384 * 1024 / 16;
        for (size_t i = gt; i < 2 * per; i += nthr) {
            const bool second = i >= per; const size_t j = second ? i - per : i; const float sc = second ? 1.f : PEER_USCALE;
            const f32x4* src = (const f32x4*)(second ? a.in[14] : a.in[13]) + 4 * j;
            v4u o;
#pragma unroll
            for (int q = 0; q < 4; ++q) { const f32x4 p = src[q]; int w = 0;
                w = __builtin_amdgcn_cvt_pk_fp8_f32(p.x * sc, p.y * sc, w, false); w = __builtin_amdgcn_cvt_pk_fp8_f32(p.z * sc, p.w * sc, w, true); o[q] = (unsigned)w; }
            ((v4u*)(ws + (second ? WS_V : WS_U)))[j] = o;
        }
        float* km = (float*)(ws + WS_KMEAN);
        for (size_t i = gt; i < 32768; i += nthr) km[i] = 0.f;
    }
}

__device__ __forceinline__ void p1_mod_h(const Args& a, LAS unsigned char* lds, int G, int tid, int lane, int wave) {
    unsigned char* ws = a.ws;
    const float* modp = (const float*)(ws + WS_MODP); const float* b_ada = a.in[3];
    float* mod = (float*)(ws + WS_MOD);
    for (int i = blockIdx.x * NTHR + tid; i < 8 * 6144; i += G * NTHR) {
        const int b = i / 6144, j = i % 6144; float s = b_ada[j];
#pragma unroll
        for (int ks = 0; ks < 16; ++ks) s += modp[(size_t)(ks * 8 + b) * 6144 + j];
        mod[i] = s;
    }
    LAS float* sm = (LAS float*)lds;
    const float* x = a.in[0]; bf16* H = (bf16*)(ws + WS_H);
    int curb = -1;
    for (int rb = blockIdx.x; rb < T / 64; rb += G) {
        const int b = rb >> 5;
        if (b != curb) {
            __syncthreads();
            for (int j = tid; j < 2048; j += NTHR) { float s = b_ada[j];
#pragma unroll
                for (int ks = 0; ks < 16; ++ks) s += modp[(size_t)(ks * 8 + b) * 6144 + j];
                sm[j] = s; }
            __syncthreads();
            curb = b;
        }
#pragma unroll 2
        for (int r = 0; r < 8; ++r) {
            const int row = rb * 64 + wave * 8 + r;
#pragma unroll
            for (int hf = 0; hf < 2; ++hf) {
                const int c0 = hf * 512 + 8 * lane;
                const f32x4 p = *(const f32x4*)(x + (size_t)row * DM + c0), q = *(const f32x4*)(x + (size_t)row * DM + c0 + 4);
                const f32x4 s0 = *(const LAS f32x4*)(sm + 1024 + c0), s1 = *(const LAS f32x4*)(sm + 1024 + c0 + 4);
                const f32x4 h0 = *(const LAS f32x4*)(sm + c0), h1 = *(const LAS f32x4*)(sm + c0 + 4);
                v4u o; o.x = pk2(p.x * (1.f + s0.x) + h0.x, p.y * (1.f + s0.y) + h0.y); o.y = pk2(p.z * (1.f + s0.z) + h0.z, p.w * (1.f + s0.w) + h0.w);
                o.z = pk2(q.x * (1.f + s1.x) + h1.x, q.y * (1.f + s1.y) + h1.y); o.w = pk2(q.z * (1.f + s1.z) + h1.z, q.w * (1.f + s1.w) + h1.w);
                *(v4u*)(H + (size_t)row * DM + c0) = o;
            }
        }
    }
}

__device__ __forceinline__ void p3_kmean(const Args& a, LAS unsigned char* lds, int G, int tid) {
    unsigned char* ws = a.ws; const bf16* QKV = (const bf16*)(ws + WS_QKV); float* km = (float*)(ws + WS_KMEAN);
    LAS float* red = (LAS float*)lds;
    for (int item = blockIdx.x; item < 256; item += G) {
        const int b = item >> 5, n = (item >> 2) & 7, rq = item & 3;
        const int cp = tid & 255, rg = tid >> 8;
        const size_t row0 = (size_t)b * SEQ + n * 256 + rq * 64 + rg * 32;
        float s0 = 0.f, s1 = 0.f;
#pragma unroll 8
        for (int r = 0; r < 32; ++r) { const unsigned w = *(const unsigned*)(QKV + (row0 + r) * NQKV + 512 + 2 * cp); s0 += bflo(w); s1 += bfhi(w); }
        if (rg == 1) { red[2 * cp] = s0; red[2 * cp + 1] = s1; }
        __syncthreads();
        if (rg == 0) { s0 += red[2 * cp]; s1 += red[2 * cp + 1]; const int c = 2 * cp, h = c >> 6, d = c & 63;
            float* dst = km + ((b * 8 + h) * 8 + n) * 64 + d;
            atomicAdd(dst, s0 * (1.f / 256.f)); atomicAdd(dst + 1, s1 * (1.f / 256.f)); }
        __syncthreads();
    }
}

__device__ __forceinline__ void unpack8(const v4u w, float (&v)[8]) { v[0] = bflo(w.x); v[1] = bfhi(w.x); v[2] = bflo(w.y); v[3] = bfhi(w.y); v[4] = bflo(w.z); v[5] = bfhi(w.z); v[6] = bflo(w.w); v[7] = bfhi(w.w); }
typedef short v4i16 __attribute__((ext_vector_type(4)));
constexpr float LOG2E = 1.4426950408889634f;
constexpr int AT_K = 0, AT_V = 18432, AT_LUT = 36864, AT_GATE = 45056, AT_SEL = 49152, AT_ANY = 49664, AT_ROW = 144;
constexpr size_t WS_YA = WS_ATT, WS_OB0 = WS_ATT + 16 * MiB, WS_OB1 = WS_ATT + 32 * MiB, WS_OB2 = WS_H, WS_LSE = WS_H + 16 * MiB;

__device__ __forceinline__ unsigned pkbf(float lo, float hi) { bf16x2 t; t.x = (__bf16)lo; t.y = (__bf16)hi; return __builtin_bit_cast(unsigned, t); }
__device__ __forceinline__ bf16x8 mk8(v4i16 a, v4i16 b) { return __builtin_shufflevector(a, b, 0, 1, 2, 3, 4, 5, 6, 7); }
__device__ __forceinline__ v4i16 tr16(const LAS unsigned char* p) { return __builtin_amdgcn_ds_read_tr16_b64_v4i16((LAS v4i16*)p); }

struct AttnState { bf16x8 qf[2]; f32x4 ot[4]; float m, l; };

__device__ __forceinline__ void attn_sub(AttnState& st, const LAS unsigned char* lds, int sub, int lane, int qidx, int k0, int dmax, bool lanesel) {
    const int q15 = lane & 15, g = lane >> 4;
    const LAS unsigned char* kb = lds + AT_K + (sub * 32 + q15) * AT_ROW + g * 16;
    f32x4 s0 = {0.f, 0.f, 0.f, 0.f}, s1 = {0.f, 0.f, 0.f, 0.f};
#pragma unroll
    for (int ks = 0; ks < 2; ++ks) {
        const bf16x8 a0 = *(const LAS bf16x8*)(kb + ks * 64), a1 = *(const LAS bf16x8*)(kb + 16 * AT_ROW + ks * 64);
        s0 = __builtin_amdgcn_mfma_f32_16x16x32_bf16(a0, st.qf[ks], s0, 0, 0, 0);
        s1 = __builtin_amdgcn_mfma_f32_16x16x32_bf16(a1, st.qf[ks], s1, 0, 0, 0);
    }
    const LAS float* lut = (const LAS float*)(lds + AT_LUT);
    float sc[8]; const int dbase = qidx - (k0 + sub * 32 + 4 * g);
#pragma unroll
    for (int r = 0; r < 8; ++r) {
        const int d = dbase - (r & 3) - (r >> 2) * 16;
        const bool ok = lanesel && d >= 0 && d <= dmax;
        const int dc = d < 0 ? 0 : (d > dmax ? dmax : d);
        const float v = ((r < 4) ? s0[r & 3] : s1[r & 3]) * LOG2E + lut[dc];
        sc[r] = ok ? v : -INFINITY;
    }
    float mx = fmaxf(fmaxf(fmaxf(sc[0], sc[1]), fmaxf(sc[2], sc[3])), fmaxf(fmaxf(sc[4], sc[5]), fmaxf(sc[6], sc[7])));
    mx = fmaxf(mx, __shfl_xor(mx, 16)); mx = fmaxf(mx, __shfl_xor(mx, 32));
    const float mn = fmaxf(st.m, mx), mu = (mn == -INFINITY) ? 0.f : mn;
    const float alpha = __builtin_amdgcn_exp2f(st.m - mu);
    float p[8], ps = 0.f;
#pragma unroll
    for (int r = 0; r < 8; ++r) { p[r] = __builtin_amdgcn_exp2f(sc[r] - mu); ps += p[r]; }
    st.l = st.l * alpha + ps; st.m = mn;
    if (!__all(alpha == 1.f)) {
#pragma unroll
        for (int n = 0; n < 4; ++n) st.ot[n] *= alpha;
    }
    v4u pw; pw.x = pkbf(p[0], p[1]); pw.y = pkbf(p[2], p[3]); pw.z = pkbf(p[4], p[5]); pw.w = pkbf(p[6], p[7]);
    const bf16x8 pb = __builtin_bit_cast(bf16x8, pw);
    const LAS unsigned char* vb = lds + AT_V + (sub * 32 + 4 * g + (q15 >> 2)) * AT_ROW + (q15 & 3) * 8;
#pragma unroll
    for (int n = 0; n < 4; ++n) {
        const v4i16 r1 = tr16(vb + n * 32), r2 = tr16(vb + 16 * AT_ROW + n * 32);
        st.ot[n] = __builtin_amdgcn_mfma_f32_16x16x32_bf16(mk8(r1, r2), pb, st.ot[n], 0, 0, 0);
    }
}

struct ChunkRegs { v4u k0, k1, v0, v1; };
__device__ __forceinline__ void chunk_fetch(ChunkRegs& c, const bf16* kbase  , int kstride_tok, int tid) {
    const int r0 = tid >> 3, cc = tid & 7;
    const bf16* p0 = kbase + (size_t)(r0 * kstride_tok) * NQKV + cc * 8; const bf16* p1 = kbase + (size_t)((r0 + 64) * kstride_tok) * NQKV + cc * 8;
    c.k0 = *(const v4u*)p0; c.k1 = *(const v4u*)p1; c.v0 = *(const v4u*)(p0 + 512); c.v1 = *(const v4u*)(p1 + 512);
}
__device__ __forceinline__ void chunk_store(const ChunkRegs& c, LAS unsigned char* lds, int tid) {
    const int r0 = tid >> 3, cc = tid & 7;
    *(LAS v4u*)(lds + AT_K + r0 * AT_ROW + cc * 16) = c.k0; *(LAS v4u*)(lds + AT_K + (r0 + 64) * AT_ROW + cc * 16) = c.k1;
    *(LAS v4u*)(lds + AT_V + r0 * AT_ROW + cc * 16) = c.v0; *(LAS v4u*)(lds + AT_V + (r0 + 64) * AT_ROW + cc * 16) = c.v1;
}
__device__ __forceinline__ void attn_init(AttnState& st, const bf16* qrow  , int lane) {
    const int g = lane >> 4;
    st.qf[0] = *(const bf16x8*)(qrow + 8 * g); st.qf[1] = *(const bf16x8*)(qrow + 32 + 8 * g);
#pragma unroll
    for (int n = 0; n < 4; ++n) st.ot[n] = (f32x4){0.f, 0.f, 0.f, 0.f};
    st.m = -INFINITY; st.l = 0.f;
}
__device__ __forceinline__ float attn_finish(AttnState& st, bf16* orow  , int lane) {
    float l = st.l; l += __shfl_xor(l, 16); l += __shfl_xor(l, 32);
    const float inv = 1.f / l; const int g = lane >> 4;
#pragma unroll
    for (int n = 0; n < 4; ++n) { v2u w; w.x = pkbf(st.ot[n][0] * inv, st.ot[n][1] * inv); w.y = pkbf(st.ot[n][2] * inv, st.ot[n][3] * inv);
        *(v2u*)(orow + 16 * n + 4 * g) = w; }
    return l;
}

__device__ __forceinline__ void moba_item(const Args& a, LAS unsigned char* lds, int item, int tid, int lane, int wave) {
    unsigned char* ws = a.ws; const bf16* QKV = (const bf16*)(ws + WS_QKV);
    const int qblk = 7 - (item >> 7), idx = item & 127, bh = idx >> 1, b = bh >> 3, h = bh & 7, qt = 2 * qblk + (idx & 1);
    const size_t tokb = (size_t)b * SEQ;
    LAS float* lut = (LAS float*)(lds + AT_LUT); LAS float* gates = (LAS float*)(lds + AT_GATE); LAS unsigned* selm = (LAS unsigned*)(lds + AT_SEL); LAS unsigned* anyw = (LAS unsigned*)(lds + AT_ANY);
    __syncthreads();
    for (int d = tid; d < 2048; d += NTHR) lut[d] = a.in[5][h * 32 + t5_bucket(d)] * LOG2E;
    if (tid == 0) *anyw = 0u;
    unsigned anysel;
    if (qblk > 3) {
        {
            const int qi = tid & 127, gi = tid >> 7;
            const bf16* qp = QKV + (tokb + qt * 128 + qi) * NQKV + h * 64;
            float ga = 0.f, gb = 0.f; const float* kma = (const float*)(ws + WS_KMEAN) + ((b * 8 + h) * 8 + gi) * 64; const float* kmb = kma + 4 * 64;
#pragma unroll
            for (int i = 0; i < 8; ++i) { const v4u w = *(const v4u*)(qp + 8 * i); float qv[8]; unpack8(w, qv);
#pragma unroll
                for (int j = 0; j < 8; ++j) { ga += qv[j] * kma[8 * i + j]; gb += qv[j] * kmb[8 * i + j]; } }
            gates[qi * 8 + gi] = ga; gates[qi * 8 + gi + 4] = gb;
        }
        __syncthreads();
        if (tid < 128) {
            float gv[8];
#pragma unroll
            for (int n = 0; n < 8; ++n) gv[n] = (n < qblk) ? gates[tid * 8 + n] : -INFINITY;
            unsigned sel = 0;
#pragma unroll
            for (int r = 0; r < 3; ++r) { float best = -INFINITY; int bi = 0;
#pragma unroll
                for (int n = 0; n < 8; ++n) { const bool take = !((sel >> n) & 1u) && (gv[n] > best); best = take ? gv[n] : best; bi = take ? n : bi; }
                sel |= 1u << bi; }
            selm[tid] = sel; atomicOr((unsigned*)anyw, sel);
        }
        __syncthreads();
        anysel = *anyw;
    } else { anysel = (1u << qblk) - 1u; __syncthreads(); }
    const unsigned mysel = (qblk > 3) ? selm[wave * 16 + (lane & 15)] : anysel;
    unsigned cm = 0;
    for (int n = 0; n < qblk; ++n) if ((anysel >> n) & 1u) cm |= 3u << (2 * n);
    cm |= 1u << (2 * qblk); if (qt & 1) cm |= 2u << (2 * qblk);
    const int qpos = qt * 128 + wave * 16 + (lane & 15), wq_hi = qt * 128 + wave * 16 + 15;
    AttnState st; attn_init(st, QKV + (tokb + qpos) * NQKV + h * 64, lane);
    ChunkRegs cr; const bf16* kcol = QKV + tokb * NQKV + 512 + h * 64;
    { const int c0 = __builtin_ctz(cm); chunk_fetch(cr, kcol + (size_t)(c0 * 128) * NQKV, 1, tid); }
    while (cm) {
        const int cur = __builtin_ctz(cm); cm &= cm - 1u;
        __syncthreads();
        chunk_store(cr, lds, tid);
        __syncthreads();
        if (cm) { const int nx = __builtin_ctz(cm); chunk_fetch(cr, kcol + (size_t)(nx * 128) * NQKV, 1, tid); }
        const int n = cur >> 1, k0 = cur * 128; const bool own = (n == qblk);
        const bool lsel = own || ((mysel >> n) & 1u);
        if (own || __any(lsel)) {
#pragma unroll 1
            for (int sub = 0; sub < 4; ++sub) {
                if (k0 + sub * 32 > wq_hi) break;
                attn_sub(st, lds, sub, lane, qpos, k0, 2047, lsel);
            }
        }
    }
    attn_finish(st, (bf16*)(ws + WS_YA) + (tokb + qpos) * 512 + h * 64, lane);
}

__device__ __forceinline__ void dil_item(const Args& a, LAS unsigned char* lds, int item, int tid, int lane, int wave) {
    unsigned char* ws = a.ws; const bf16* QKV = (const bf16*)(ws + WS_QKV);
    const int grp = item >> 4, sub16 = item & 15, br = grp % 3, bh = grp / 3, b = bh >> 3, h = bh & 7;
    const int dil = (br == 0) ? 1 : (br == 1 ? 4 : 16);
    const int r = (br == 0) ? 0 : (br == 1 ? (sub16 >> 2) : sub16), j = (br == 0) ? sub16 : (br == 1 ? (sub16 & 3) : 0);
    const size_t tokb = (size_t)b * SEQ;
    LAS float* lut = (LAS float*)(lds + AT_LUT);
    __syncthreads();
    for (int d = tid; d <= 128; d += NTHR) lut[d] = a.in[5][(8 + h) * 32 + t5_bucket(d * dil)] * LOG2E;
    const int lq = 128 * j + wave * 16 + (lane & 15);
    const size_t qtok = tokb + (size_t)lq * dil + r;
    AttnState st; attn_init(st, QKV + qtok * NQKV + 1536 + h * 64, lane);
    ChunkRegs cr; const bf16* kcol = QKV + (tokb + r) * NQKV + 2048 + h * 64;
    const int c_first = (j > 0) ? 0 : 1;
    chunk_fetch(cr, kcol + (size_t)((128 * (j - 1 + c_first)) * dil) * NQKV, dil, tid);
#pragma unroll 1
    for (int c = c_first; c < 2; ++c) {
        __syncthreads();
        chunk_store(cr, lds, tid);
        __syncthreads();
        if (c == 0) chunk_fetch(cr, kcol + (size_t)((128 * j) * dil) * NQKV, dil, tid);
        const int k0 = 128 * (j - 1 + c), wh = wave >> 1;
        const int s_lo = (c == 0) ? wh : 0, s_hi = (c == 0) ? 3 : wh;
#pragma unroll 1
        for (int sub = s_lo; sub <= s_hi; ++sub) attn_sub(st, lds, sub, lane, lq, k0, 128, true);
    }
    bf16* ob = (bf16*)(ws + (br == 0 ? WS_OB0 : (br == 1 ? WS_OB1 : WS_OB2)));
    const float l = attn_finish(st, ob + qtok * 512 + h * 64, lane);
    if ((lane >> 4) == 0) ((float*)(ws + WS_LSE))[((size_t)br * T + qtok) * 8 + h] = st.m + __builtin_amdgcn_logf(l);
}

__device__ __forceinline__ void p4_attn(const Args& a, LAS unsigned char* lds, int G, int tid, int lane, int wave) {
    for (int v = blockIdx.x; v < 256; v += G) {
        moba_item(a, lds, v, tid, lane, wave);
        moba_item(a, lds, 256 + v, tid, lane, wave);
        moba_item(a, lds, 767 - v, tid, lane, wave);
        moba_item(a, lds, 1023 - v, tid, lane, wave);
#pragma unroll 1
        for (int i = 0; i < 12; ++i) dil_item(a, lds, v * 12 + i, tid, lane, wave);
    }
}

__device__ __forceinline__ void p5_combine_rms(const Args& a, int G, int lane, int wave) {
    unsigned char* ws = a.ws; const bf16* YA = (const bf16*)(ws + WS_YA);
    const bf16* OB0 = (const bf16*)(ws + WS_OB0); const bf16* OB1 = (const bf16*)(ws + WS_OB1); const bf16* OB2 = (const bf16*)(ws + WS_OB2);
    const float* LSE = (const float*)(ws + WS_LSE); bf16* A2 = (bf16*)a.out;
    for (int row = blockIdx.x * NWAVES + wave; row < T; row += G * NWAVES) {
        float v[8], o0[8], o1[8], o2[8];
        unpack8(*(const v4u*)(YA + (size_t)row * 512 + 8 * lane), v);
        unpack8(*(const v4u*)(OB0 + (size_t)row * 512 + 8 * lane), o0); unpack8(*(const v4u*)(OB1 + (size_t)row * 512 + 8 * lane), o1); unpack8(*(const v4u*)(OB2 + (size_t)row * 512 + 8 * lane), o2);
        const int h = lane >> 3;
        const float l0 = LSE[((size_t)0 * T + row) * 8 + h], l1 = LSE[((size_t)1 * T + row) * 8 + h], l2 = LSE[((size_t)2 * T + row) * 8 + h];
        const float mx = fmaxf(l0, fmaxf(l1, l2));
        float w0 = __builtin_amdgcn_exp2f(l0 - mx), w1 = __builtin_amdgcn_exp2f(l1 - mx), w2 = __builtin_amdgcn_exp2f(l2 - mx);
        const float inv = 1.f / (w0 + w1 + w2); w0 *= inv; w1 *= inv; w2 *= inv;
        float ssa = 0.f, ssb = 0.f;
#pragma unroll
        for (int j = 0; j < 8; ++j) { o0[j] = w0 * o0[j] + w1 * o1[j] + w2 * o2[j]; ssa += v[j] * v[j]; ssb += o0[j] * o0[j]; }
        ssa = wave_sum(ssa); ssb = wave_sum(ssb);
        const float ra = rsqrtf(ssa * (1.f / 512.f) + LN_EPS), rb = rsqrtf(ssb * (1.f / 512.f) + LN_EPS);
        v4u o; o.x = pkbf(v[0] * ra, v[1] * ra); o.y = pkbf(v[2] * ra, v[3] * ra); o.z = pkbf(v[4] * ra, v[5] * ra); o.w = pkbf(v[6] * ra, v[7] * ra);
        *(v4u*)(A2 + (size_t)row * DM + 8 * lane) = o;
        o.x = pkbf(o0[0] * rb, o0[1] * rb); o.y = pkbf(o0[2] * rb, o0[3] * rb); o.z = pkbf(o0[4] * rb, o0[5] * rb); o.w = pkbf(o0[6] * rb, o0[7] * rb);
        *(v4u*)(A2 + (size_t)row * DM + 512 + 8 * lane) = o;
    }
}
__device__ __forceinline__ void load16(const float* p, int lane, float (&v)[16]) {
#pragma unroll
    for (int q = 0; q < 4; ++q) { const f32x4 t = *(const f32x4*)(p + (q >> 1) * 512 + 8 * lane + (q & 1) * 4); v[4 * q] = t.x; v[4 * q + 1] = t.y; v[4 * q + 2] = t.z; v[4 * q + 3] = t.w; }
}
__device__ __forceinline__ void store16(float* p, int lane, const float (&v)[16]) {
#pragma unroll
    for (int q = 0; q < 4; ++q) { f32x4 t; t.x = v[4 * q]; t.y = v[4 * q + 1]; t.z = v[4 * q + 2]; t.w = v[4 * q + 3]; *(f32x4*)(p + (q >> 1) * 512 + 8 * lane + (q & 1) * 4) = t; }
}
__device__ __forceinline__ void layer_norm16(float (&z)[16], const float* g, const float* bta, int lane) {
    float s = 0.f;
#pragma unroll
    for (int j = 0; j < 16; ++j) s += z[j];
    const float mu = wave_sum(s) * (1.f / DM); float q = 0.f;
#pragma unroll
    for (int j = 0; j < 16; ++j) { z[j] -= mu; q += z[j] * z[j]; }
    const float rs = rsqrtf(wave_sum(q) * (1.f / DM) + LN_EPS);
    float gg[16], bb[16]; load16(g, lane, gg); load16(bta, lane, bb);
#pragma unroll
    for (int j = 0; j < 16; ++j) z[j] = z[j] * rs * gg[j] + bb[j];
}

__device__ __forceinline__ void p7_ln1(const Args& a, int G, int lane, int wave) {
    unsigned char* ws = a.ws; const float* x = a.in[0]; const float* Y = (const float*)(ws + WS_QKV); const float* mod = (const float*)(ws + WS_MOD);
    float* x1 = a.out; bf16* H2 = (bf16*)(ws + WS_H);
    for (int row = blockIdx.x * NWAVES + wave; row < T; row += G * NWAVES) {
        const int b = row >> 11; float z[16], y[16], t[16];
        load16(x + (size_t)row * DM, lane, z); load16(Y + (size_t)row * DM, lane, y); load16(mod + b * 6144 + 2048, lane, t);
#pragma unroll
        for (int j = 0; j < 16; ++j) z[j] = DN_ALPHA * z[j] + (1.f + t[j]) * y[j];
        layer_norm16(z, a.in[9], a.in[10], lane);
        store16(x1 + (size_t)row * DM, lane, z);
        load16(mod + b * 6144 + 4096, lane, y); load16(mod + b * 6144 + 3072, lane, t);
#pragma unroll
        for (int j = 0; j < 16; ++j) z[j] = z[j] * (1.f + y[j]) + t[j];
        v4u o0, o1; o0.x = pk2(z[0], z[1]); o0.y = pk2(z[2], z[3]); o0.z = pk2(z[4], z[5]); o0.w = pk2(z[6], z[7]);
        o1.x = pk2(z[8], z[9]); o1.y = pk2(z[10], z[11]); o1.z = pk2(z[12], z[13]); o1.w = pk2(z[14], z[15]);
        *(v4u*)(H2 + (size_t)row * DM + 8 * lane) = o0; *(v4u*)(H2 + (size_t)row * DM + 512 + 8 * lane) = o1;
    }
}

__device__ __forceinline__ unsigned mono(float s) { const unsigned u = __float_as_uint(s); return u ^ ((unsigned)((int)u >> 31) | 0x80000000u); }
__device__ __forceinline__ float unmono(unsigned k) { return __uint_as_float((k & 0x80000000u) ? (k ^ 0x80000000u) : ~k); }
__device__ __forceinline__ void ins16(unsigned (&t)[16], unsigned x) {
#pragma unroll
    for (int j = 0; j < 16; ++j) { const unsigned hi = t[j] > x ? t[j] : x; x = t[j] > x ? x : t[j]; t[j] = hi; }
}
__device__ __forceinline__ unsigned lookup8(unsigned long long lo, unsigned long long hi, int idx) {
    const unsigned long long w = (idx & 8) ? hi : lo;
    return (unsigned)(w >> ((idx & 7) * 8)) & 0xffu;
}
template <int N> __device__ __forceinline__ void sort_desc(unsigned (&a)[N]) {
#pragma unroll
    for (int k = 2; k <= N; k <<= 1)
#pragma unroll
        for (int j = k >> 1; j > 0; j >>= 1)
#pragma unroll
            for (int i = 0; i < N; ++i) { const int l = i ^ j;
                if (l > i) { const unsigned x = a[i], y = a[l], hi = x > y ? x : y, lo = x > y ? y : x;
                    if ((i & k) == 0) { a[i] = hi; a[l] = lo; } else { a[i] = lo; a[l] = hi; } } }
}
__device__ __forceinline__ void merge_top16(unsigned (&a)[16], const unsigned (&b)[16]) {
#pragma unroll
    for (int i = 0; i < 16; ++i) a[i] = a[i] > b[15 - i] ? a[i] : b[15 - i];
#pragma unroll
    for (int j = 8; j > 0; j >>= 1)
#pragma unroll
        for (int i = 0; i < 16; ++i) { const int l = i ^ j; if (l > i) { const unsigned x = a[i], y = a[l]; a[i] = x > y ? x : y; a[l] = x > y ? y : x; } }
}
__device__ __forceinline__ void xmerge(unsigned (&a)[16], int mask) {
    unsigned b[16];
#pragma unroll
    for (int i = 0; i < 16; ++i) b[i] = (unsigned)__shfl_xor((int)a[i], mask);
    merge_top16(a, b);
}
constexpr int TK_ROW = 144;
__device__ __forceinline__ void p9_topk(const Args& a, LAS unsigned char* lds, int G, int tid) {
    unsigned char* ws = a.ws; const float* QP = (const float*)(ws + WS_QKV); const float* sub_keys = a.in[12];
    int* elist = (int*)(ws + WS_ATT); float* glist = (float*)(ws + WS_ATT + 8 * MiB);
    const int lane = tid & 63, wave = tid >> 6, c = lane & 15, g = lane >> 4;
    for (int i = tid; i < 256 * 8; i += NTHR) { const int row = i >> 3, ch = i & 7;
        const f32x4 p = *(const f32x4*)(sub_keys + row * 64 + ch * 8), q = *(const f32x4*)(sub_keys + row * 64 + ch * 8 + 4);
        const float v[8] = {p.x, p.y, p.z, p.w, q.x, q.y, q.z, q.w}; float r[8]; v4u hi, lo;
        hi.x = pkbf(v[0], v[1]); hi.y = pkbf(v[2], v[3]); hi.z = pkbf(v[4], v[5]); hi.w = pkbf(v[6], v[7]);
        r[0] = v[0] - bflo(hi.x); r[1] = v[1] - bfhi(hi.x); r[2] = v[2] - bflo(hi.y); r[3] = v[3] - bfhi(hi.y);
        r[4] = v[4] - bflo(hi.z); r[5] = v[5] - bfhi(hi.z); r[6] = v[6] - bflo(hi.w); r[7] = v[7] - bfhi(hi.w);
        lo.x = pkbf(r[0], r[1]); lo.y = pkbf(r[2], r[3]); lo.z = pkbf(r[4], r[5]); lo.w = pkbf(r[6], r[7]);
        *(LAS v4u*)(lds + row * TK_ROW + ch * 16) = hi; *(LAS v4u*)(lds + 256 * TK_ROW + row * TK_ROW + ch * 16) = lo; }
    __syncthreads();
    for (int task = blockIdx.x * NWAVES + wave; task < T / 2; task += G * NWAVES) {
        const int tok = task * 2 + (c >> 3), head = c & 7;
        unsigned T1[16], T2[16];
#pragma unroll 1
        for (int hf = 0; hf < 2; ++hf) {
            bf16x8 qh[2], ql[2];
#pragma unroll
            for (int ks = 0; ks < 2; ++ks) {
                const float* qp = QP + (size_t)tok * DM + head * 128 + hf * 64 + ks * 32 + 8 * g;
                const f32x4 p = *(const f32x4*)qp, q = *(const f32x4*)(qp + 4);
                v4u hi, lo; hi.x = pkbf(p.x, p.y); hi.y = pkbf(p.z, p.w); hi.z = pkbf(q.x, q.y); hi.w = pkbf(q.z, q.w);
                lo.x = pkbf(p.x - bflo(hi.x), p.y - bfhi(hi.x)); lo.y = pkbf(p.z - bflo(hi.y), p.w - bfhi(hi.y));
                lo.z = pkbf(q.x - bflo(hi.z), q.y - bfhi(hi.z)); lo.w = pkbf(q.z - bflo(hi.w), q.w - bfhi(hi.w));
                qh[ks] = __builtin_bit_cast(bf16x8, hi); ql[ks] = __builtin_bit_cast(bf16x8, lo);
            }
            unsigned P[32];
#pragma unroll
            for (int kt = 0; kt < 8; ++kt) {
                f32x4 acc = {0.f, 0.f, 0.f, 0.f};
#pragma unroll
                for (int ks = 0; ks < 2; ++ks) {
                    const LAS unsigned char* kp = lds + (hf * 128 + kt * 16 + c) * TK_ROW + ks * 64 + g * 16;
                    const bf16x8 kh = *(const LAS bf16x8*)kp, kl = *(const LAS bf16x8*)(kp + 256 * TK_ROW);
                    acc = __builtin_amdgcn_mfma_f32_16x16x32_bf16(kh, qh[ks], acc, 0, 0, 0);
                    acc = __builtin_amdgcn_mfma_f32_16x16x32_bf16(kl, qh[ks], acc, 0, 0, 0);
                    acc = __builtin_amdgcn_mfma_f32_16x16x32_bf16(kh, ql[ks], acc, 0, 0, 0);
                }
#pragma unroll
                for (int r = 0; r < 4; ++r) P[kt * 4 + r] = (mono(acc[r]) & ~127u) | (unsigned)(127 - (kt * 16 + r)) ;
            }
#pragma unroll
            for (int i = 0; i < 32; ++i) P[i] -= (unsigned)(4 * g);
            unsigned A[16], B[16];
#pragma unroll
            for (int i = 0; i < 16; ++i) { A[i] = P[i]; B[i] = P[16 + i]; }
            __builtin_amdgcn_sched_barrier(0);
            sort_desc<16>(A); __builtin_amdgcn_sched_barrier(0); sort_desc<16>(B); __builtin_amdgcn_sched_barrier(0); merge_top16(A, B);
            __builtin_amdgcn_sched_barrier(0);
            xmerge(A, 16); __builtin_amdgcn_sched_barrier(0); xmerge(A, 32); __builtin_amdgcn_sched_barrier(0);
#pragma unroll
            for (int i = 0; i < 16; ++i) { if (hf == 0) T1[i] = A[i]; else T2[i] = A[i]; }
        }
        float v1[16], v2[16]; unsigned long long i1lo = 0, i1hi = 0, i2lo = 0, i2hi = 0;
#pragma unroll
        for (int j = 0; j < 16; ++j) {
            v1[j] = unmono(T1[j] & ~127u); v2[j] = unmono(T2[j] & ~127u);
            const unsigned long long s1 = (unsigned long long)(127u - (T1[j] & 127u)) << ((j & 7) * 8), s2 = (unsigned long long)(127u - (T2[j] & 127u)) << ((j & 7) * 8);
            if (j < 8) { i1lo |= s1; i2lo |= s2; } else { i1hi |= s1; i2hi |= s2; }
        }
        unsigned top[16];
#pragma unroll
        for (int j = 0; j < 16; ++j) top[j] = (mono(v1[0] + v2[j]) & ~255u) | (unsigned)(255 - j);
#pragma unroll
        for (int aa = 1; aa < 16; ++aa)
#pragma unroll
            for (int bb = 0; bb < 16; ++bb)
                if ((aa + 1) * (bb + 1) <= 16) ins16(top, (mono(v1[aa] + v2[bb]) & ~255u) | (unsigned)(255 - (aa * 16 + bb)));
        if (g == 0) {
            float vals[16]; int ex[16]; float sum = 0.f;
            const float vmax = unmono(top[0] & ~255u);
#pragma unroll
            for (int r = 0; r < 16; ++r) { const int pos = 255 - (int)(top[r] & 255u);
                ex[r] = (int)(lookup8(i1lo, i1hi, pos >> 4) * 128u + lookup8(i2lo, i2hi, pos & 15));
                vals[r] = __expf(unmono(top[r] & ~255u) - vmax); sum += vals[r]; }
            const float inv = 1.f / sum; const size_t p = (size_t)tok * 8 + head;
#pragma unroll
            for (int r = 0; r < 4; ++r) {
                *(int4*)(elist + p * 16 + 4 * r) = make_int4(ex[4 * r], ex[4 * r + 1], ex[4 * r + 2], ex[4 * r + 3]);
                f32x4 gg; gg.x = vals[4 * r] * inv; gg.y = vals[4 * r + 1] * inv; gg.z = vals[4 * r + 2] * inv; gg.w = vals[4 * r + 3] * inv;
                *(f32x4*)(glist + p * 16 + 4 * r) = gg;
            }
        }
    }
}

typedef float f32x2 __attribute__((ext_vector_type(2)));
template <int CTRL> __device__ __forceinline__ float dppf(float v) { return __builtin_bit_cast(float, __builtin_amdgcn_update_dpp(0, __builtin_bit_cast(int, v), CTRL, 0xf, 0xf, false)); }
__device__ __forceinline__ float wave_total(float v) {
    v += dppf<0xB1>(v); v += dppf<0x4E>(v); v += dppf<0x141>(v); v += dppf<0x140>(v);
    const int iv = __builtin_bit_cast(int, v);
    return (__builtin_bit_cast(float, __builtin_amdgcn_readlane(iv, 0)) + __builtin_bit_cast(float, __builtin_amdgcn_readlane(iv, 16)))
         + (__builtin_bit_cast(float, __builtin_amdgcn_readlane(iv, 32)) + __builtin_bit_cast(float, __builtin_amdgcn_readlane(iv, 48)));
}
__device__ __forceinline__ float gelu1(float v) {
    const float av = fabsf(v), t = __builtin_amdgcn_rcpf(av * 0.2316418882f + 1.0f);
    float q = t * 0.5307027145f + (-0.7265760135f); q = q * t + 0.7107068705f; q = q * t + (-0.142248368f); q = q * t + 0.127414796f; q = q * t;
    const float e = __builtin_amdgcn_exp2f((v * v) * (-0.72134752044f)), m = v * (q * e);
    return v < 0.f ? m : v - m;
}
__device__ __forceinline__ void ld16c(const float* p, float (&v)[16]) {
#pragma unroll
    for (int q = 0; q < 4; ++q) { const f32x4 t = ((const f32x4*)p)[q]; v[4 * q] = t.x; v[4 * q + 1] = t.y; v[4 * q + 2] = t.z; v[4 * q + 3] = t.w; }
}
constexpr int PW_X = 0, PW_XROW = 1088, PW_UT = 4352, PW_UROW = 272, PW_LIST = 8704, PW_BYTES = 12800;
__device__ __forceinline__ void peer_axpy(float (&f)[16], const v4u vr, float act) {
#pragma unroll
    for (int q = 0; q < 4; ++q) {
        const f32x2 lo = __builtin_amdgcn_cvt_pk_f32_fp8((int)vr[q], false), hi = __builtin_amdgcn_cvt_pk_f32_fp8((int)vr[q], true);
        f[4 * q] += act * lo.x; f[4 * q + 1] += act * lo.y; f[4 * q + 2] += act * hi.x; f[4 * q + 3] += act * hi.y;
    }
}
__device__ __forceinline__ void peer_pair(float (&f)[16], const v4u vr, const f32x4 a4, const v2u myent, int p) {
    const float gp = __builtin_bit_cast(float, __builtin_amdgcn_readlane((int)myent.y, p));
    const float av = (p & 3) == 0 ? a4.x : ((p & 3) == 1 ? a4.y : ((p & 3) == 2 ? a4.z : a4.w));
    const float act = __builtin_bit_cast(float, __builtin_amdgcn_readlane(__float_as_int(av), 16 * (p >> 2))) * gp;
    peer_axpy(f, vr, act);
    __builtin_amdgcn_sched_barrier(0);
}
__device__ __forceinline__ void peer_batch(float (&f)[16], const LAS unsigned char* wl, int t, int bt, const unsigned char* U8, const unsigned char* V8, int lane) {
    const int l15 = lane & 15, g = lane >> 4;
    const LAS unsigned char* ent = wl + PW_LIST + 1024 * t + 128 * bt;
    const v2u myent = *(const LAS v2u*)(ent + 8 * l15);
    v4u ur[4][4], vrA[4];
    {
        int er[4];
#pragma unroll
        for (int q = 0; q < 4; ++q) er[q] = (int)(*(const LAS unsigned*)(ent + 8 * (4 * q + g)));
#pragma unroll
        for (int c = 0; c < 4; ++c)
#pragma unroll
            for (int q = 0; q < 4; ++q) ur[c][q] = *(const v4u*)(U8 + (size_t)er[q] * 1024 + 256 * c + 16 * l15);
    }
#pragma unroll
    for (int p = 0; p < 4; ++p) { const int ep = __builtin_amdgcn_readlane((int)myent.x, p); vrA[p] = *(const v4u*)(V8 + (size_t)ep * 1024 + 16 * lane); }
    __builtin_amdgcn_sched_barrier(0);
    f32x4 acc = {0.f, 0.f, 0.f, 0.f};
#pragma unroll
    for (int c = 0; c < 4; ++c) {
#pragma unroll
        for (int q = 0; q < 4; ++q) *(LAS v4u*)(wl + PW_UT + (4 * q + g) * PW_UROW + 16 * l15) = ur[c][q];
        asm volatile("s_waitcnt lgkmcnt(0)" ::: "memory");
#pragma unroll
        for (int j = 0; j < 4; ++j) {
            const v4u a16 = *(const LAS v4u*)(wl + PW_UT + l15 * PW_UROW + 64 * j + 16 * g);
            const v4u x16 = *(const LAS v4u*)(wl + PW_X + t * PW_XROW + 256 * c + 64 * j + 16 * g);
            const long a0 = (long)(((unsigned long long)a16.y << 32) | a16.x), a1 = (long)(((unsigned long long)a16.w << 32) | a16.z);
            const long x0 = (long)(((unsigned long long)x16.y << 32) | x16.x), x1 = (long)(((unsigned long long)x16.w << 32) | x16.z);
            acc = __builtin_amdgcn_mfma_f32_16x16x32_fp8_fp8(a0, x0, acc, 0, 0, 0);
            acc = __builtin_amdgcn_mfma_f32_16x16x32_fp8_fp8(a1, x1, acc, 0, 0, 0);
        }
        asm volatile("s_waitcnt lgkmcnt(0)" ::: "memory");
    }
    __builtin_amdgcn_sched_barrier(0);
    f32x4 a4;
#pragma unroll
    for (int r = 0; r < 4; ++r) a4[r] = gelu1(acc[r] * (1.f / PEER_USCALE));
    v4u vrB[4], vrC[4], vrD[4];
#pragma unroll
    for (int p = 0; p < 4; ++p) { const int ep = __builtin_amdgcn_readlane((int)myent.x, 4 + p); vrB[p] = *(const v4u*)(V8 + (size_t)ep * 1024 + 16 * lane); }
#pragma unroll
    for (int p = 0; p < 4; ++p) { const int ep = __builtin_amdgcn_readlane((int)myent.x, 8 + p); vrC[p] = *(const v4u*)(V8 + (size_t)ep * 1024 + 16 * lane); }
    __builtin_amdgcn_sched_barrier(0);
#pragma unroll
    for (int p = 0; p < 4; ++p) peer_pair(f, vrA[p], a4, myent, p);
#pragma unroll
    for (int p = 0; p < 4; ++p) { const int ep = __builtin_amdgcn_readlane((int)myent.x, 12 + p); vrD[p] = *(const v4u*)(V8 + (size_t)ep * 1024 + 16 * lane); }
    __builtin_amdgcn_sched_barrier(0);
#pragma unroll
    for (int p = 0; p < 4; ++p) peer_pair(f, vrB[p], a4, myent, 4 + p);
#pragma unroll
    for (int p = 0; p < 4; ++p) peer_pair(f, vrC[p], a4, myent, 8 + p);
#pragma unroll
    for (int p = 0; p < 4; ++p) peer_pair(f, vrD[p], a4, myent, 12 + p);
}
__device__ __forceinline__ void p10_peer(const Args& a, LAS unsigned char* lds, int G, int lane, int wave) {
    unsigned char* ws = a.ws; const unsigned char* U8 = ws + WS_U; const unsigned char* V8 = ws + WS_V;
    const int* elist = (const int*)(ws + WS_ATT); const float* glist = (const float*)(ws + WS_ATT + 8 * MiB);
    const float* mod = (const float*)(ws + WS_MOD); float* out = a.out;
    const int NGW = G * NWAVES;
    LAS unsigned char* wl = lds + wave * PW_BYTES;
    for (int grp0 = blockIdx.x * NWAVES + wave; grp0 < T / 4; grp0 += NGW) {
        const int tok0 = grp0 * 4, b = tok0 >> 11;
        {
            float sc[16], sh[16]; ld16c(mod + b * 6144 + 4096 + 16 * lane, sc); ld16c(mod + b * 6144 + 3072 + 16 * lane, sh);
            int e0[4], e1[4]; float g0[4], g1[4];
#pragma unroll
            for (int t = 0; t < 4; ++t) {
                float xv[16]; ld16c(out + (size_t)(tok0 + t) * DM + 16 * lane, xv);
#pragma unroll
                for (int j = 0; j < 16; ++j) xv[j] = xv[j] * (1.f + sc[j]) + sh[j];
                v4u o;
#pragma unroll
                for (int q = 0; q < 4; ++q) { int w = 0; w = __builtin_amdgcn_cvt_pk_fp8_f32(xv[4 * q], xv[4 * q + 1], w, false); w = __builtin_amdgcn_cvt_pk_fp8_f32(xv[4 * q + 2], xv[4 * q + 3], w, true); o[q] = (unsigned)w; }
                *(LAS v4u*)(wl + PW_X + t * PW_XROW + 16 * lane) = o;
                e0[t] = elist[(size_t)(tok0 + t) * 128 + lane]; e1[t] = elist[(size_t)(tok0 + t) * 128 + 64 + lane];
                g0[t] = glist[(size_t)(tok0 + t) * 128 + lane]; g1[t] = glist[(size_t)(tok0 + t) * 128 + 64 + lane];
            }
            int base[4] = {0, 0, 0, 0};
#pragma unroll 1
            for (int s = 0; s < 16; ++s) {
#pragma unroll
                for (int t = 0; t < 4; ++t) {
                    const bool h0 = (e0[t] >> 10) == s, h1 = (e1[t] >> 10) == s;
                    const unsigned long long m0 = __ballot(h0), m1 = __ballot(h1);
                    const int c0 = __builtin_popcountll(m0), c1 = __builtin_popcountll(m1);
                    const int r0 = (int)__builtin_amdgcn_mbcnt_hi((unsigned)(m0 >> 32), __builtin_amdgcn_mbcnt_lo((unsigned)m0, 0u));
                    const int r1 = (int)__builtin_amdgcn_mbcnt_hi((unsigned)(m1 >> 32), __builtin_amdgcn_mbcnt_lo((unsigned)m1, 0u));
                    if (h0) { v2u w; w.x = (unsigned)e0[t]; w.y = __float_as_uint(g0[t]); *(LAS v2u*)(wl + PW_LIST + 1024 * t + 8 * (base[t] + r0)) = w; }
                    if (h1) { v2u w; w.x = (unsigned)e1[t]; w.y = __float_as_uint(g1[t]); *(LAS v2u*)(wl + PW_LIST + 1024 * t + 8 * (base[t] + c0 + r1)) = w; }
                    base[t] += c0 + c1;
                }
            }
            asm volatile("s_waitcnt lgkmcnt(0)" ::: "memory");
        }
        float f[4][16];
#pragma unroll
        for (int t = 0; t < 4; ++t)
#pragma unroll
            for (int jj = 0; jj < 16; ++jj) f[t][jj] = 0.f;
#pragma unroll 1
        for (int bt = 0; bt < 8; ++bt) {
#pragma unroll
            for (int t = 0; t < 4; ++t) peer_batch(f[t], wl, t, bt, U8, V8, lane);
        }
        float g2[16], lg[16], lb[16];
        { const float* lgp = a.in[15]; const float* lbp = a.in[16]; asm volatile("" : "+s"(lgp), "+s"(lbp));
          ld16c(mod + b * 6144 + 5120 + 16 * lane, g2); ld16c(lgp + 16 * lane, lg); ld16c(lbp + 16 * lane, lb); }
#pragma unroll
        for (int t = 0; t < 4; ++t) {
            float z[16]; ld16c(out + (size_t)(tok0 + t) * DM + 16 * lane, z);
            float sm = 0.f;
#pragma unroll
            for (int jj = 0; jj < 16; ++jj) { z[jj] = DN_ALPHA * z[jj] + (1.f + g2[jj]) * f[t][jj]; sm += z[jj]; }
            const float mu = wave_total(sm) * (1.f / DM); float q = 0.f;
#pragma unroll
            for (int jj = 0; jj < 16; ++jj) { z[jj] -= mu; q += z[jj] * z[jj]; }
            const float rs = rsqrtf(wave_total(q) * (1.f / DM) + LN_EPS);
#pragma unroll
            for (int q4 = 0; q4 < 4; ++q4) { f32x4 o; o.x = z[4 * q4] * rs * lg[4 * q4] + lb[4 * q4]; o.y = z[4 * q4 + 1] * rs * lg[4 * q4 + 1] + lb[4 * q4 + 1];
                o.z = z[4 * q4 + 2] * rs * lg[4 * q4 + 2] + lb[4 * q4 + 2]; o.w = z[4 * q4 + 3] * rs * lg[4 * q4 + 3] + lb[4 * q4 + 3];
                ((f32x4*)(out + (size_t)(tok0 + t) * DM + 16 * lane))[q4] = o; }
        }
    }
}

constexpr int N_PHASES = 11;
__global__ void __launch_bounds__(NTHR, 2) mega(Args args) {
    extern __shared__ __attribute__((aligned(16))) unsigned char lds_raw[];
    LAS unsigned char* lds = (LAS unsigned char*)lds_raw;
    const int tid = threadIdx.x, lane = tid & 63, wave = __builtin_amdgcn_readfirstlane(tid >> 6), G = gridDim.x;
    unsigned char* ws = args.ws;
    volatile LAS unsigned* MISC = (volatile LAS unsigned*)(lds + MISC_OFF);
    for (int u = tid; u < (LDS_BYTES - RING_BYTES) / 4; u += NTHR) ((LAS unsigned*)(lds + RING_BYTES))[u] = 0u;
    __syncthreads();
    const int lo = args.ph_lo, hi = args.ph_hi;
    unsigned* barw = (unsigned*)(ws + WS_CTL) + CW_BAR + args.bar_idx * XCD_BAR_WORDS;
    XcdBarrier bar; bar.bar = barw; bar.x = 0; bar.st = nullptr;
    if (hi - lo > 1) bar = xcd_barrier_post(barw, MISC + 8);
#define IN(k) (lo <= (k) && (k) < hi)
#define REPS(k) ((PROBE_PH == (k)) ? 1 + PROBE_N : 1)
#define REPBAR(k, rep) do { if ((rep) + 1 < REPS(k)) xcd_barrier(bar); } while (0)
#define SEAM(k) do { if (IN(k) && IN((k) + 1)) xcd_barrier(bar); } while (0)

    if (IN(0)) { for (int rep = 0; rep < REPS(0); ++rep) { p0_prologue(args, lds, G, tid, lane, wave); REPBAR(0, rep); } } SEAM(0);
    if (IN(1)) { for (int rep = 0; rep < REPS(1); ++rep) { p1_mod_h(args, lds, G, tid, lane, wave); REPBAR(1, rep); } } SEAM(1);
    if (IN(2)) { for (int rep = 0; rep < REPS(2); ++rep) {
        __syncthreads();
        pg8::Gemm g{(const pg8::bf16_t*)(ws + WS_H), (const pg8::bf16_t*)(ws + WS_WIN), T, NQKV, DM};
        pg8::StaticOrder S; S.init(T, NQKV, G, (int)blockIdx.x);
        pg8::EpiBf16<0> E{(pg8::bf16_t*)(ws + WS_QKV), NQKV, nullptr, 0, 0};
        pg8::gemm_phase<pg8::EpiBf16<0>, pg8::StaticOrder, false>(lds, g, S, E, nullptr);
        REPBAR(2, rep); }
    } SEAM(2);
    if (IN(3)) { p3_kmean(args, lds, G, tid); } SEAM(3);
    if (IN(4)) { for (int rep = 0; rep < REPS(4); ++rep) { p4_attn(args, lds, G, tid, lane, wave); REPBAR(4, rep); } } SEAM(4);
    if (IN(5)) { for (int rep = 0; rep < REPS(5); ++rep) { p5_combine_rms(args, G, lane, wave); REPBAR(5, rep); } } SEAM(5);
    if (IN(6)) { for (int rep = 0; rep < REPS(6); ++rep) {
        __syncthreads();
        pg8::Gemm g{(const pg8::bf16_t*)args.out, (const pg8::bf16_t*)(ws + WS_WOUT), T, DM, DM};
        pg8::StaticOrder S; S.init(T, DM, G, (int)blockIdx.x);
        pg8::EpiF32 E{(float*)(ws + WS_QKV), DM, nullptr};
        pg8::gemm_phase<pg8::EpiF32, pg8::StaticOrder, false>(lds, g, S, E, nullptr);
        REPBAR(6, rep); }
    } SEAM(6);
    if (IN(7)) { for (int rep = 0; rep < REPS(7); ++rep) { p7_ln1(args, G, lane, wave); REPBAR(7, rep); } } SEAM(7);
    if (IN(8)) { for (int rep = 0; rep < REPS(8); ++rep) {
        __syncthreads();
        pg8::Gemm g{(const pg8::bf16_t*)(ws + WS_H), (const pg8::bf16_t*)(ws + WS_WQ), T, DM, DM};
        pg8::StaticOrder S; S.init(T, DM, G, (int)blockIdx.x);
        pg8::EpiF32 E{(float*)(ws + WS_QKV), DM, nullptr};
        pg8::gemm_phase<pg8::EpiF32, pg8::StaticOrder, false>(lds, g, S, E, nullptr);
        REPBAR(8, rep); }
    } SEAM(8);
    if (IN(9)) { for (int rep = 0; rep < REPS(9); ++rep) { __syncthreads(); p9_topk(args, lds, G, tid); REPBAR(9, rep); } } SEAM(9);
    if (IN(10)) { __syncthreads(); p10_peer(args, lds, G, lane, wave); }
#undef IN
#undef SEAM
}
}

#ifndef MK_N_LAUNCHES
#define MK_N_LAUNCHES 1
#endif

extern "C" void kernel_launch(void* const* d_in, const int* in_sizes, int n_in, void* d_out, int out_size, void* d_ws, size_t ws_size, hipStream_t stream) {
    static int grid = 0;
    if (!grid) {
        int dev = 0, cus = 0, per_cu = 0;
        if (hipGetDevice(&dev) != hipSuccess || hipDeviceGetAttribute(&cus, hipDeviceAttributeMultiprocessorCount, dev) != hipSuccess) { fprintf(stderr, "kernel_launch: device query failed\n"); return; }
        if (hipFuncSetAttribute((const void*)mk::mega, hipFuncAttributeMaxDynamicSharedMemorySize, mk::LDS_BYTES) != hipSuccess) { fprintf(stderr, "kernel_launch: hipFuncSetAttribute failed\n"); return; }
        if (hipOccupancyMaxActiveBlocksPerMultiprocessor(&per_cu, (const void*)mk::mega, mk::NTHR, mk::LDS_BYTES) != hipSuccess || per_cu < 1) { fprintf(stderr, "kernel_launch: occupancy query says %d\n", per_cu); return; }
        grid = cus;
    }
    if (n_in != 17 || ws_size < mk::WS_END) { fprintf(stderr, "kernel_launch: unexpected n_in %d / ws %zu\n", n_in, ws_size); return; }
    (void)hipMemsetAsync((char*)d_ws + mk::WS_CTL, 0, mk::CTL_ZERO_BYTES, stream);
    mk::Args a{};
    for (int i = 0; i < 17; ++i) a.in[i] = (const float*)d_in[i];
    a.out = (float*)d_out; a.ws = (unsigned char*)d_ws;
    a.ph_lo = 0; a.ph_hi = mk::N_PHASES;
    hipLaunchKernelGGL(mk::mega, dim3(grid), dim3(mk::NTHR), mk::LDS_BYTES, stream, a);
}
```

```cpp
#include <hip/hip_runtime.h>
#include <stdint.h>
#include <math.h>
#include <stdio.h>
namespace pg8 {
#define PG8_LAS __attribute__((address_space(3)))
typedef unsigned short bf16_t;
typedef short bf16x8 __attribute__((ext_vector_type(8)));
typedef float f32x4 __attribute__((ext_vector_type(4)));
typedef unsigned u32x4 __attribute__((ext_vector_type(4)));
constexpr int BM = 256, BK = 64, HALF = 128, HTB = HALF * BK * 2  , STAGE_BYTES = 8 * HTB, NXCD = 8, WGM = 8;

__host__ __device__ __forceinline__ int lds_byte(int r, int c) { const int st = (r >> 4) * 2 + (c >> 5), rr = r & 15, cc = c & 31, ob = rr * 64 + cc * 2; return st * 1024 + (ob ^ (((ob >> 9) & 1) << 5)); }
__host__ __device__ __forceinline__ void stage_rc(int b, int& R, int& C) { const int st = b / 1024, sb = b % 1024, swz = sb ^ (((sb >> 9) & 1) << 5); R = (st >> 1) * 16 + swz / 64; C = (st & 1) * 32 + (swz % 64) / 2; }
__host__ __device__ __forceinline__ int perm32(int rho) { const int n = rho >> 4, i = rho & 15; return 8 * (i >> 2) + 4 * n + (i & 3); }

struct Unit { int pm, pn; };
struct Gemm { const bf16_t* A; const bf16_t* Bt; int M, N, K; };

struct StaticOrder {
    int nM, nN, nwg, G, c;
    __host__ __device__ void init(int M, int N, int G_, int c_) { nM = M / BM; nN = N / BM; nwg = nM * nN; G = G_; c = c_; }
    __host__ __device__ bool next(int i, Unit& u) const {
        const long L = (long)i * G + c; if (L >= nwg) return false;
        int wgid = (int)L; { const int q = nwg / NXCD, r = nwg % NXCD, xcd = wgid % NXCD, off = wgid / NXCD; wgid = (xcd < r ? xcd * (q + 1) : r * (q + 1) + (xcd - r) * q) + off; }
        const int nig = WGM * nN, gid = wgid / nig, fm = gid * WGM, gsz = (nM - fm) < WGM ? (nM - fm) : WGM;
        u.pm = fm + ((wgid % nig) % gsz); u.pn = (wgid % nig) / gsz; return true;
    }
    __device__ __forceinline__ void a_ready(const Unit&) const {}
    __device__ __forceinline__ void done(const Unit&) const {}
};
struct CountedOrder : StaticOrder {
    const unsigned* ready; unsigned need; unsigned* tmo;
    __device__ __forceinline__ void a_ready(const Unit& u) const {
        if (threadIdx.x < 64) {
            const unsigned long long t0 = __builtin_amdgcn_s_memrealtime(); unsigned polls = 0;
            while ((unsigned)__builtin_amdgcn_readfirstlane(__hip_atomic_load(ready + 64 * u.pm, __ATOMIC_RELAXED, __HIP_MEMORY_SCOPE_AGENT)) < need) {
                if ((++polls & 255u) == 0u && __builtin_amdgcn_readfirstlane(__hip_atomic_load(tmo, __ATOMIC_RELAXED, __HIP_MEMORY_SCOPE_AGENT)) != 0u) break;
                if (__builtin_amdgcn_s_memrealtime() - t0 > 2000000ull) {
                    if (threadIdx.x == 0) { unsigned expect = 0u; __hip_atomic_compare_exchange_strong(tmo + 1, &expect, 0x600u | (unsigned)(u.pm & 0xff), __ATOMIC_RELAXED, __ATOMIC_RELAXED, __HIP_MEMORY_SCOPE_AGENT); __hip_atomic_store(tmo, 1u, __ATOMIC_RELAXED, __HIP_MEMORY_SCOPE_AGENT); }
                    break; }
                __builtin_amdgcn_s_sleep(2); }
            __builtin_amdgcn_fence(__ATOMIC_ACQUIRE, "agent");
            asm volatile("s_waitcnt vmcnt(0)" ::: "memory");
        }
#if !defined(BROKEN_HOOK_NO_BARRIER)
        asm volatile("" ::: "memory"); __builtin_amdgcn_s_barrier(); asm volatile("" ::: "memory");
#endif
    }
};

__device__ __forceinline__ unsigned cvt_pk_bf16(float lo, float hi) { unsigned r; asm volatile("v_cvt_pk_bf16_f32 %0, %1, %2" : "=v"(r) : "v"(lo), "v"(hi)); return r; }
typedef float f32x2 __attribute__((ext_vector_type(2)));
__device__ __forceinline__ f32x2 gelu_pk(f32x2 v) {
    const f32x2 av = __builtin_elementwise_abs(v), d = av * 0.2316418882f + 1.0f;
    f32x2 t; t.x = __builtin_amdgcn_rcpf(d.x); t.y = __builtin_amdgcn_rcpf(d.y);
    f32x2 q = t * 0.5307027145f + (-0.7265760135f); q = q * t + 0.7107068705f; q = q * t + (-0.142248368f); q = q * t + 0.127414796f; q = q * t;
    const f32x2 s = (v * v) * (-0.72134752044f);
    f32x2 e; e.x = __builtin_amdgcn_exp2f(s.x); e.y = __builtin_amdgcn_exp2f(s.y);
    const f32x2 m = v * (q * e), r = v - m;
    f32x2 o; o.x = v.x < 0.f ? m.x : r.x; o.y = v.y < 0.f ? m.y : r.y; return o;
}

struct EpiF32 {
    static constexpr bool PERM = false, AFTER_DRAIN = false;
    float* C; int ldc; const float* bias;
    __device__ __forceinline__ void operator()(const f32x4 (&acc)[2][2][4][2], const Unit& u, int wr, int wc, int fr, int fq) const {
        const int row0 = u.pm * BM + wr * 64 + fr, col0 = u.pn * BM + wc * 32 + 4 * fq;
        f32x4 bv[2][2];
#pragma unroll
        for (int bj = 0; bj < 2; ++bj)
#pragma unroll
            for (int n = 0; n < 2; ++n) bv[bj][n] = bias ? *(const f32x4*)(bias + col0 + bj * HALF + n * 16) : (f32x4){0.f, 0.f, 0.f, 0.f};
#pragma unroll
        for (int ai = 0; ai < 2; ++ai)
#pragma unroll
            for (int m = 0; m < 4; ++m) { float* rowp = C + (size_t)(row0 + ai * HALF + m * 16) * ldc + col0;
#pragma unroll
                for (int bj = 0; bj < 2; ++bj)
#pragma unroll
                    for (int n = 0; n < 2; ++n) *(f32x4*)(rowp + bj * HALF + n * 16) = acc[ai][bj][m][n] + bv[bj][n]; }
    }
};
template <int ACT  > struct EpiBf16 {
    static constexpr bool PERM = true, AFTER_DRAIN = false;
    bf16_t* O; int ldc; const float* bias; int split_cols; size_t split_stride;
    __device__ __forceinline__ void operator()(const f32x4 (&acc)[2][2][4][2], const Unit& u, int wr, int wc, int fr, int fq) const {
        const int row0 = u.pm * BM + wr * 64 + fr; int colt = u.pn * BM; bf16_t* base = O;
        if (split_cols) { const int t = colt / split_cols; base += (size_t)t * split_stride; colt -= t * split_cols; }
        const int col0 = colt + wc * 32 + 8 * fq, bcol0 = u.pn * BM + wc * 32 + 8 * fq;
        f32x4 bv[2][2];
#pragma unroll
        for (int bj = 0; bj < 2; ++bj)
#pragma unroll
            for (int n = 0; n < 2; ++n) bv[bj][n] = bias ? *(const f32x4*)(bias + bcol0 + bj * HALF + 4 * n) : (f32x4){0.f, 0.f, 0.f, 0.f};
#pragma unroll
        for (int ai = 0; ai < 2; ++ai)
#pragma unroll
            for (int m = 0; m < 4; ++m) { bf16_t* rowp = base + (size_t)(row0 + ai * HALF + m * 16) * ldc + col0;
#pragma unroll
                for (int bj = 0; bj < 2; ++bj) { f32x4 v0 = acc[ai][bj][m][0] + bv[bj][0], v1 = acc[ai][bj][m][1] + bv[bj][1];
                    if (ACT == 1) { f32x2 a = gelu_pk((f32x2){v0[0], v0[1]}), b = gelu_pk((f32x2){v0[2], v0[3]}), c = gelu_pk((f32x2){v1[0], v1[1]}), d = gelu_pk((f32x2){v1[2], v1[3]});
                        v0 = (f32x4){a.x, a.y, b.x, b.y}; v1 = (f32x4){c.x, c.y, d.x, d.y}; }
                    if (ACT == 2) {
#pragma unroll
                        for (int j = 0; j < 4; ++j) { v0[j] = 0.5f * v0[j] * (1.0f + erff(v0[j] * 0.70710678f)); v1[j] = 0.5f * v1[j] * (1.0f + erff(v1[j] * 0.70710678f)); } }
                    u32x4 w; w.x = cvt_pk_bf16(v0[0], v0[1]); w.y = cvt_pk_bf16(v0[2], v0[3]); w.z = cvt_pk_bf16(v1[0], v1[1]); w.w = cvt_pk_bf16(v1[2], v1[3]);
                    *(u32x4*)(rowp + bj * HALF) = w; } }
    }
};

struct PanelStats {
    unsigned* xbuf;
    unsigned* cnt;
    unsigned* tmo;
    int ntn; float eps;
    unsigned code;
    __device__ __forceinline__ bool run(const f32x4 (&v)[2][2][4][2], const Unit& u, int wr, int wc, int fr, int fq, PG8_LAS unsigned char* lds, int wid, int lane) const {
        typedef float f32x2v __attribute__((ext_vector_type(2)));
        PG8_LAS f32x2v* P = (PG8_LAS f32x2v*)lds;
        PG8_LAS f32x2v* S = (PG8_LAS f32x2v*)(lds + 8192);
        PG8_LAS unsigned* flag = (PG8_LAS unsigned*)(lds + 8192 + 2048);
#pragma unroll
        for (int ai = 0; ai < 2; ++ai)
#pragma unroll
            for (int m = 0; m < 4; ++m) {
                float s = 0.f;
#pragma unroll
                for (int bj = 0; bj < 2; ++bj)
#pragma unroll
                    for (int n = 0; n < 2; ++n) { const f32x4 x = v[ai][bj][m][n]; s += (x[0] + x[1]) + (x[2] + x[3]); }
                s += __shfl_xor(s, 16); s += __shfl_xor(s, 32);
                const float mw = s * (1.0f / 64.0f); float q = 0.f;
#pragma unroll
                for (int bj = 0; bj < 2; ++bj)
#pragma unroll
                    for (int n = 0; n < 2; ++n) { const f32x4 d = v[ai][bj][m][n] - mw; q += (d[0] * d[0] + d[1] * d[1]) + (d[2] * d[2] + d[3] * d[3]); }
                q += __shfl_xor(q, 16); q += __shfl_xor(q, 32);
                if (fq == 0) P[(ai * HALF + wr * 64 + m * 16 + fr) * 4 + wc] = (f32x2v){mw, q};
            }
        asm volatile("s_waitcnt lgkmcnt(0)" ::: "memory"); __builtin_amdgcn_s_barrier(); asm volatile("" ::: "memory");
#if defined(BROKEN_NO_WAIT)
        if (blockIdx.x >= 64) { const long long t0 = clock64(); while (clock64() - t0 < 60000) __builtin_amdgcn_s_sleep(8); }
#endif
        const int row = wid * 32 + (lane & 31);
        if (lane < 32) {
            const f32x2v a = P[row * 4 + 0], b = P[row * 4 + 1], c = P[row * 4 + 2], d = P[row * 4 + 3];
            const float mt = (a.x + b.x + c.x + d.x) * 0.25f;
            const float da = a.x - mt, db = b.x - mt, dc = c.x - mt, dd = d.x - mt;
            const float m2 = (a.y + b.y) + (c.y + d.y) + 64.0f * ((da * da + db * db) + (dc * dc + dd * dd));
            unsigned long long* slot = (unsigned long long*)xbuf + ((size_t)(u.pm * BM + row) * 4 + u.pn);
            __hip_atomic_store(slot, ((unsigned long long)__float_as_uint(m2) << 32) | __float_as_uint(mt), __ATOMIC_RELAXED, __HIP_MEMORY_SCOPE_AGENT);
        }
        asm volatile("s_waitcnt vmcnt(0)" ::: "memory");
        if (lane == 0) __hip_atomic_fetch_add(cnt + 64 * u.pm, 1u, __ATOMIC_RELAXED, __HIP_MEMORY_SCOPE_AGENT);
        if (wid == 0) {
            bool dead = false; const unsigned long long t0 = __builtin_amdgcn_s_memrealtime(); const unsigned want = 8u * (unsigned)ntn;
            for (;;) {
#if defined(BROKEN_NO_WAIT)
                break;
#endif
                if ((unsigned)__builtin_amdgcn_readfirstlane(__hip_atomic_load(cnt + 64 * u.pm, __ATOMIC_RELAXED, __HIP_MEMORY_SCOPE_AGENT)) >= want) break;
                if (__builtin_amdgcn_s_memrealtime() - t0 > 2000000ull) {
                    if (lane == 0) { unsigned expect = 0u; __hip_atomic_compare_exchange_strong(tmo + 1, &expect, code | (unsigned)(u.pm & 0xff), __ATOMIC_RELAXED, __ATOMIC_RELAXED, __HIP_MEMORY_SCOPE_AGENT);
                                     __hip_atomic_store(tmo, 1u, __ATOMIC_RELAXED, __HIP_MEMORY_SCOPE_AGENT); }
                    dead = true; break; }
                __builtin_amdgcn_s_sleep(2);
            }
            __builtin_amdgcn_fence(__ATOMIC_ACQUIRE, "agent");
            if (lane == 0) flag[0] = dead ? 1u : 0u;
        }
        asm volatile("s_waitcnt vmcnt(0) lgkmcnt(0)" ::: "memory"); __builtin_amdgcn_s_barrier(); asm volatile("" ::: "memory");
        const bool bad = flag[0] != 0u;
        if (lane < 32) {
            const unsigned long long* slot = (const unsigned long long*)xbuf + (size_t)(u.pm * BM + row) * 4; float mt[4], m2[4]; float ms = 0.f;
#pragma unroll
            for (int t = 0; t < 4; ++t) { if (t < ntn) { const unsigned long long w = __hip_atomic_load(slot + t, __ATOMIC_RELAXED, __HIP_MEMORY_SCOPE_AGENT); mt[t] = __uint_as_float((unsigned)w); m2[t] = __uint_as_float((unsigned)(w >> 32)); } else { mt[t] = 0.f; m2[t] = 0.f; } ms += mt[t]; }
            const float mean = ms / (float)ntn; float q = 0.f;
#pragma unroll
            for (int t = 0; t < 4; ++t) if (t < ntn) { const float dm = mt[t] - mean; q += m2[t] + 256.0f * dm * dm; }
            S[row] = (f32x2v){mean, 1.0f / sqrtf(q / (256.0f * (float)ntn) + eps)};
        }
        asm volatile("s_waitcnt lgkmcnt(0)" ::: "memory"); __builtin_amdgcn_s_barrier(); asm volatile("" ::: "memory");
        return bad;
    }
};
struct EpiLnRes {
    static constexpr bool PERM = false, AFTER_DRAIN = true;
    const float* base; float* out; int ldc; const float* bias; PanelStats st; unsigned poison;
    __device__ __forceinline__ void refuse(size_t i0, size_t stride, int M, int N) const { const float q = __builtin_nanf(""); for (size_t i = i0; i < (size_t)M * N; i += stride) out[(i / N) * ldc + i % N] = q;
        if (i0 == 0) { unsigned expect = 0u; __hip_atomic_compare_exchange_strong(st.tmo + 1, &expect, 0x7f0u, __ATOMIC_RELAXED, __ATOMIC_RELAXED, __HIP_MEMORY_SCOPE_AGENT); __hip_atomic_store(st.tmo, 1u, __ATOMIC_RELAXED, __HIP_MEMORY_SCOPE_AGENT); } }
    __device__ __forceinline__ void fused(f32x4 (&acc)[2][2][4][2], const Unit& u, int wr, int wc, int fr, int fq, PG8_LAS unsigned char* lds, int wid, int lane) const {
        typedef float f32x2v __attribute__((ext_vector_type(2)));
        const PG8_LAS f32x2v* S = (const PG8_LAS f32x2v*)(lds + 8192);
        const int col0 = u.pn * BM + wc * 32 + 4 * fq;
#pragma unroll
        for (int bj = 0; bj < 2; ++bj)
#pragma unroll
            for (int n = 0; n < 2; ++n) { const f32x4 bv = bias ? *(const f32x4*)(bias + col0 + bj * HALF + n * 16) : (f32x4){0.f, 0.f, 0.f, 0.f};
#pragma unroll
                for (int ai = 0; ai < 2; ++ai)
#pragma unroll
                    for (int m = 0; m < 4; ++m) acc[ai][bj][m][n] += bv; }
        const bool bad = st.run(acc, u, wr, wc, fr, fq, lds, wid, lane) || poison != 0u;
        const float qnan = __builtin_nanf("");
#pragma unroll
        for (int ai = 0; ai < 2; ++ai)
#pragma unroll
            for (int m = 0; m < 4; ++m) { const int r = ai * HALF + wr * 64 + m * 16 + fr; const f32x2v sr = S[r]; const size_t off = (size_t)(u.pm * BM + r) * ldc + col0;
#pragma unroll
                for (int bj = 0; bj < 2; ++bj)
#pragma unroll
                    for (int n = 0; n < 2; ++n) { const f32x4 bs = *(const f32x4*)(base + off + bj * HALF + n * 16); f32x4 o = bs + (acc[ai][bj][m][n] - sr.x) * sr.y;
                        if (bad) o = (f32x4){qnan, qnan, qnan, qnan}; *(f32x4*)(out + off + bj * HALF + n * 16) = o; }
                asm volatile("" ::: "memory"); }
    }
};
struct EpiLnResLn {
    static constexpr bool PERM = false, AFTER_DRAIN = true;
    const float* base; float* out; bf16_t* xn; int ldc; const float* bias; PanelStats st1, st2; unsigned poison;
    __device__ __forceinline__ void refuse(size_t i0, size_t stride, int M, int N) const { const float q = __builtin_nanf(""); for (size_t i = i0; i < (size_t)M * N; i += stride) { const size_t o = (i / N) * ldc + i % N; out[o] = q; xn[o] = (bf16_t)0x7fc0u; }
        if (i0 == 0) { unsigned expect = 0u; __hip_atomic_compare_exchange_strong(st1.tmo + 1, &expect, 0x7f0u, __ATOMIC_RELAXED, __ATOMIC_RELAXED, __HIP_MEMORY_SCOPE_AGENT); __hip_atomic_store(st1.tmo, 1u, __ATOMIC_RELAXED, __HIP_MEMORY_SCOPE_AGENT); } }
    __device__ __forceinline__ void fused(f32x4 (&acc)[2][2][4][2], const Unit& u, int wr, int wc, int fr, int fq, PG8_LAS unsigned char* lds, int wid, int lane) const {
        typedef float f32x2v __attribute__((ext_vector_type(2))); typedef unsigned u32x2v __attribute__((ext_vector_type(2)));
        const PG8_LAS f32x2v* S = (const PG8_LAS f32x2v*)(lds + 8192);
        const int col0 = u.pn * BM + wc * 32 + 4 * fq;
#pragma unroll
        for (int bj = 0; bj < 2; ++bj)
#pragma unroll
            for (int n = 0; n < 2; ++n) { const f32x4 bv = bias ? *(const f32x4*)(bias + col0 + bj * HALF + n * 16) : (f32x4){0.f, 0.f, 0.f, 0.f};
#pragma unroll
                for (int ai = 0; ai < 2; ++ai)
#pragma unroll
                    for (int m = 0; m < 4; ++m) acc[ai][bj][m][n] += bv; }
        bool bad = st1.run(acc, u, wr, wc, fr, fq, lds, wid, lane) || poison != 0u;
        const float qnan = __builtin_nanf("");
#pragma unroll
        for (int ai = 0; ai < 2; ++ai)
#pragma unroll
            for (int m = 0; m < 4; ++m) { const int r = ai * HALF + wr * 64 + m * 16 + fr; const f32x2v sr = S[r]; const size_t off = (size_t)(u.pm * BM + r) * ldc + col0;
#pragma unroll
                for (int bj = 0; bj < 2; ++bj)
#pragma unroll
                    for (int n = 0; n < 2; ++n) { const f32x4 bs = *(const f32x4*)(base + off + bj * HALF + n * 16); acc[ai][bj][m][n] = bs + (acc[ai][bj][m][n] - sr.x) * sr.y; }
                asm volatile("" : "+v"(acc[ai][0][m][0]), "+v"(acc[ai][0][m][1]), "+v"(acc[ai][1][m][0]), "+v"(acc[ai][1][m][1]));
                if (m & 1) asm volatile("" ::: "memory"); }
        const bool bad1 = bad;
        bad = st2.run(acc, u, wr, wc, fr, fq, lds, wid, lane) || bad;
#pragma unroll
        for (int ai = 0; ai < 2; ++ai)
#pragma unroll
            for (int m = 0; m < 4; ++m) { const int r = ai * HALF + wr * 64 + m * 16 + fr; const f32x2v sr = S[r]; const size_t off = (size_t)(u.pm * BM + r) * ldc + col0;
#pragma unroll
                for (int bj = 0; bj < 2; ++bj)
#pragma unroll
                    for (int n = 0; n < 2; ++n) { const f32x4 x1 = acc[ai][bj][m][n]; *(f32x4*)(out + off + bj * HALF + n * 16) = bad1 ? (f32x4){qnan, qnan, qnan, qnan} : x1;
                        const f32x4 o = (x1 - sr.x) * sr.y; u32x2v w; w.x = cvt_pk_bf16(o[0], o[1]); w.y = cvt_pk_bf16(o[2], o[3]);
                        if (bad) { w.x = 0x7fc07fc0u; w.y = 0x7fc07fc0u; } *(u32x2v*)(xn + off + bj * HALF + n * 16) = w; }
                asm volatile("" ::: "memory"); }
    }
};

template <class Epi, class Sched, bool STAMP = false>
__device__ __forceinline__ void gemm_phase(PG8_LAS unsigned char* lds, const Gemm g, const Sched& S, const Epi& E, unsigned long long* stamps) {
    const int tid = threadIdx.x, wid = __builtin_amdgcn_readfirstlane(tid >> 6), lane = tid & 63, wr = wid >> 2, wc = wid & 3, fr = lane & 15, fq = lane >> 4;
    const int K = g.K, nt = K / BK;
    int ts_lo = 0, ts_hi = 0, nts = 0; const unsigned long long rt_entry = STAMP ? (unsigned long long)wall_clock64() : 0ull;
#define PG8_STAMP() do { if (STAMP && wid == 0 && nts < 64) { const unsigned long long _c = (unsigned long long)clock64(); \
        ts_lo = (lane == nts) ? (int)(unsigned)_c : ts_lo; ts_hi = (lane == nts) ? (int)(unsigned)(_c >> 32) : ts_hi; ++nts; } } while (0)
    PG8_STAMP();
    unsigned voffA[2], voffB[2];
#pragma unroll
    for (int i = 0; i < 2; ++i) { int R, C; stage_rc(tid * 16 + i * 8192, R, C); const int Rb = Epi::PERM ? ((R & ~31) + perm32(R & 31)) : R;
        voffA[i] = (unsigned)(R * K + C) * 2u; voffB[i] = (unsigned)(Rb * K + C) * 2u; }
    const size_t kstep = (size_t)(BK * 2);
    const size_t hstep = (size_t)HALF * K * 2;
    const size_t tstep = 2 * hstep;
    const unsigned ldsw = (unsigned)wid * 1024u;
    const int aoff = lds_byte(wr * 64 + fr, fq * 8), boff = lds_byte(wc * 32 + fr, fq * 8);
#define PG8_SA(b, h) (((b) * 2 + (h)) * HTB)
#define PG8_SB(b, h) ((4 + (b) * 2 + (h)) * HTB)
#define PG8_STAGE(bufoff, gbase, voff) do { _Pragma("unroll") for (int _i = 0; _i < 2; ++_i) \
        __builtin_amdgcn_global_load_lds((const unsigned*)((const char*)(gbase) + (voff)[_i]), (PG8_LAS unsigned*)(lds + (bufoff) + ldsw + _i * 8192), 16, 0, 0); } while (0)
#define PG8_LDA(dst, b, h) do { _Pragma("unroll") for (int m = 0; m < 4; ++m) _Pragma("unroll") for (int k = 0; k < 2; ++k) dst[m][k] = *(const PG8_LAS bf16x8*)(lds + PG8_SA(b, h) + aoff + m * 2048 + k * 1024); } while (0)
#define PG8_LDB(dst, b, h) do { _Pragma("unroll") for (int n = 0; n < 2; ++n) _Pragma("unroll") for (int k = 0; k < 2; ++k) dst[n][k] = *(const PG8_LAS bf16x8*)(lds + PG8_SB(b, h) + boff + n * 2048 + k * 1024); } while (0)
#define PG8_MMA(ai, bj, At, Bt) do { __builtin_amdgcn_s_setprio(1); _Pragma("unroll") for (int m = 0; m < 4; ++m) _Pragma("unroll") for (int n = 0; n < 2; ++n) _Pragma("unroll") for (int k = 0; k < 2; ++k) \
        acc[ai][bj][m][n] = __builtin_amdgcn_mfma_f32_16x16x32_bf16(Bt[n][k], At[m][k], acc[ai][bj][m][n], 0, 0, 0); __builtin_amdgcn_s_setprio(0); } while (0)
#define PG8_WAIT_V(n) asm volatile("s_waitcnt vmcnt(" #n ")" ::: "memory")
#define PG8_WAIT_L(n) asm volatile("s_waitcnt lgkmcnt(" #n ")" ::: "memory")
#define PG8_BAR __builtin_amdgcn_s_barrier()
#define PG8_SCHED __builtin_amdgcn_sched_barrier(0)
    Unit cur, nxt; int ui = 0;
    if (!S.next(0, cur)) return;
    f32x4 acc[2][2][4][2];
#pragma unroll
    for (int a = 0; a < 2; ++a)
#pragma unroll
        for (int b = 0; b < 2; ++b)
#pragma unroll
            for (int m = 0; m < 4; ++m)
#pragma unroll
                for (int n = 0; n < 2; ++n) acc[a][b][m][n] = (f32x4){0.f, 0.f, 0.f, 0.f};
    bf16x8 At[4][2], B0[2][2], B1[2][2];
    const char* cA = (const char*)g.A + (size_t)cur.pm * tstep; const char* cB = (const char*)g.Bt + (size_t)cur.pn * tstep;
    S.a_ready(cur);
    PG8_STAGE(PG8_SB(0, 0), cB, voffB); PG8_STAGE(PG8_SA(0, 0), cA, voffA); PG8_STAGE(PG8_SB(0, 1), cB + hstep, voffB); PG8_STAGE(PG8_SA(0, 1), cA + hstep, voffA);
    if (wr == 1) PG8_BAR;
    PG8_WAIT_V(4); PG8_BAR;
    PG8_STAGE(PG8_SB(1, 0), cB + kstep, voffB); PG8_STAGE(PG8_SA(1, 0), cA + kstep, voffA); PG8_STAGE(PG8_SB(1, 1), cB + hstep + kstep, voffB);
    PG8_WAIT_V(6); PG8_BAR;
    PG8_STAMP();
    for (;;) {
        const bool has_next = S.next(ui + 1, nxt);
        const char* nA = has_next ? (const char*)g.A + (size_t)nxt.pm * tstep : cA; const char* nB = has_next ? (const char*)g.Bt + (size_t)nxt.pn * tstep : cB;
        for (int t = 0; t < nt; t += 2) {
            const bool last = (t == nt - 2);
            const char* a1 = cA + (size_t)(t + 1) * kstep;
            const char* a2 = last ? nA : cA + (size_t)(t + 2) * kstep; const char* b2 = last ? nB : cB + (size_t)(t + 2) * kstep;
            const char* a3 = a2 + kstep; const char* b3 = b2 + kstep;
            if (last && has_next) S.a_ready(nxt);
            PG8_LDB(B0, 0, 0); PG8_SCHED; PG8_LDA(At, 0, 0); PG8_STAGE(PG8_SA(1, 1), a1 + hstep, voffA);
            PG8_WAIT_L(8); PG8_BAR; PG8_WAIT_L(0); PG8_MMA(0, 0, At, B0); PG8_BAR; PG8_SCHED;
            PG8_LDB(B1, 0, 1); PG8_STAGE(PG8_SB(0, 0), b2, voffB);
            PG8_BAR; PG8_WAIT_L(0); PG8_MMA(0, 1, At, B1); PG8_BAR;
            PG8_LDA(At, 0, 1); PG8_STAGE(PG8_SA(0, 0), a2, voffA);
            PG8_BAR; PG8_WAIT_L(0); PG8_MMA(1, 0, At, B0); PG8_BAR; PG8_SCHED;
            PG8_STAGE(PG8_SB(0, 1), b2 + hstep, voffB);
            PG8_WAIT_V(6); PG8_BAR; PG8_MMA(1, 1, At, B1); PG8_BAR;
            PG8_LDB(B0, 1, 0); PG8_SCHED; PG8_LDA(At, 1, 0); PG8_STAGE(PG8_SA(0, 1), a2 + hstep, voffA);
            PG8_WAIT_L(8); PG8_BAR; PG8_WAIT_L(0); PG8_MMA(0, 0, At, B0); PG8_BAR; PG8_SCHED;
            PG8_LDB(B1, 1, 1); PG8_STAGE(PG8_SB(1, 0), b3, voffB);
            PG8_BAR; PG8_WAIT_L(0); PG8_MMA(0, 1, At, B1); PG8_BAR;
            PG8_LDA(At, 1, 1); PG8_STAGE(PG8_SA(1, 0), a3, voffA);
            PG8_BAR; PG8_WAIT_L(0); PG8_MMA(1, 0, At, B0); PG8_BAR; PG8_SCHED;
            PG8_STAGE(PG8_SB(1, 1), b3 + hstep, voffB);
            PG8_WAIT_V(6); PG8_BAR; PG8_MMA(1, 1, At, B1); PG8_BAR;
        }
        PG8_STAMP();
        if constexpr (!Epi::AFTER_DRAIN) { E(acc, cur, wr, wc, fr, fq); S.done(cur); }
        PG8_STAMP();
        if (!has_next) break;
#pragma unroll
        for (int a = 0; a < 2; ++a)
#pragma unroll
            for (int b = 0; b < 2; ++b)
#pragma unroll
                for (int m = 0; m < 4; ++m)
#pragma unroll
                    for (int n = 0; n < 2; ++n) acc[a][b][m][n] = (f32x4){0.f, 0.f, 0.f, 0.f};
        cur = nxt; cA = nA; cB = nB; ++ui;
    }
    PG8_WAIT_V(0);
    if (wr == 0) PG8_BAR;
    PG8_BAR;
    if constexpr (Epi::AFTER_DRAIN) { E.fused(acc, cur, wr, wc, fr, fq, lds, wid, lane); S.done(cur); }
    PG8_STAMP();
    if (STAMP && wid == 0) { stamps[lane] = lane < nts ? (((unsigned long long)(unsigned)ts_hi << 32) | (unsigned)ts_lo) : 0ull;
        if (lane == 62) stamps[62] = rt_entry; if (lane == 63) stamps[63] = (unsigned long long)wall_clock64(); }
#undef PG8_STAMP
#undef PG8_SA
#undef PG8_SB
#undef PG8_STAGE
#undef PG8_LDA
#undef PG8_LDB
#undef PG8_MMA
#undef PG8_WAIT_V
#undef PG8_WAIT_L
#undef PG8_BAR
#undef PG8_SCHED
}
}
#define XB_TMO      128
#define XB_XCNT(j)  (256  + 64 * (j))
#define XB_XSUB(j)  (1280 + 64 * (j))
#define XB_XGEN(j)  (2304 + 64 * (j))
#define XB_TOP      3328
#define XB_TOPGEN   3392
#define XCD_BAR_WORDS 3456
#define XB_SPIN_CAP (1u << 18)
#define LAS __attribute__((address_space(3)))

__device__ __forceinline__ unsigned xb_ld(unsigned* p)              { return __hip_atomic_load(p, __ATOMIC_RELAXED, __HIP_MEMORY_SCOPE_AGENT); }
__device__ __forceinline__ unsigned xb_add(unsigned* p, unsigned v) { return __hip_atomic_fetch_add(p, v, __ATOMIC_RELAXED, __HIP_MEMORY_SCOPE_AGENT); }
__device__ __forceinline__ unsigned xb_xcc_id() { return (unsigned)__builtin_amdgcn_s_getreg((3 << 11) | 20) & 0xFu; }
#define XB_SPIN(cond, bar) do { unsigned _sp = 0; while (cond) { __builtin_amdgcn_s_sleep(1); \
    if ((++_sp & 255u) == 0u) { if (xb_ld(&(bar)[XB_TMO])) break; if (_sp > XB_SPIN_CAP) { atomicAdd(&(bar)[XB_TMO], 1u); break; } } } } while (0)

struct XcdBarrier {
    unsigned* bar; unsigned x;
    volatile LAS unsigned* st;
};

__device__ __forceinline__ XcdBarrier xcd_barrier_post(unsigned* bar, volatile LAS unsigned* st) {
    XcdBarrier b; b.bar = bar; b.x = xb_xcc_id(); b.st = st;
    if (threadIdx.x == 0) (void)xb_add(&bar[XB_XCNT(b.x)], 1u);
    return b;
}
__device__ __forceinline__ void xcd_barrier_complete(unsigned* bar, unsigned x, unsigned& nloc, unsigned& nx) {
    const unsigned G = gridDim.x * gridDim.y * gridDim.z;
    unsigned sum, cnt, mine, sp = 0u;
    for (;;) {
        sum = 0u; cnt = 0u; mine = 0u;
#pragma unroll
        for (unsigned j = 0; j < 16; ++j) { const unsigned c = xb_ld(&bar[XB_XCNT(j)]); sum += c; cnt += (c > 0u) ? 1u : 0u; mine = (j == x) ? c : mine; }
        if (sum == G) break;
        __builtin_amdgcn_s_sleep(1);
        if ((++sp & 255u) == 0u) { if (xb_ld(&bar[XB_TMO])) break; if (sp > XB_SPIN_CAP) { atomicAdd(&bar[XB_TMO], 1u); break; } }
    }
    nloc = mine > 0u ? mine : 1u; nx = cnt > 0u ? cnt : 1u;
}

__device__ __forceinline__ void xcd_barrier(const XcdBarrier& b) {
    asm volatile("s_waitcnt vmcnt(0)" ::: "memory");
    __syncthreads();
    if (threadIdx.x == 0) {
        unsigned* bar = b.bar;
        __builtin_amdgcn_s_waitcnt(0);
        unsigned nloc = b.st[0], nx = b.st[1];
        if (nloc == 0u) { xcd_barrier_complete(bar, b.x, nloc, nx); b.st[0] = nloc; b.st[1] = nx; }
        const unsigned old = xb_add(&bar[XB_XSUB(b.x)], 1u);
        const unsigned gen = old / nloc;
        if (old + 1u == (gen + 1u) * nloc) {
            __builtin_amdgcn_fence(__ATOMIC_RELEASE, "agent");
            asm volatile("s_waitcnt vmcnt(0)" ::: "memory");
            const unsigned og = xb_add(&bar[XB_TOP], 1u);
            const unsigned tg = og / nx;
            if (og + 1u == (tg + 1u) * nx) xb_add(&bar[XB_TOPGEN], 1u);
            else XB_SPIN(xb_ld(&bar[XB_TOPGEN]) == tg, bar);
            __builtin_amdgcn_fence(__ATOMIC_ACQUIRE, "agent");
            xb_add(&bar[XB_XGEN(b.x)], 1u);
            asm volatile("s_waitcnt vmcnt(0)" ::: "memory");
        } else {
            XB_SPIN(xb_ld(&bar[XB_XGEN(b.x)]) == gen, bar);
            __builtin_amdgcn_fence(__ATOMIC_ACQUIRE, "agent");
            asm volatile("s_waitcnt vmcnt(0)" ::: "memory");
        }
    }
    __syncthreads();
}

#ifndef PROBE_PH
#define PROBE_PH -1
#define PROBE_N 0
#endif
namespace mk {
typedef unsigned short bf16;
typedef unsigned v4u __attribute__((ext_vector_type(4)));
typedef unsigned v2u __attribute__((ext_vector_type(2)));
typedef float f32x4 __attribute__((ext_vector_type(4)));
typedef short bf16x8 __attribute__((ext_vector_type(8)));
typedef __bf16 bf16x2 __attribute__((ext_vector_type(2)));

constexpr int NB = 8, SEQ = 2048, DM = 1024, T = NB * SEQ, NQKV = 3072;
constexpr float LN_EPS = 1e-5f;
constexpr float DN_ALPHA = 1.189207115002721f;
constexpr int NWAVES = 8, NTHR = 512;

constexpr size_t MiB = 1u << 20;
constexpr size_t WS_CTL = 0;
constexpr size_t CTL_ZERO_BYTES = 64 * 1024;
constexpr size_t WS_MODP = 1 * MiB;
constexpr size_t WS_MOD = 4 * MiB;
constexpr size_t WS_KMEAN = 4 * MiB + 256 * 1024;
constexpr size_t WS_WIN = 5 * MiB;
constexpr size_t WS_WOUT = 11 * MiB;
constexpr size_t WS_WQ = 13 * MiB;
constexpr size_t WS_U = 16 * MiB;
constexpr size_t WS_V = 48 * MiB;
constexpr size_t WS_H = 80 * MiB;
constexpr size_t WS_QKV = 112 * MiB;
constexpr size_t WS_ATT = 208 * MiB;
constexpr size_t WS_END = 256 * MiB;
constexpr int CW_BAR = 4096;
constexpr float PEER_USCALE = 32.f;

constexpr int RING_BYTES = 131072;
constexpr int MISC_OFF = RING_BYTES + 320;
constexpr int LDS_BYTES = 147456;

__device__ __forceinline__ unsigned f2bf(float f) { unsigned u = __float_as_uint(f); return (u + 0x7fffu + ((u >> 16) & 1u)) >> 16; }
__device__ __forceinline__ unsigned pk2(float lo, float hi) { return f2bf(lo) | (f2bf(hi) << 16); }
__device__ __forceinline__ float bflo(unsigned w) { return __uint_as_float(w << 16); }
__device__ __forceinline__ float bfhi(unsigned w) { return __uint_as_float(w & 0xffff0000u); }
__device__ __forceinline__ float dot2(unsigned a, unsigned b, float acc) { return __builtin_amdgcn_fdot2_f32_bf16(__builtin_bit_cast(bf16x2, a), __builtin_bit_cast(bf16x2, b), acc, false); }
__device__ __forceinline__ float wave_sum(float v) {
#pragma unroll
    for (int o = 1; o < 64; o <<= 1) v += __shfl_xor(v, o);
    return v;
}
__device__ __forceinline__ int t5_bucket(int d) {
    if (d < 16) return d;
    int b = 16;
    b += (d >= 22); b += (d >= 30); b += (d >= 40); b += (d >= 54); b += (d >= 73); b += (d >= 99); b += (d >= 134); b += (d >= 182);
    b += (d >= 246); b += (d >= 332); b += (d >= 450); b += (d >= 609); b += (d >= 825); b += (d >= 1117); b += (d >= 1513);
    return b;
}

struct Args {
    const float* in[17]; float* out; unsigned char* ws; int ph_lo, ph_hi, bar_idx, pad;
};

template <int MODE>
__device__ __forceinline__ void transpose_item(const float* W, int K, int N, bf16* WT, LAS float* scr, int item, int lane, const float* gna, const float* gnb) {
    const int nblk = N / 32, kb = item / nblk, nb = item % nblk, k0 = 64 * kb, n0 = 32 * nb;
    float cs = 1.f;
    if (MODE == 1) { if (n0 < 512 || (n0 >= 1536 && n0 < 2048)) cs = 0.125f; }
#pragma unroll 8
    for (int i = 0; i < 32; ++i) { const int kk = 2 * i + (lane >> 5); float v = W[(size_t)(k0 + kk) * N + n0 + (lane & 31)] * cs;
        if (MODE == 2) { const int k = k0 + kk; v *= (k < 512) ? gna[k] : gnb[k - 512]; }
        scr[kk * 33 + (lane & 31)] = v; }
    asm volatile("s_waitcnt lgkmcnt(0)" ::: "memory");
    const int c = lane & 7;
#pragma unroll
    for (int j = 0; j < 4; ++j) { const int n = (lane >> 3) + 8 * j; const LAS float* s = scr + (8 * c) * 33 + n;
        v4u o; o.x = pk2(s[0 * 33], s[1 * 33]); o.y = pk2(s[2 * 33], s[3 * 33]); o.z = pk2(s[4 * 33], s[5 * 33]); o.w = pk2(s[6 * 33], s[7 * 33]);
        *(v4u*)(WT + (size_t)(n0 + n) * K + k0 + 8 * c) = o; }
    asm volatile("s_waitcnt lgkmcnt(0)" ::: "memory");
}

__device__ __forceinline__ void p0_prologue(const Args& a, LAS unsigned char* lds, int G, int tid, int lane, int wave) {
    unsigned char* ws = a.ws;
    {
        const float* c = a.in[1]; const float* w_ada = a.in[2]; float* modp = (float*)(ws + WS_MODP);
        LAS float* sc = (LAS float*)lds;
        for (int item = blockIdx.x; item < 192; item += G) {
            const int ks = item / 12, cb = item % 12;
            { const int b = tid >> 6, i = tid & 63; const float v = c[b * DM + ks * 64 + i]; sc[b * 64 + i] = v / (1.f + __expf(-v)); }
            __syncthreads();
            const int col = cb * 512 + tid;
            float acc[8];
#pragma unroll
            for (int b = 0; b < 8; ++b) acc[b] = 0.f;
#pragma unroll 8
            for (int i = 0; i < 64; ++i) { const float w = w_ada[(size_t)(ks * 64 + i) * 6144 + col];
#pragma unroll
                for (int b = 0; b < 8; ++b) acc[b] += sc[b * 64 + i] * w; }
#pragma unroll
            for (int b = 0; b < 8; ++b) modp[(size_t)(ks * 8 + b) * 6144 + col] = acc[b];
            __syncthreads();
        }
    }
    {
        LAS float* scr = (LAS float*)(lds + wave * 16384);
        const int gw = blockIdx.x * NWAVES + wave, NGW = G * NWAVES;
        constexpr int I_IN = 16 * 96, I_O = 16 * 32, I_Q = 16 * 32;
        for (int it = gw; it < I_IN + I_O + I_Q; it += NGW) {
            int r = it;
            if (r < I_IN) { transpose_item<1>(a.in[4], DM, NQKV, (bf16*)(ws + WS_WIN), scr, r, lane, nullptr, nullptr); continue; } r -= I_IN;
            if (r < I_O) { transpose_item<2>(a.in[8], DM, DM, (bf16*)(ws + WS_WOUT), scr, r, lane, a.in[6], a.in[7]); continue; } r -= I_O;
            transpose_item<0>(a.in[11], DM, DM, (bf16*)(ws + WS_WQ), scr, r, lane, nullptr, nullptr);
        }
    }
    {
        const size_t nthr = (size_t)G * NTHR, gt = (size_t)blockIdx.x * NTHR + tid;
        const size_t per = (size_t)16384 * 1024 / 16;
        for (size_t i = gt; i < 2 * per; i += nthr) {
            const bool second = i >= per; const size_t j = second ? i - per : i; const float sc = second ? 1.f : PEER_USCALE;
            const f32x4* src = (const f32x4*)(second ? a.in[14] : a.in[13]) + 4 * j;
            v4u o;
#pragma unroll
            for (int q = 0; q < 4; ++q) { const f32x4 p = src[q]; int w = 0;
                w = __builtin_amdgcn_cvt_pk_fp8_f32(p.x * sc, p.y * sc, w, false); w = __builtin_amdgcn_cvt_pk_fp8_f32(p.z * sc, p.w * sc, w, true); o[q] = (unsigned)w; }
            ((v4u*)(ws + (second ? WS_V : WS_U)))[j] = o;
        }
        float* km = (float*)(ws + WS_KMEAN);
        for (size_t i = gt; i < 32768; i += nthr) km[i] = 0.f;
    }
}

__device__ __forceinline__ void p1_mod_h(const Args& a, LAS unsigned char* lds, int G, int tid, int lane, int wave) {
    unsigned char* ws = a.ws;
    const float* modp = (const float*)(ws + WS_MODP); const float* b_ada = a.in[3];
    float* mod = (float*)(ws + WS_MOD);
    for (int i = blockIdx.x * NTHR + tid; i < 8 * 6144; i += G * NTHR) {
        const int b = i / 6144, j = i % 6144; float s = b_ada[j];
#pragma unroll
        for (int ks = 0; ks < 16; ++ks) s += modp[(size_t)(ks * 8 + b) * 6144 + j];
        mod[i] = s;
    }
    LAS float* sm = (LAS float*)lds;
    const float* x = a.in[0]; bf16* H = (bf16*)(ws + WS_H);
    int curb = -1;
    for (int rb = blockIdx.x; rb < T / 64; rb += G) {
        const int b = rb >> 5;
        if (b != curb) {
            __syncthreads();
            for (int j = tid; j < 2048; j += NTHR) { float s = b_ada[j];
#pragma unroll
                for (int ks = 0; ks < 16; ++ks) s += modp[(size_t)(ks * 8 + b) * 6144 + j];
                sm[j] = s; }
            __syncthreads();
            curb = b;
        }
#pragma unroll 2
        for (int r = 0; r < 8; ++r) {
            const int row = rb * 64 + wave * 8 + r;
#pragma unroll
            for (int hf = 0; hf < 2; ++hf) {
                const int c0 = hf * 512 + 8 * lane;
                const f32x4 p = *(const f32x4*)(x + (size_t)row * DM + c0), q = *(const f32x4*)(x + (size_t)row * DM + c0 + 4);
                const f32x4 s0 = *(const LAS f32x4*)(sm + 1024 + c0), s1 = *(const LAS f32x4*)(sm + 1024 + c0 + 4);
                const f32x4 h0 = *(const LAS f32x4*)(sm + c0), h1 = *(const LAS f32x4*)(sm + c0 + 4);
                v4u o; o.x = pk2(p.x * (1.f + s0.x) + h0.x, p.y * (1.f + s0.y) + h0.y); o.y = pk2(p.z * (1.f + s0.z) + h0.z, p.w * (1.f + s0.w) + h0.w);
                o.z = pk2(q.x * (1.f + s1.x) + h1.x, q.y * (1.f + s1.y) + h1.y); o.w = pk2(q.z * (1.f + s1.z) + h1.z, q.w * (1.f + s1.w) + h1.w);
                *(v4u*)(H + (size_t)row * DM + c0) = o;
            }
        }
    }
}

__device__ __forceinline__ void p3_kmean(const Args& a, LAS unsigned char* lds, int G, int tid) {
    unsigned char* ws = a.ws; const bf16* QKV = (const bf16*)(ws + WS_QKV); float* km = (float*)(ws + WS_KMEAN);
    LAS float* red = (LAS float*)lds;
    for (int item = blockIdx.x; item < 256; item += G) {
        const int b = item >> 5, n = (item >> 2) & 7, rq = item & 3;
        const int cp = tid & 255, rg = tid >> 8;
        const size_t row0 = (size_t)b * SEQ + n * 256 + rq * 64 + rg * 32;
        float s0 = 0.f, s1 = 0.f;
#pragma unroll 8
        for (int r = 0; r < 32; ++r) { const unsigned w = *(const unsigned*)(QKV + (row0 + r) * NQKV + 512 + 2 * cp); s0 += bflo(w); s1 += bfhi(w); }
        if (rg == 1) { red[2 * cp] = s0; red[2 * cp + 1] = s1; }
        __syncthreads();
        if (rg == 0) { s0 += red[2 * cp]; s1 += red[2 * cp + 1]; const int c = 2 * cp, h = c >> 6, d = c & 63;
            float* dst = km + ((b * 8 + h) * 8 + n) * 64 + d;
            atomicAdd(dst, s0 * (1.f / 256.f)); atomicAdd(dst + 1, s1 * (1.f / 256.f)); }
        __syncthreads();
    }
}

__device__ __forceinline__ void unpack8(const v4u w, float (&v)[8]) { v[0] = bflo(w.x); v[1] = bfhi(w.x); v[2] = bflo(w.y); v[3] = bfhi(w.y); v[4] = bflo(w.z); v[5] = bfhi(w.z); v[6] = bflo(w.w); v[7] = bfhi(w.w); }
typedef short v4i16 __attribute__((ext_vector_type(4)));
constexpr float LOG2E = 1.4426950408889634f;
constexpr int AT_ROW = 160, AT_K = 0, AT_V = 128 * AT_ROW, AT_LUT = 256 * AT_ROW, AT_GATE = AT_LUT + 8192, AT_SEL = AT_GATE + 4096, AT_ANY = AT_SEL + 512;
constexpr size_t WS_YA = WS_ATT, WS_OB0 = WS_ATT + 16 * MiB, WS_OB1 = WS_ATT + 32 * MiB, WS_OB2 = WS_H, WS_LSE = WS_H + 16 * MiB;

__device__ __forceinline__ unsigned pkbf(float lo, float hi) { bf16x2 t; t.x = (__bf16)lo; t.y = (__bf16)hi; return __builtin_bit_cast(unsigned, t); }
__device__ __forceinline__ bf16x8 mk8(v4i16 a, v4i16 b) { return __builtin_shufflevector(a, b, 0, 1, 2, 3, 4, 5, 6, 7); }
__device__ __forceinline__ v4i16 tr16(const LAS unsigned char* p) { return __builtin_amdgcn_ds_read_tr16_b64_v4i16((LAS v4i16*)p); }

struct AttnState { bf16x8 qf[2]; f32x4 ot[4]; float m, l; };

template <bool SEL>
__device__ __forceinline__ void attn_chunk(AttnState& st, const LAS unsigned char* lds, int s_lo, int s_hi, int m_lo, int m_hi, int lane, int qidx, int k0, int dmax, bool lanesel) {
    const int q15 = lane & 15, g = lane >> 4;
    f32x4 s0[4], s1[4];
#pragma unroll
    for (int sub = 0; sub < 4; ++sub) {
        s0[sub] = (f32x4){0.f, 0.f, 0.f, 0.f}; s1[sub] = (f32x4){0.f, 0.f, 0.f, 0.f};
        if (sub >= s_lo && sub <= s_hi) {
            const LAS unsigned char* kb = lds + AT_K + (sub * 32 + q15) * AT_ROW + g * 16;
#pragma unroll
            for (int ks = 0; ks < 2; ++ks) {
                const bf16x8 a0 = *(const LAS bf16x8*)(kb + ks * 64), a1 = *(const LAS bf16x8*)(kb + 16 * AT_ROW + ks * 64);
                s0[sub] = __builtin_amdgcn_mfma_f32_16x16x32_bf16(a0, st.qf[ks], s0[sub], 0, 0, 0);
                s1[sub] = __builtin_amdgcn_mfma_f32_16x16x32_bf16(a1, st.qf[ks], s1[sub], 0, 0, 0);
            }
        }
    }
    const LAS float* lut = (const LAS float*)(lds + AT_LUT);
    float sc[4][8]; float mx = -INFINITY;
#pragma unroll
    for (int sub = 0; sub < 4; ++sub) {
        const float sv[8] = {s0[sub].x, s0[sub].y, s0[sub].z, s0[sub].w, s1[sub].x, s1[sub].y, s1[sub].z, s1[sub].w};
        const int dbase = qidx - (k0 + sub * 32 + 4 * g);
        if (sub < s_lo || sub > s_hi) {
#pragma unroll
            for (int r = 0; r < 8; ++r) sc[sub][r] = -INFINITY;
        } else if (sub >= m_lo && sub <= m_hi) {
#pragma unroll
            for (int r = 0; r < 8; ++r) {
                const int d = dbase - (r & 3) - (r >> 2) * 16;
                const bool ok = (!SEL || lanesel) && d >= 0 && d <= dmax;
                const int dc = d < 0 ? 0 : (d > dmax ? dmax : d);
                sc[sub][r] = ok ? (sv[r] * LOG2E + lut[dc]) : -INFINITY;
                mx = fmaxf(mx, sc[sub][r]);
            }
        } else {
            const LAS float* lp = lut + (dbase - 19);
#pragma unroll
            for (int r = 0; r < 8; ++r) {
                const float v = sv[r] * LOG2E + lp[19 - (r & 3) - (r >> 2) * 16];
                sc[sub][r] = (SEL && !lanesel) ? -INFINITY : v;
                mx = fmaxf(mx, sc[sub][r]);
            }
        }
    }
    mx = fmaxf(mx, __shfl_xor(mx, 16)); mx = fmaxf(mx, __shfl_xor(mx, 32));
    const float mn = fmaxf(st.m, mx), mu = (mn == -INFINITY) ? 0.f : mn;
    const float alpha = __builtin_amdgcn_exp2f(st.m - mu);
    float ps = 0.f;
#pragma unroll
    for (int sub = 0; sub < 4; ++sub) {
        if (sub >= s_lo && sub <= s_hi) {
#pragma unroll
            for (int r = 0; r < 8; ++r) { sc[sub][r] = __builtin_amdgcn_exp2f(sc[sub][r] - mu); ps += sc[sub][r]; }
        }
    }
    st.l = st.l * alpha + ps; st.m = mn;
    if (!__all(alpha == 1.f)) {
#pragma unroll
        for (int n = 0; n < 4; ++n) st.ot[n] *= alpha;
    }
#pragma unroll
    for (int sub = 0; sub < 4; ++sub) {
        if (sub >= s_lo && sub <= s_hi) {
            v4u pw; pw.x = pkbf(sc[sub][0], sc[sub][1]); pw.y = pkbf(sc[sub][2], sc[sub][3]); pw.z = pkbf(sc[sub][4], sc[sub][5]); pw.w = pkbf(sc[sub][6], sc[sub][7]);
            const bf16x8 pb = __builtin_bit_cast(bf16x8, pw);
            const LAS unsigned char* vb = lds + AT_V + (sub * 32 + 4 * g + (q15 >> 2)) * AT_ROW + (q15 & 3) * 8;
#pragma unroll
            for (int n = 0; n < 4; ++n) {
                const v4i16 r1 = tr16(vb + n * 32), r2 = tr16(vb + 16 * AT_ROW + n * 32);
                st.ot[n] = __builtin_amdgcn_mfma_f32_16x16x32_bf16(mk8(r1, r2), pb, st.ot[n], 0, 0, 0);
            }
        }
    }
}

struct ChunkRegs { v4u k0, k1, v0, v1; };
__device__ __forceinline__ void chunk_fetch(ChunkRegs& c, const bf16* kbase  , int kstride_tok, int tid) {
    const int r0 = tid >> 3, cc = tid & 7;
    const bf16* p0 = kbase + (size_t)(r0 * kstride_tok) * NQKV + cc * 8; const bf16* p1 = kbase + (size_t)((r0 + 64) * kstride_tok) * NQKV + cc * 8;
    c.k0 = *(const v4u*)p0; c.k1 = *(const v4u*)p1; c.v0 = *(const v4u*)(p0 + 512); c.v1 = *(const v4u*)(p1 + 512);
}
__device__ __forceinline__ void chunk_store(const ChunkRegs& c, LAS unsigned char* lds, int tid) {
    const int r0 = tid >> 3, cc = tid & 7;
    *(LAS v4u*)(lds + AT_K + r0 * AT_ROW + cc * 16) = c.k0; *(LAS v4u*)(lds + AT_K + (r0 + 64) * AT_ROW + cc * 16) = c.k1;
    *(LAS v4u*)(lds + AT_V + r0 * AT_ROW + cc * 16) = c.v0; *(LAS v4u*)(lds + AT_V + (r0 + 64) * AT_ROW + cc * 16) = c.v1;
}
__device__ __forceinline__ void attn_init(AttnState& st, const bf16* qrow  , int lane) {
    const int g = lane >> 4;
    st.qf[0] = *(const bf16x8*)(qrow + 8 * g); st.qf[1] = *(const bf16x8*)(qrow + 32 + 8 * g);
#pragma unroll
    for (int n = 0; n < 4; ++n) st.ot[n] = (f32x4){0.f, 0.f, 0.f, 0.f};
    st.m = -INFINITY; st.l = 0.f;
}
__device__ __forceinline__ float attn_finish(AttnState& st, bf16* orow  , int lane) {
    float l = st.l; l += __shfl_xor(l, 16); l += __shfl_xor(l, 32);
    const float inv = 1.f / l; const int g = lane >> 4;
#pragma unroll
    for (int n = 0; n < 4; ++n) { v2u w; w.x = pkbf(st.ot[n][0] * inv, st.ot[n][1] * inv); w.y = pkbf(st.ot[n][2] * inv, st.ot[n][3] * inv);
        *(v2u*)(orow + 16 * n + 4 * g) = w; }
    return l;
}

template <int MODE>
__device__ __forceinline__ void moba_item(const Args& a, LAS unsigned char* lds, int item, int tid, int lane, int wave) {
    unsigned char* ws = a.ws; const bf16* QKV = (const bf16*)(ws + WS_QKV);
    const int qblk = 7 - (item >> 7), idx = item & 127, bh = idx >> 1, b = bh >> 3, h = bh & 7, qt = 2 * qblk + (idx & 1);
    const size_t tokb = (size_t)b * SEQ;
    LAS float* lut = (LAS float*)(lds + AT_LUT); LAS float* gates = (LAS float*)(lds + AT_GATE); LAS unsigned* selm = (LAS unsigned*)(lds + AT_SEL); LAS unsigned* anyw = (LAS unsigned*)(lds + AT_ANY);
    __syncthreads();
    for (int d = tid; d < 2048; d += NTHR) lut[d] = a.in[5][h * 32 + t5_bucket(d)] * LOG2E;
    if (tid == 0) *anyw = 0u;
    unsigned anysel;
    if (qblk > 3) {
        {
            const int qi = tid & 127, gi = tid >> 7;
            const bf16* qp = QKV + (tokb + qt * 128 + qi) * NQKV + h * 64;
            float ga = 0.f, gb = 0.f; const float* kma = (const float*)(ws + WS_KMEAN) + ((b * 8 + h) * 8 + gi) * 64; const float* kmb = kma + 4 * 64;
#pragma unroll
            for (int i = 0; i < 8; ++i) { const v4u w = *(const v4u*)(qp + 8 * i); float qv[8]; unpack8(w, qv);
#pragma unroll
                for (int j = 0; j < 8; ++j) { ga += qv[j] * kma[8 * i + j]; gb += qv[j] * kmb[8 * i + j]; } }
            gates[qi * 8 + gi] = ga; gates[qi * 8 + gi + 4] = gb;
        }
        __syncthreads();
        if (tid < 128) {
            float gv[8];
#pragma unroll
            for (int n = 0; n < 8; ++n) gv[n] = (n < qblk) ? gates[tid * 8 + n] : -INFINITY;
            unsigned sel = 0;
#pragma unroll
            for (int r = 0; r < 3; ++r) { float best = -INFINITY; int bi = 0;
#pragma unroll
                for (int n = 0; n < 8; ++n) { const bool take = !((sel >> n) & 1u) && (gv[n] > best); best = take ? gv[n] : best; bi = take ? n : bi; }
                sel |= 1u << bi; }
            selm[tid] = sel; atomicOr((unsigned*)anyw, sel);
        }
        __syncthreads();
        anysel = *anyw;
    } else { anysel = (1u << qblk) - 1u; __syncthreads(); }
    const unsigned mysel = (qblk > 3) ? selm[wave * 16 + (lane & 15)] : anysel;
    unsigned cm = 0;
    for (int n = 0; n < qblk; ++n) if ((anysel >> n) & 1u) cm |= 3u << (2 * n);
    cm |= 1u << (2 * qblk); if (qt & 1) cm |= 2u << (2 * qblk);
    const int qpos = qt * 128 + wave * 16 + (lane & 15), wq_hi = qt * 128 + wave * 16 + 15, wq_lo = qt * 128 + wave * 16;
    AttnState st; attn_init(st, QKV + (tokb + qpos) * NQKV + h * 64, lane);
    ChunkRegs cr; const bf16* kcol = QKV + tokb * NQKV + 512 + h * 64;
    { const int c0 = __builtin_ctz(cm); if (MODE != 2) chunk_fetch(cr, kcol + (size_t)(c0 * 128) * NQKV, 1, tid); }
    while (cm) {
        const int cur = __builtin_ctz(cm); cm &= cm - 1u;
        __syncthreads();
        if (MODE != 2) chunk_store(cr, lds, tid);
        __syncthreads();
        if (cm) { const int nx = __builtin_ctz(cm); if (MODE != 2) chunk_fetch(cr, kcol + (size_t)(nx * 128) * NQKV, 1, tid); }
        const int n = cur >> 1, k0 = cur * 128; const bool own = (n == qblk);
        const bool lsel = own || ((mysel >> n) & 1u);
        if (own) {
            int s_hi = (wq_hi - k0) >> 5; s_hi = s_hi > 3 ? 3 : s_hi;
            int m_lo = (wq_lo - k0 + 1) >> 5; m_lo = m_lo < 0 ? 0 : m_lo;
            if (s_hi >= 0 && MODE != 3) attn_chunk<false>(st, lds, 0, s_hi, m_lo, s_hi, lane, qpos, k0, 2047, true);
        } else if (__any(lsel)) {
            if (MODE != 3) attn_chunk<true>(st, lds, 0, 3, 4, 3, lane, qpos, k0, 2047, lsel);
        }
    }
    attn_finish(st, (bf16*)(ws + WS_YA) + (tokb + qpos) * 512 + h * 64, lane);
}

template <int MODE>
__device__ __forceinline__ void dil_item(const Args& a, LAS unsigned char* lds, int item, int tid, int lane, int wave) {
    unsigned char* ws = a.ws; const bf16* QKV = (const bf16*)(ws + WS_QKV);
    const int grp = item >> 4, sub16 = item & 15, br = grp % 3, bh = grp / 3, b = bh >> 3, h = bh & 7;
    const int dil = (br == 0) ? 1 : (br == 1 ? 4 : 16);
    const int r = (br == 0) ? 0 : (br == 1 ? (sub16 >> 2) : sub16), j = (br == 0) ? sub16 : (br == 1 ? (sub16 & 3) : 0);
    const size_t tokb = (size_t)b * SEQ;
    LAS float* lut = (LAS float*)(lds + AT_LUT);
    __syncthreads();
    for (int d = tid; d <= 128; d += NTHR) lut[d] = a.in[5][(8 + h) * 32 + t5_bucket(d * dil)] * LOG2E;
    const int lq = 128 * j + wave * 16 + (lane & 15);
    const size_t qtok = tokb + (size_t)lq * dil + r;
    AttnState st; attn_init(st, QKV + qtok * NQKV + 1536 + h * 64, lane);
    ChunkRegs cr; const bf16* kcol = QKV + (tokb + r) * NQKV + 2048 + h * 64;
    const int c_first = (j > 0) ? 0 : 1;
    if (MODE != 2) chunk_fetch(cr, kcol + (size_t)((128 * (j - 1 + c_first)) * dil) * NQKV, dil, tid);
#pragma unroll 1
    for (int c = c_first; c < 2; ++c) {
        __syncthreads();
        if (MODE != 2) chunk_store(cr, lds, tid);
        __syncthreads();
        if (c == 0) if (MODE != 2) chunk_fetch(cr, kcol + (size_t)((128 * j) * dil) * NQKV, dil, tid);
        const int k0 = 128 * (j - 1 + c), wh = wave >> 1;
        const int s_lo = (c == 0) ? wh : 0, s_hi = (c == 0) ? 3 : wh;
        if (MODE != 3) attn_chunk<false>(st, lds, s_lo, s_hi, wh, wh, lane, lq, k0, 128, true);
    }
    bf16* ob = (bf16*)(ws + (br == 0 ? WS_OB0 : (br == 1 ? WS_OB1 : WS_OB2)));
    const float l = attn_finish(st, ob + qtok * 512 + h * 64, lane);
    if ((lane >> 4) == 0) ((float*)(ws + WS_LSE))[((size_t)br * T + qtok) * 8 + h] = st.m + __builtin_amdgcn_logf(l);
}

template <int MODE>
__device__ __forceinline__ void p4_attn(const Args& a, LAS unsigned char* lds, int G, int tid, int lane, int wave) {
    for (int v = blockIdx.x; v < 256; v += G) {
        moba_item<MODE>(a, lds, v, tid, lane, wave);
        moba_item<MODE>(a, lds, 256 + v, tid, lane, wave);
        moba_item<MODE>(a, lds, 767 - v, tid, lane, wave);
        moba_item<MODE>(a, lds, 1023 - v, tid, lane, wave);
#pragma unroll 1
        for (int i = 0; i < 12; ++i) dil_item<MODE>(a, lds, v * 12 + i, tid, lane, wave);
    }
}

__device__ __forceinline__ void p5_combine_rms(const Args& a, int G, int lane, int wave) {
    unsigned char* ws = a.ws; const bf16* YA = (const bf16*)(ws + WS_YA);
    const bf16* OB0 = (const bf16*)(ws + WS_OB0); const bf16* OB1 = (const bf16*)(ws + WS_OB1); const bf16* OB2 = (const bf16*)(ws + WS_OB2);
    const float* LSE = (const float*)(ws + WS_LSE); bf16* A2 = (bf16*)a.out;
    for (int row = blockIdx.x * NWAVES + wave; row < T; row += G * NWAVES) {
        float v[8], o0[8], o1[8], o2[8];
        unpack8(*(const v4u*)(YA + (size_t)row * 512 + 8 * lane), v);
        unpack8(*(const v4u*)(OB0 + (size_t)row * 512 + 8 * lane), o0); unpack8(*(const v4u*)(OB1 + (size_t)row * 512 + 8 * lane), o1); unpack8(*(const v4u*)(OB2 + (size_t)row * 512 + 8 * lane), o2);
        const int h = lane >> 3;
        const float l0 = LSE[((size_t)0 * T + row) * 8 + h], l1 = LSE[((size_t)1 * T + row) * 8 + h], l2 = LSE[((size_t)2 * T + row) * 8 + h];
        const float mx = fmaxf(l0, fmaxf(l1, l2));
        float w0 = __builtin_amdgcn_exp2f(l0 - mx), w1 = __builtin_amdgcn_exp2f(l1 - mx), w2 = __builtin_amdgcn_exp2f(l2 - mx);
        const float inv = 1.f / (w0 + w1 + w2); w0 *= inv; w1 *= inv; w2 *= inv;
        float ssa = 0.f, ssb = 0.f;
#pragma unroll
        for (int j = 0; j < 8; ++j) { o0[j] = w0 * o0[j] + w1 * o1[j] + w2 * o2[j]; ssa += v[j] * v[j]; ssb += o0[j] * o0[j]; }
        ssa = wave_sum(ssa); ssb = wave_sum(ssb);
        const float ra = rsqrtf(ssa * (1.f / 512.f) + LN_EPS), rb = rsqrtf(ssb * (1.f / 512.f) + LN_EPS);
        v4u o; o.x = pkbf(v[0] * ra, v[1] * ra); o.y = pkbf(v[2] * ra, v[3] * ra); o.z = pkbf(v[4] * ra, v[5] * ra); o.w = pkbf(v[6] * ra, v[7] * ra);
        *(v4u*)(A2 + (size_t)row * DM + 8 * lane) = o;
        o.x = pkbf(o0[0] * rb, o0[1] * rb); o.y = pkbf(o0[2] * rb, o0[3] * rb); o.z = pkbf(o0[4] * rb, o0[5] * rb); o.w = pkbf(o0[6] * rb, o0[7] * rb);
        *(v4u*)(A2 + (size_t)row * DM + 512 + 8 * lane) = o;
    }
}
__device__ __forceinline__ void load16(const float* p, int lane, float (&v)[16]) {
#pragma unroll
    for (int q = 0; q < 4; ++q) { const f32x4 t = *(const f32x4*)(p + (q >> 1) * 512 + 8 * lane + (q & 1) * 4); v[4 * q] = t.x; v[4 * q + 1] = t.y; v[4 * q + 2] = t.z; v[4 * q + 3] = t.w; }
}
__device__ __forceinline__ void store16(float* p, int lane, const float (&v)[16]) {
#pragma unroll
    for (int q = 0; q < 4; ++q) { f32x4 t; t.x = v[4 * q]; t.y = v[4 * q + 1]; t.z = v[4 * q + 2]; t.w = v[4 * q + 3]; *(f32x4*)(p + (q >> 1) * 512 + 8 * lane + (q & 1) * 4) = t; }
}
__device__ __forceinline__ void layer_norm16(float (&z)[16], const float* g, const float* bta, int lane) {
    float s = 0.f;
#pragma unroll
    for (int j = 0; j < 16; ++j) s += z[j];
    const float mu = wave_sum(s) * (1.f / DM); float q = 0.f;
#pragma unroll
    for (int j = 0; j < 16; ++j) { z[j] -= mu; q += z[j] * z[j]; }
    const float rs = rsqrtf(wave_sum(q) * (1.f / DM) + LN_EPS);
    float gg[16], bb[16]; load16(g, lane, gg); load16(bta, lane, bb);
#pragma unroll
    for (int j = 0; j < 16; ++j) z[j] = z[j] * rs * gg[j] + bb[j];
}

__device__ __forceinline__ void p7_ln1(const Args& a, int G, int lane, int wave) {
    unsigned char* ws = a.ws; const float* x = a.in[0]; const float* Y = (const float*)(ws + WS_QKV); const float* mod = (const float*)(ws + WS_MOD);
    float* x1 = a.out; bf16* H2 = (bf16*)(ws + WS_H);
    for (int row = blockIdx.x * NWAVES + wave; row < T; row += G * NWAVES) {
        const int b = row >> 11; float z[16], y[16], t[16];
        load16(x + (size_t)row * DM, lane, z); load16(Y + (size_t)row * DM, lane, y); load16(mod + b * 6144 + 2048, lane, t);
#pragma unroll
        for (int j = 0; j < 16; ++j) z[j] = DN_ALPHA * z[j] + (1.f + t[j]) * y[j];
        layer_norm16(z, a.in[9], a.in[10], lane);
        store16(x1 + (size_t)row * DM, lane, z);
        load16(mod + b * 6144 + 4096, lane, y); load16(mod + b * 6144 + 3072, lane, t);
#pragma unroll
        for (int j = 0; j < 16; ++j) z[j] = z[j] * (1.f + y[j]) + t[j];
        v4u o0, o1; o0.x = pk2(z[0], z[1]); o0.y = pk2(z[2], z[3]); o0.z = pk2(z[4], z[5]); o0.w = pk2(z[6], z[7]);
        o1.x = pk2(z[8], z[9]); o1.y = pk2(z[10], z[11]); o1.z = pk2(z[12], z[13]); o1.w = pk2(z[14], z[15]);
        *(v4u*)(H2 + (size_t)row * DM + 8 * lane) = o0; *(v4u*)(H2 + (size_t)row * DM + 512 + 8 * lane) = o1;
    }
}

__device__ __forceinline__ unsigned mono(float s) { const unsigned u = __float_as_uint(s); return u ^ ((unsigned)((int)u >> 31) | 0x80000000u); }
__device__ __forceinline__ float unmono(unsigned k) { return __uint_as_float((k & 0x80000000u) ? (k ^ 0x80000000u) : ~k); }
__device__ __forceinline__ void ins16(unsigned (&t)[16], unsigned x) {
#pragma unroll
    for (int j = 0; j < 16; ++j) { const unsigned hi = t[j] > x ? t[j] : x; x = t[j] > x ? x : t[j]; t[j] = hi; }
}
__device__ __forceinline__ unsigned lookup8(unsigned long long lo, unsigned long long hi, int idx) {
    const unsigned long long w = (idx & 8) ? hi : lo;
    return (unsigned)(w >> ((idx & 7) * 8)) & 0xffu;
}
template <int N> __device__ __forceinline__ void sort_desc(unsigned (&a)[N]) {
#pragma unroll
    for (int k = 2; k <= N; k <<= 1)
#pragma unroll
        for (int j = k >> 1; j > 0; j >>= 1)
#pragma unroll
            for (int i = 0; i < N; ++i) { const int l = i ^ j;
                if (l > i) { const unsigned x = a[i], y = a[l], hi = x > y ? x : y, lo = x > y ? y : x;
                    if ((i & k) == 0) { a[i] = hi; a[l] = lo; } else { a[i] = lo; a[l] = hi; } } }
}
__device__ __forceinline__ void merge_top16(unsigned (&a)[16], const unsigned (&b)[16]) {
#pragma unroll
    for (int i = 0; i < 16; ++i) a[i] = a[i] > b[15 - i] ? a[i] : b[15 - i];
#pragma unroll
    for (int j = 8; j > 0; j >>= 1)
#pragma unroll
        for (int i = 0; i < 16; ++i) { const int l = i ^ j; if (l > i) { const unsigned x = a[i], y = a[l]; a[i] = x > y ? x : y; a[l] = x > y ? y : x; } }
}
__device__ __forceinline__ void xmerge(unsigned (&a)[16], int mask) {
    unsigned b[16];
#pragma unroll
    for (int i = 0; i < 16; ++i) b[i] = (unsigned)__shfl_xor((int)a[i], mask);
    merge_top16(a, b);
}
constexpr int TK_ROW = 144;
__device__ __forceinline__ void p9_topk(const Args& a, LAS unsigned char* lds, int G, int tid) {
    unsigned char* ws = a.ws; const float* QP = (const float*)(ws + WS_QKV); const float* sub_keys = a.in[12];
    int* elist = (int*)(ws + WS_ATT); float* glist = (float*)(ws + WS_ATT + 8 * MiB);
    const int lane = tid & 63, wave = tid >> 6, c = lane & 15, g = lane >> 4;
    for (int i = tid; i < 256 * 8; i += NTHR) { const int row = i >> 3, ch = i & 7;
        const f32x4 p = *(const f32x4*)(sub_keys + row * 64 + ch * 8), q = *(const f32x4*)(sub_keys + row * 64 + ch * 8 + 4);
        const float v[8] = {p.x, p.y, p.z, p.w, q.x, q.y, q.z, q.w}; float r[8]; v4u hi, lo;
        hi.x = pkbf(v[0], v[1]); hi.y = pkbf(v[2], v[3]); hi.z = pkbf(v[4], v[5]); hi.w = pkbf(v[6], v[7]);
        r[0] = v[0] - bflo(hi.x); r[1] = v[1] - bfhi(hi.x); r[2] = v[2] - bflo(hi.y); r[3] = v[3] - bfhi(hi.y);
        r[4] = v[4] - bflo(hi.z); r[5] = v[5] - bfhi(hi.z); r[6] = v[6] - bflo(hi.w); r[7] = v[7] - bfhi(hi.w);
        lo.x = pkbf(r[0], r[1]); lo.y = pkbf(r[2], r[3]); lo.z = pkbf(r[4], r[5]); lo.w = pkbf(r[6], r[7]);
        *(LAS v4u*)(lds + row * TK_ROW + ch * 16) = hi; *(LAS v4u*)(lds + 256 * TK_ROW + row * TK_ROW + ch * 16) = lo; }
    __syncthreads();
    for (int task = blockIdx.x * NWAVES + wave; task < T / 2; task += G * NWAVES) {
        const int tok = task * 2 + (c >> 3), head = c & 7;
        unsigned T1[16], T2[16];
#pragma unroll 1
        for (int hf = 0; hf < 2; ++hf) {
            bf16x8 qh[2], ql[2];
#pragma unroll
            for (int ks = 0; ks < 2; ++ks) {
                const float* qp = QP + (size_t)tok * DM + head * 128 + hf * 64 + ks * 32 + 8 * g;
                const f32x4 p = *(const f32x4*)qp, q = *(const f32x4*)(qp + 4);
                v4u hi, lo; hi.x = pkbf(p.x, p.y); hi.y = pkbf(p.z, p.w); hi.z = pkbf(q.x, q.y); hi.w = pkbf(q.z, q.w);
                lo.x = pkbf(p.x - bflo(hi.x), p.y - bfhi(hi.x)); lo.y = pkbf(p.z - bflo(hi.y), p.w - bfhi(hi.y));
                lo.z = pkbf(q.x - bflo(hi.z), q.y - bfhi(hi.z)); lo.w = pkbf(q.z - bflo(hi.w), q.w - bfhi(hi.w));
                qh[ks] = __builtin_bit_cast(bf16x8, hi); ql[ks] = __builtin_bit_cast(bf16x8, lo);
            }
            unsigned P[32];
#pragma unroll
            for (int kt = 0; kt < 8; ++kt) {
                f32x4 acc = {0.f, 0.f, 0.f, 0.f};
#pragma unroll
                for (int ks = 0; ks < 2; ++ks) {
                    const LAS unsigned char* kp = lds + (hf * 128 + kt * 16 + c) * TK_ROW + ks * 64 + g * 16;
                    const bf16x8 kh = *(const LAS bf16x8*)kp, kl = *(const LAS bf16x8*)(kp + 256 * TK_ROW);
                    acc = __builtin_amdgcn_mfma_f32_16x16x32_bf16(kh, qh[ks], acc, 0, 0, 0);
                    acc = __builtin_amdgcn_mfma_f32_16x16x32_bf16(kl, qh[ks], acc, 0, 0, 0);
                    acc = __builtin_amdgcn_mfma_f32_16x16x32_bf16(kh, ql[ks], acc, 0, 0, 0);
                }
#pragma unroll
                for (int r = 0; r < 4; ++r) P[kt * 4 + r] = (mono(acc[r]) & ~127u) | (unsigned)(127 - (kt * 16 + r)) ;
            }
#pragma unroll
            for (int i = 0; i < 32; ++i) P[i] -= (unsigned)(4 * g);
            unsigned A[16], B[16];
#pragma unroll
            for (int i = 0; i < 16; ++i) { A[i] = P[i]; B[i] = P[16 + i]; }
            __builtin_amdgcn_sched_barrier(0);
            sort_desc<16>(A); __builtin_amdgcn_sched_barrier(0); sort_desc<16>(B); __builtin_amdgcn_sched_barrier(0); merge_top16(A, B);
            __builtin_amdgcn_sched_barrier(0);
            xmerge(A, 16); __builtin_amdgcn_sched_barrier(0); xmerge(A, 32); __builtin_amdgcn_sched_barrier(0);
#pragma unroll
            for (int i = 0; i < 16; ++i) { if (hf == 0) T1[i] = A[i]; else T2[i] = A[i]; }
        }
        float v1[16], v2[16]; unsigned long long i1lo = 0, i1hi = 0, i2lo = 0, i2hi = 0;
#pragma unroll
        for (int j = 0; j < 16; ++j) {
            v1[j] = unmono(T1[j] & ~127u); v2[j] = unmono(T2[j] & ~127u);
            const unsigned long long s1 = (unsigned long long)(127u - (T1[j] & 127u)) << ((j & 7) * 8), s2 = (unsigned long long)(127u - (T2[j] & 127u)) << ((j & 7) * 8);
            if (j < 8) { i1lo |= s1; i2lo |= s2; } else { i1hi |= s1; i2hi |= s2; }
        }
        unsigned top[16];
#pragma unroll
        for (int j = 0; j < 16; ++j) top[j] = (mono(v1[0] + v2[j]) & ~255u) | (unsigned)(255 - j);
#pragma unroll
        for (int aa = 1; aa < 16; ++aa)
#pragma unroll
            for (int bb = 0; bb < 16; ++bb)
                if ((aa + 1) * (bb + 1) <= 16) ins16(top, (mono(v1[aa] + v2[bb]) & ~255u) | (unsigned)(255 - (aa * 16 + bb)));
        if (g == 0) {
            float vals[16]; int ex[16]; float sum = 0.f;
            const float vmax = unmono(top[0] & ~255u);
#pragma unroll
            for (int r = 0; r < 16; ++r) { const int pos = 255 - (int)(top[r] & 255u);
                ex[r] = (int)(lookup8(i1lo, i1hi, pos >> 4) * 128u + lookup8(i2lo, i2hi, pos & 15));
                vals[r] = __expf(unmono(top[r] & ~255u) - vmax); sum += vals[r]; }
            const float inv = 1.f / sum; const size_t p = (size_t)tok * 8 + head;
#pragma unroll
            for (int r = 0; r < 4; ++r) {
                *(int4*)(elist + p * 16 + 4 * r) = make_int4(ex[4 * r], ex[4 * r + 1], ex[4 * r + 2], ex[4 * r + 3]);
                f32x4 gg; gg.x = vals[4 * r] * inv; gg.y = vals[4 * r + 1] * inv; gg.z = vals[4 * r + 2] * inv; gg.w = vals[4 * r + 3] * inv;
                *(f32x4*)(glist + p * 16 + 4 * r) = gg;
            }
        }
    }
}

typedef float f32x2 __attribute__((ext_vector_type(2)));
template <int CTRL> __device__ __forceinline__ float dppf(float v) { return __builtin_bit_cast(float, __builtin_amdgcn_update_dpp(0, __builtin_bit_cast(int, v), CTRL, 0xf, 0xf, false)); }
__device__ __forceinline__ float wave_total(float v) {
    v += dppf<0xB1>(v); v += dppf<0x4E>(v); v += dppf<0x141>(v); v += dppf<0x140>(v);
    const int iv = __builtin_bit_cast(int, v);
    return (__builtin_bit_cast(float, __builtin_amdgcn_readlane(iv, 0)) + __builtin_bit_cast(float, __builtin_amdgcn_readlane(iv, 16)))
         + (__builtin_bit_cast(float, __builtin_amdgcn_readlane(iv, 32)) + __builtin_bit_cast(float, __builtin_amdgcn_readlane(iv, 48)));
}
__device__ __forceinline__ float gelu1(float v) {
    const float av = fabsf(v), t = __builtin_amdgcn_rcpf(av * 0.2316418882f + 1.0f);
    float q = t * 0.5307027145f + (-0.7265760135f); q = q * t + 0.7107068705f; q = q * t + (-0.142248368f); q = q * t + 0.127414796f; q = q * t;
    const float e = __builtin_amdgcn_exp2f((v * v) * (-0.72134752044f)), m = v * (q * e);
    return v < 0.f ? m : v - m;
}
__device__ __forceinline__ void ld16c(const float* p, float (&v)[16]) {
#pragma unroll
    for (int q = 0; q < 4; ++q) { const f32x4 t = ((const f32x4*)p)[q]; v[4 * q] = t.x; v[4 * q + 1] = t.y; v[4 * q + 2] = t.z; v[4 * q + 3] = t.w; }
}
constexpr int PW_X = 0, PW_XROW = 1088, PW_UT = 4352, PW_UROW = 272, PW_LIST = 8704, PW_BYTES = 12800;
__device__ __forceinline__ void peer_axpy(float (&f)[16], const v4u vr, float act) {
#pragma unroll
    for (int q = 0; q < 4; ++q) {
        const f32x2 lo = __builtin_amdgcn_cvt_pk_f32_fp8((int)vr[q], false), hi = __builtin_amdgcn_cvt_pk_f32_fp8((int)vr[q], true);
        f[4 * q] += act * lo.x; f[4 * q + 1] += act * lo.y; f[4 * q + 2] += act * hi.x; f[4 * q + 3] += act * hi.y;
    }
}
__device__ __forceinline__ void peer_pair(float (&f)[16], const v4u vr, const f32x4 a4, const v2u myent, int p) {
    const float gp = __builtin_bit_cast(float, __builtin_amdgcn_readlane((int)myent.y, p));
    const float av = (p & 3) == 0 ? a4.x : ((p & 3) == 1 ? a4.y : ((p & 3) == 2 ? a4.z : a4.w));
    const float act = __builtin_bit_cast(float, __builtin_amdgcn_readlane(__float_as_int(av), 16 * (p >> 2))) * gp;
    peer_axpy(f, vr, act);
    __builtin_amdgcn_sched_barrier(0);
}
__device__ __forceinline__ void peer_batch(float (&f)[16], const LAS unsigned char* wl, int t, int bt, const unsigned char* U8, const unsigned char* V8, int lane) {
    const int l15 = lane & 15, g = lane >> 4;
    const LAS unsigned char* ent = wl + PW_LIST + 1024 * t + 128 * bt;
    const v2u myent = *(const LAS v2u*)(ent + 8 * l15);
    v4u ur[4][4], vrA[4];
    {
        int er[4];
#pragma unroll
        for (int q = 0; q < 4; ++q) er[q] = (int)(*(const LAS unsigned*)(ent + 8 * (4 * q + g)));
#pragma unroll
        for (int c = 0; c < 4; ++c)
#pragma unroll
            for (int q = 0; q < 4; ++q) ur[c][q] = *(const v4u*)(U8 + (size_t)er[q] * 1024 + 256 * c + 16 * l15);
    }
#pragma unroll
    for (int p = 0; p < 4; ++p) { const int ep = __builtin_amdgcn_readlane((int)myent.x, p); vrA[p] = *(const v4u*)(V8 + (size_t)ep * 1024 + 16 * lane); }
    __builtin_amdgcn_sched_barrier(0);
    f32x4 acc = {0.f, 0.f, 0.f, 0.f};
#pragma unroll
    for (int c = 0; c < 4; ++c) {
#pragma unroll
        for (int q = 0; q < 4; ++q) *(LAS v4u*)(wl + PW_UT + (4 * q + g) * PW_UROW + 16 * l15) = ur[c][q];
        asm volatile("s_waitcnt lgkmcnt(0)" ::: "memory");
#pragma unroll
        for (int j = 0; j < 4; ++j) {
            const v4u a16 = *(const LAS v4u*)(wl + PW_UT + l15 * PW_UROW + 64 * j + 16 * g);
            const v4u x16 = *(const LAS v4u*)(wl + PW_X + t * PW_XROW + 256 * c + 64 * j + 16 * g);
            const long a0 = (long)(((unsigned long long)a16.y << 32) | a16.x), a1 = (long)(((unsigned long long)a16.w << 32) | a16.z);
            const long x0 = (long)(((unsigned long long)x16.y << 32) | x16.x), x1 = (long)(((unsigned long long)x16.w << 32) | x16.z);
            acc = __builtin_amdgcn_mfma_f32_16x16x32_fp8_fp8(a0, x0, acc, 0, 0, 0);
            acc = __builtin_amdgcn_mfma_f32_16x16x32_fp8_fp8(a1, x1, acc, 0, 0, 0);
        }
        asm volatile("s_waitcnt lgkmcnt(0)" ::: "memory");
    }
    __builtin_amdgcn_sched_barrier(0);
    f32x4 a4;
#pragma unroll
    for (int r = 0; r < 4; ++r) a4[r] = gelu1(acc[r] * (1.f / PEER_USCALE));
    v4u vrB[4], vrC[4], vrD[4];
#pragma unroll
    for (int p = 0; p < 4; ++p) { const int ep = __builtin_amdgcn_readlane((int)myent.x, 4 + p); vrB[p] = *(const v4u*)(V8 + (size_t)ep * 1024 + 16 * lane); }
#pragma unroll
    for (int p = 0; p < 4; ++p) { const int ep = __builtin_amdgcn_readlane((int)myent.x, 8 + p); vrC[p] = *(const v4u*)(V8 + (size_t)ep * 1024 + 16 * lane); }
    __builtin_amdgcn_sched_barrier(0);
#pragma unroll
    for (int p = 0; p < 4; ++p) peer_pair(f, vrA[p], a4, myent, p);
#pragma unroll
    for (int p = 0; p < 4; ++p) { const int ep = __builtin_amdgcn_readlane((int)myent.x, 12 + p); vrD[p] = *(const v4u*)(V8 + (size_t)ep * 1024 + 16 * lane); }
    __builtin_amdgcn_sched_barrier(0);
#pragma unroll
    for (int p = 0; p < 4; ++p) peer_pair(f, vrB[p], a4, myent, 4 + p);
#pragma unroll
    for (int p = 0; p < 4; ++p) peer_pair(f, vrC[p], a4, myent, 8 + p);
#pragma unroll
    for (int p = 0; p < 4; ++p) peer_pair(f, vrD[p], a4, myent, 12 + p);
}
__device__ __forceinline__ void p10_peer(const Args& a, LAS unsigned char* lds, int G, int lane, int wave) {
    unsigned char* ws = a.ws; const unsigned char* U8 = ws + WS_U; const unsigned char* V8 = ws + WS_V;
    const int* elist = (const int*)(ws + WS_ATT); const float* glist = (const float*)(ws + WS_ATT + 8 * MiB);
    const float* mod = (const float*)(ws + WS_MOD); float* out = a.out;
    const int NGW = G * NWAVES;
    LAS unsigned char* wl = lds + wave * PW_BYTES;
    for (int grp0 = blockIdx.x * NWAVES + wave; grp0 < T / 4; grp0 += NGW) {
        const int tok0 = grp0 * 4, b = tok0 >> 11;
        {
            float sc[16], sh[16]; ld16c(mod + b * 6144 + 4096 + 16 * lane, sc); ld16c(mod + b * 6144 + 3072 + 16 * lane, sh);
            int e0[4], e1[4]; float g0[4], g1[4];
#pragma unroll
            for (int t = 0; t < 4; ++t) {
                float xv[16]; ld16c(out + (size_t)(tok0 + t) * DM + 16 * lane, xv);
#pragma unroll
                for (int j = 0; j < 16; ++j) xv[j] = xv[j] * (1.f + sc[j]) + sh[j];
                v4u o;
#pragma unroll
                for (int q = 0; q < 4; ++q) { int w = 0; w = __builtin_amdgcn_cvt_pk_fp8_f32(xv[4 * q], xv[4 * q + 1], w, false); w = __builtin_amdgcn_cvt_pk_fp8_f32(xv[4 * q + 2], xv[4 * q + 3], w, true); o[q] = (unsigned)w; }
                *(LAS v4u*)(wl + PW_X + t * PW_XROW + 16 * lane) = o;
                e0[t] = elist[(size_t)(tok0 + t) * 128 + lane]; e1[t] = elist[(size_t)(tok0 + t) * 128 + 64 + lane];
                g0[t] = glist[(size_t)(tok0 + t) * 128 + lane]; g1[t] = glist[(size_t)(tok0 + t) * 128 + 64 + lane];
            }
            int base[4] = {0, 0, 0, 0};
#pragma unroll 1
            for (int s = 0; s < 16; ++s) {
#pragma unroll
                for (int t = 0; t < 4; ++t) {
                    const bool h0 = (e0[t] >> 10) == s, h1 = (e1[t] >> 10) == s;
                    const unsigned long long m0 = __ballot(h0), m1 = __ballot(h1);
                    const int c0 = __builtin_popcountll(m0), c1 = __builtin_popcountll(m1);
                    const int r0 = (int)__builtin_amdgcn_mbcnt_hi((unsigned)(m0 >> 32), __builtin_amdgcn_mbcnt_lo((unsigned)m0, 0u));
                    const int r1 = (int)__builtin_amdgcn_mbcnt_hi((unsigned)(m1 >> 32), __builtin_amdgcn_mbcnt_lo((unsigned)m1, 0u));
                    if (h0) { v2u w; w.x = (unsigned)e0[t]; w.y = __float_as_uint(g0[t]); *(LAS v2u*)(wl + PW_LIST + 1024 * t + 8 * (base[t] + r0)) = w; }
                    if (h1) { v2u w; w.x = (unsigned)e1[t]; w.y = __float_as_uint(g1[t]); *(LAS v2u*)(wl + PW_LIST + 1024 * t + 8 * (base[t] + c0 + r1)) = w; }
                    base[t] += c0 + c1;
                }
            }
            asm volatile("s_waitcnt lgkmcnt(0)" ::: "memory");
        }
        float f[4][16];
#pragma unroll
        for (int t = 0; t < 4; ++t)
#pragma unroll
            for (int jj = 0; jj < 16; ++jj) f[t][jj] = 0.f;
#pragma unroll 1
        for (int bt = 0; bt < 8; ++bt) {
#pragma unroll
            for (int t = 0; t < 4; ++t) peer_batch(f[t], wl, t, bt, U8, V8, lane);
        }
        float g2[16], lg[16], lb[16];
        { const float* lgp = a.in[15]; const float* lbp = a.in[16]; asm volatile("" : "+s"(lgp), "+s"(lbp));
          ld16c(mod + b * 6144 + 5120 + 16 * lane, g2); ld16c(lgp + 16 * lane, lg); ld16c(lbp + 16 * lane, lb); }
#pragma unroll
        for (int t = 0; t < 4; ++t) {
            float z[16]; ld16c(out + (size_t)(tok0 + t) * DM + 16 * lane, z);
            float sm = 0.f;
#pragma unroll
            for (int jj = 0; jj < 16; ++jj) { z[jj] = DN_ALPHA * z[jj] + (1.f + g2[jj]) * f[t][jj]; sm += z[jj]; }
            const float mu = wave_total(sm) * (1.f / DM); float q = 0.f;
#pragma unroll
            for (int jj = 0; jj < 16; ++jj) { z[jj] -= mu; q += z[jj] * z[jj]; }
            const float rs = rsqrtf(wave_total(q) * (1.f / DM) + LN_EPS);
#pragma unroll
            for (int q4 = 0; q4 < 4; ++q4) { f32x4 o; o.x = z[4 * q4] * rs * lg[4 * q4] + lb[4 * q4]; o.y = z[4 * q4 + 1] * rs * lg[4 * q4 + 1] + lb[4 * q4 + 1];
                o.z = z[4 * q4 + 2] * rs * lg[4 * q4 + 2] + lb[4 * q4 + 2]; o.w = z[4 * q4 + 3] * rs * lg[4 * q4 + 3] + lb[4 * q4 + 3];
                ((f32x4*)(out + (size_t)(tok0 + t) * DM + 16 * lane))[q4] = o; }
        }
    }
}

constexpr int N_PHASES = 11;
__global__ void __launch_bounds__(NTHR, 2) mega(Args args) {
    extern __shared__ __attribute__((aligned(16))) unsigned char lds_raw[];
    LAS unsigned char* lds = (LAS unsigned char*)lds_raw;
    const int tid = threadIdx.x, lane = tid & 63, wave = __builtin_amdgcn_readfirstlane(tid >> 6), G = gridDim.x;
    unsigned char* ws = args.ws;
    volatile LAS unsigned* MISC = (volatile LAS unsigned*)(lds + MISC_OFF);
    for (int u = tid; u < (LDS_BYTES - RING_BYTES) / 4; u += NTHR) ((LAS unsigned*)(lds + RING_BYTES))[u] = 0u;
    __syncthreads();
    const int lo = args.ph_lo, hi = args.ph_hi;
    unsigned* barw = (unsigned*)(ws + WS_CTL) + CW_BAR + args.bar_idx * XCD_BAR_WORDS;
    XcdBarrier bar; bar.bar = barw; bar.x = 0; bar.st = nullptr;
    if (hi - lo > 1) bar = xcd_barrier_post(barw, MISC + 8);
#define IN(k) (lo <= (k) && (k) < hi)
#define REPS(k) ((PROBE_PH == (k)) ? 1 + PROBE_N : 1)
#define REPBAR(k, rep) do { if ((rep) + 1 < REPS(k)) xcd_barrier(bar); } while (0)
#define SEAM(k) do { if (IN(k) && IN((k) + 1)) xcd_barrier(bar); } while (0)

    if (IN(0)) { for (int rep = 0; rep < REPS(0); ++rep) { p0_prologue(args, lds, G, tid, lane, wave); REPBAR(0, rep); } } SEAM(0);
    if (IN(1)) { for (int rep = 0; rep < REPS(1); ++rep) { p1_mod_h(args, lds, G, tid, lane, wave); REPBAR(1, rep); } } SEAM(1);
    if (IN(2)) { for (int rep = 0; rep < REPS(2); ++rep) {
        __syncthreads();
        pg8::Gemm g{(const pg8::bf16_t*)(ws + WS_H), (const pg8::bf16_t*)(ws + WS_WIN), T, NQKV, DM};
        pg8::StaticOrder S; S.init(T, NQKV, G, (int)blockIdx.x);
        pg8::EpiBf16<0> E{(pg8::bf16_t*)(ws + WS_QKV), NQKV, nullptr, 0, 0};
        pg8::gemm_phase<pg8::EpiBf16<0>, pg8::StaticOrder, false>(lds, g, S, E, nullptr);
        REPBAR(2, rep); }
    } SEAM(2);
    if (IN(3)) { p3_kmean(args, lds, G, tid); } SEAM(3);
    if (IN(4)) {
        if (PROBE_PH == 4) { p4_attn<PROBE_N>(args, lds, G, tid, lane, wave); xcd_barrier(bar); }
        p4_attn<0>(args, lds, G, tid, lane, wave); } SEAM(4);
    if (IN(5)) { for (int rep = 0; rep < REPS(5); ++rep) { p5_combine_rms(args, G, lane, wave); REPBAR(5, rep); } } SEAM(5);
    if (IN(6)) { for (int rep = 0; rep < REPS(6); ++rep) {
        __syncthreads();
        pg8::Gemm g{(const pg8::bf16_t*)args.out, (const pg8::bf16_t*)(ws + WS_WOUT), T, DM, DM};
        pg8::StaticOrder S; S.init(T, DM, G, (int)blockIdx.x);
        pg8::EpiF32 E{(float*)(ws + WS_QKV), DM, nullptr};
        pg8::gemm_phase<pg8::EpiF32, pg8::StaticOrder, false>(lds, g, S, E, nullptr);
        REPBAR(6, rep); }
    } SEAM(6);
    if (IN(7)) { for (int rep = 0; rep < REPS(7); ++rep) { p7_ln1(args, G, lane, wave); REPBAR(7, rep); } } SEAM(7);
    if (IN(8)) { for (int rep = 0; rep < REPS(8); ++rep) {
        __syncthreads();
        pg8::Gemm g{(const pg8::bf16_t*)(ws + WS_H), (const pg8::bf16_t*)(ws + WS_WQ), T, DM, DM};
        pg8::StaticOrder S; S.init(T, DM, G, (int)blockIdx.x);
        pg8::EpiF32 E{(float*)(ws + WS_QKV), DM, nullptr};
        pg8::gemm_phase<pg8::EpiF32, pg8::StaticOrder, false>(lds, g, S, E, nullptr);
        REPBAR(8, rep); }
    } SEAM(8);
    if (IN(9)) { for (int rep = 0; rep < REPS(9); ++rep) { __syncthreads(); p9_topk(args, lds, G, tid); REPBAR(9, rep); } } SEAM(9);
    if (IN(10)) { __syncthreads(); p10_peer(args, lds, G, lane, wave); }
#undef IN
#undef SEAM
}
}

#ifndef MK_N_LAUNCHES
#define MK_N_LAUNCHES 1
#endif

extern "C" void kernel_launch(void* const* d_in, const int* in_sizes, int n_in, void* d_out, int out_size, void* d_ws, size_t ws_size, hipStream_t stream) {
    static int grid = 0;
    if (!grid) {
        int dev = 0, cus = 0, per_cu = 0;
        if (hipGetDevice(&dev) != hipSuccess || hipDeviceGetAttribute(&cus, hipDeviceAttributeMultiprocessorCount, dev) != hipSuccess) { fprintf(stderr, "kernel_launch: device query failed\n"); return; }
        if (hipFuncSetAttribute((const void*)mk::mega, hipFuncAttributeMaxDynamicSharedMemorySize, mk::LDS_BYTES) != hipSuccess) { fprintf(stderr, "kernel_launch: hipFuncSetAttribute failed\n"); return; }
        if (hipOccupancyMaxActiveBlocksPerMultiprocessor(&per_cu, (const void*)mk::mega, mk::NTHR, mk::LDS_BYTES) != hipSuccess || per_cu < 1) { fprintf(stderr, "kernel_launch: occupancy query says %d\n", per_cu); return; }
        grid = cus;
    }
    if (n_in != 17 || ws_size < mk::WS_END) { fprintf(stderr, "kernel_launch: unexpected n_in %d / ws %zu\n", n_in, ws_size); return; }
    (void)hipMemsetAsync((char*)d_ws + mk::WS_CTL, 0, mk::CTL_ZERO_BYTES, stream);
    mk::Args a{};
    for (int i = 0; i < 17; ++i) a.in[i] = (const float*)d_in[i];
    a.out = (float*)d_out; a.ws = (unsigned char*)d_ws;
    a.ph_lo = 0; a.ph_hi = mk::N_PHASES;
    hipLaunchKernelGGL(mk::mega, dim3(grid), dim3(mk::NTHR), mk::LDS_BYTES, stream, a);
}
```

```cpp
#include <hip/hip_runtime.h>
#include <stdint.h>
#include <math.h>
#include <stdio.h>
namespace pg8 {
#define PG8_LAS __attribute__((address_space(3)))
typedef unsigned short bf16_t;
typedef short bf16x8 __attribute__((ext_vector_type(8)));
typedef float f32x4 __attribute__((ext_vector_type(4)));
typedef unsigned u32x4 __attribute__((ext_vector_type(4)));
constexpr int BM = 256, BK = 64, HALF = 128, HTB = HALF * BK * 2  , STAGE_BYTES = 8 * HTB, NXCD = 8, WGM = 8;

__host__ __device__ __forceinline__ int lds_byte(int r, int c) { const int st = (r >> 4) * 2 + (c >> 5), rr = r & 15, cc = c & 31, ob = rr * 64 + cc * 2; return st * 1024 + (ob ^ (((ob >> 9) & 1) << 5)); }
__host__ __device__ __forceinline__ void stage_rc(int b, int& R, int& C) { const int st = b / 1024, sb = b % 1024, swz = sb ^ (((sb >> 9) & 1) << 5); R = (st >> 1) * 16 + swz / 64; C = (st & 1) * 32 + (swz % 64) / 2; }
__host__ __device__ __forceinline__ int perm32(int rho) { const int n = rho >> 4, i = rho & 15; return 8 * (i >> 2) + 4 * n + (i & 3); }

struct Unit { int pm, pn; };
struct Gemm { const bf16_t* A; const bf16_t* Bt; int M, N, K; };

struct StaticOrder {
    int nM, nN, nwg, G, c;
    __host__ __device__ void init(int M, int N, int G_, int c_) { nM = M / BM; nN = N / BM; nwg = nM * nN; G = G_; c = c_; }
    __host__ __device__ bool next(int i, Unit& u) const {
        const long L = (long)i * G + c; if (L >= nwg) return false;
        int wgid = (int)L; { const int q = nwg / NXCD, r = nwg % NXCD, xcd = wgid % NXCD, off = wgid / NXCD; wgid = (xcd < r ? xcd * (q + 1) : r * (q + 1) + (xcd - r) * q) + off; }
        const int nig = WGM * nN, gid = wgid / nig, fm = gid * WGM, gsz = (nM - fm) < WGM ? (nM - fm) : WGM;
        u.pm = fm + ((wgid % nig) % gsz); u.pn = (wgid % nig) / gsz; return true;
    }
    __device__ __forceinline__ void a_ready(const Unit&) const {}
    __device__ __forceinline__ void done(const Unit&) const {}
};
struct CountedOrder : StaticOrder {
    const unsigned* ready; unsigned need; unsigned* tmo;
    __device__ __forceinline__ void a_ready(const Unit& u) const {
        if (threadIdx.x < 64) {
            const unsigned long long t0 = __builtin_amdgcn_s_memrealtime(); unsigned polls = 0;
            while ((unsigned)__builtin_amdgcn_readfirstlane(__hip_atomic_load(ready + 64 * u.pm, __ATOMIC_RELAXED, __HIP_MEMORY_SCOPE_AGENT)) < need) {
                if ((++polls & 255u) == 0u && __builtin_amdgcn_readfirstlane(__hip_atomic_load(tmo, __ATOMIC_RELAXED, __HIP_MEMORY_SCOPE_AGENT)) != 0u) break;
                if (__builtin_amdgcn_s_memrealtime() - t0 > 2000000ull) {
                    if (threadIdx.x == 0) { unsigned expect = 0u; __hip_atomic_compare_exchange_strong(tmo + 1, &expect, 0x600u | (unsigned)(u.pm & 0xff), __ATOMIC_RELAXED, __ATOMIC_RELAXED, __HIP_MEMORY_SCOPE_AGENT); __hip_atomic_store(tmo, 1u, __ATOMIC_RELAXED, __HIP_MEMORY_SCOPE_AGENT); }
                    break; }
                __builtin_amdgcn_s_sleep(2); }
            __builtin_amdgcn_fence(__ATOMIC_ACQUIRE, "agent");
            asm volatile("s_waitcnt vmcnt(0)" ::: "memory");
        }
#if !defined(BROKEN_HOOK_NO_BARRIER)
        asm volatile("" ::: "memory"); __builtin_amdgcn_s_barrier(); asm volatile("" ::: "memory");
#endif
    }
};

__device__ __forceinline__ unsigned cvt_pk_bf16(float lo, float hi) { unsigned r; asm volatile("v_cvt_pk_bf16_f32 %0, %1, %2" : "=v"(r) : "v"(lo), "v"(hi)); return r; }
typedef float f32x2 __attribute__((ext_vector_type(2)));
__device__ __forceinline__ f32x2 gelu_pk(f32x2 v) {
    const f32x2 av = __builtin_elementwise_abs(v), d = av * 0.2316418882f + 1.0f;
    f32x2 t; t.x = __builtin_amdgcn_rcpf(d.x); t.y = __builtin_amdgcn_rcpf(d.y);
    f32x2 q = t * 0.5307027145f + (-0.7265760135f); q = q * t + 0.7107068705f; q = q * t + (-0.142248368f); q = q * t + 0.127414796f; q = q * t;
    const f32x2 s = (v * v) * (-0.72134752044f);
    f32x2 e; e.x = __builtin_amdgcn_exp2f(s.x); e.y = __builtin_amdgcn_exp2f(s.y);
    const f32x2 m = v * (q * e), r = v - m;
    f32x2 o; o.x = v.x < 0.f ? m.x : r.x; o.y = v.y < 0.f ? m.y : r.y; return o;
}

struct EpiF32 {
    static constexpr bool PERM = false, AFTER_DRAIN = false;
    float* C; int ldc; const float* bias;
    __device__ __forceinline__ void operator()(const f32x4 (&acc)[2][2][4][2], const Unit& u, int wr, int wc, int fr, int fq) const {
        const int row0 = u.pm * BM + wr * 64 + fr, col0 = u.pn * BM + wc * 32 + 4 * fq;
        f32x4 bv[2][2];
#pragma unroll
        for (int bj = 0; bj < 2; ++bj)
#pragma unroll
            for (int n = 0; n < 2; ++n) bv[bj][n] = bias ? *(const f32x4*)(bias + col0 + bj * HALF + n * 16) : (f32x4){0.f, 0.f, 0.f, 0.f};
#pragma unroll
        for (int ai = 0; ai < 2; ++ai)
#pragma unroll
            for (int m = 0; m < 4; ++m) { float* rowp = C + (size_t)(row0 + ai * HALF + m * 16) * ldc + col0;
#pragma unroll
                for (int bj = 0; bj < 2; ++bj)
#pragma unroll
                    for (int n = 0; n < 2; ++n) *(f32x4*)(rowp + bj * HALF + n * 16) = acc[ai][bj][m][n] + bv[bj][n]; }
    }
};
template <int ACT  > struct EpiBf16 {
    static constexpr bool PERM = true, AFTER_DRAIN = false;
    bf16_t* O; int ldc; const float* bias; int split_cols; size_t split_stride;
    __device__ __forceinline__ void operator()(const f32x4 (&acc)[2][2][4][2], const Unit& u, int wr, int wc, int fr, int fq) const {
        const int row0 = u.pm * BM + wr * 64 + fr; int colt = u.pn * BM; bf16_t* base = O;
        if (split_cols) { const int t = colt / split_cols; base += (size_t)t * split_stride; colt -= t * split_cols; }
        const int col0 = colt + wc * 32 + 8 * fq, bcol0 = u.pn * BM + wc * 32 + 8 * fq;
        f32x4 bv[2][2];
#pragma unroll
        for (int bj = 0; bj < 2; ++bj)
#pragma unroll
            for (int n = 0; n < 2; ++n) bv[bj][n] = bias ? *(const f32x4*)(bias + bcol0 + bj * HALF + 4 * n) : (f32x4){0.f, 0.f, 0.f, 0.f};
#pragma unroll
        for (int ai = 0; ai < 2; ++ai)
#pragma unroll
            for (int m = 0; m < 4; ++m) { bf16_t* rowp = base + (size_t)(row0 + ai * HALF + m * 16) * ldc + col0;
#pragma unroll
                for (int bj = 0; bj < 2; ++bj) { f32x4 v0 = acc[ai][bj][m][0] + bv[bj][0], v1 = acc[ai][bj][m][1] + bv[bj][1];
                    if (ACT == 1) { f32x2 a = gelu_pk((f32x2){v0[0], v0[1]}), b = gelu_pk((f32x2){v0[2], v0[3]}), c = gelu_pk((f32x2){v1[0], v1[1]}), d = gelu_pk((f32x2){v1[2], v1[3]});
                        v0 = (f32x4){a.x, a.y, b.x, b.y}; v1 = (f32x4){c.x, c.y, d.x, d.y}; }
                    if (ACT == 2) {
#pragma unroll
                        for (int j = 0; j < 4; ++j) { v0[j] = 0.5f * v0[j] * (1.0f + erff(v0[j] * 0.70710678f)); v1[j] = 0.5f * v1[j] * (1.0f + erff(v1[j] * 0.70710678f)); } }
                    u32x4 w; w.x = cvt_pk_bf16(v0[0], v0[1]); w.y = cvt_pk_bf16(v0[2], v0[3]); w.z = cvt_pk_bf16(v1[0], v1[1]); w.w = cvt_pk_bf16(v1[2], v1[3]);
                    *(u32x4*)(rowp + bj * HALF) = w; } }
    }
};

struct PanelStats {
    unsigned* xbuf;
    unsigned* cnt;
    unsigned* tmo;
    int ntn; float eps;
    unsigned code;
    __device__ __forceinline__ bool run(const f32x4 (&v)[2][2][4][2], const Unit& u, int wr, int wc, int fr, int fq, PG8_LAS unsigned char* lds, int wid, int lane) const {
        typedef float f32x2v __attribute__((ext_vector_type(2)));
        PG8_LAS f32x2v* P = (PG8_LAS f32x2v*)lds;
        PG8_LAS f32x2v* S = (PG8_LAS f32x2v*)(lds + 8192);
        PG8_LAS unsigned* flag = (PG8_LAS unsigned*)(lds + 8192 + 2048);
#pragma unroll
        for (int ai = 0; ai < 2; ++ai)
#pragma unroll
            for (int m = 0; m < 4; ++m) {
                float s = 0.f;
#pragma unroll
                for (int bj = 0; bj < 2; ++bj)
#pragma unroll
                    for (int n = 0; n < 2; ++n) { const f32x4 x = v[ai][bj][m][n]; s += (x[0] + x[1]) + (x[2] + x[3]); }
                s += __shfl_xor(s, 16); s += __shfl_xor(s, 32);
                const float mw = s * (1.0f / 64.0f); float q = 0.f;
#pragma unroll
                for (int bj = 0; bj < 2; ++bj)
#pragma unroll
                    for (int n = 0; n < 2; ++n) { const f32x4 d = v[ai][bj][m][n] - mw; q += (d[0] * d[0] + d[1] * d[1]) + (d[2] * d[2] + d[3] * d[3]); }
                q += __shfl_xor(q, 16); q += __shfl_xor(q, 32);
                if (fq == 0) P[(ai * HALF + wr * 64 + m * 16 + fr) * 4 + wc] = (f32x2v){mw, q};
            }
        asm volatile("s_waitcnt lgkmcnt(0)" ::: "memory"); __builtin_amdgcn_s_barrier(); asm volatile("" ::: "memory");
#if defined(BROKEN_NO_WAIT)
        if (blockIdx.x >= 64) { const long long t0 = clock64(); while (clock64() - t0 < 60000) __builtin_amdgcn_s_sleep(8); }
#endif
        const int row = wid * 32 + (lane & 31);
        if (lane < 32) {
            const f32x2v a = P[row * 4 + 0], b = P[row * 4 + 1], c = P[row * 4 + 2], d = P[row * 4 + 3];
            const float mt = (a.x + b.x + c.x + d.x) * 0.25f;
            const float da = a.x - mt, db = b.x - mt, dc = c.x - mt, dd = d.x - mt;
            const float m2 = (a.y + b.y) + (c.y + d.y) + 64.0f * ((da * da + db * db) + (dc * dc + dd * dd));
            unsigned long long* slot = (unsigned long long*)xbuf + ((size_t)(u.pm * BM + row) * 4 + u.pn);
            __hip_atomic_store(slot, ((unsigned long long)__float_as_uint(m2) << 32) | __float_as_uint(mt), __ATOMIC_RELAXED, __HIP_MEMORY_SCOPE_AGENT);
        }
        asm volatile("s_waitcnt vmcnt(0)" ::: "memory");
        if (lane == 0) __hip_atomic_fetch_add(cnt + 64 * u.pm, 1u, __ATOMIC_RELAXED, __HIP_MEMORY_SCOPE_AGENT);
        if (wid == 0) {
            bool dead = false; const unsigned long long t0 = __builtin_amdgcn_s_memrealtime(); const unsigned want = 8u * (unsigned)ntn;
            for (;;) {
#if defined(BROKEN_NO_WAIT)
                break;
#endif
                if ((unsigned)__builtin_amdgcn_readfirstlane(__hip_atomic_load(cnt + 64 * u.pm, __ATOMIC_RELAXED, __HIP_MEMORY_SCOPE_AGENT)) >= want) break;
                if (__builtin_amdgcn_s_memrealtime() - t0 > 2000000ull) {
                    if (lane == 0) { unsigned expect = 0u; __hip_atomic_compare_exchange_strong(tmo + 1, &expect, code | (unsigned)(u.pm & 0xff), __ATOMIC_RELAXED, __ATOMIC_RELAXED, __HIP_MEMORY_SCOPE_AGENT);
                                     __hip_atomic_store(tmo, 1u, __ATOMIC_RELAXED, __HIP_MEMORY_SCOPE_AGENT); }
                    dead = true; break; }
                __builtin_amdgcn_s_sleep(2);
            }
            __builtin_amdgcn_fence(__ATOMIC_ACQUIRE, "agent");
            if (lane == 0) flag[0] = dead ? 1u : 0u;
        }
        asm volatile("s_waitcnt vmcnt(0) lgkmcnt(0)" ::: "memory"); __builtin_amdgcn_s_barrier(); asm volatile("" ::: "memory");
        const bool bad = flag[0] != 0u;
        if (lane < 32) {
            const unsigned long long* slot = (const unsigned long long*)xbuf + (size_t)(u.pm * BM + row) * 4; float mt[4], m2[4]; float ms = 0.f;
#pragma unroll
            for (int t = 0; t < 4; ++t) { if (t < ntn) { const unsigned long long w = __hip_atomic_load(slot + t, __ATOMIC_RELAXED, __HIP_MEMORY_SCOPE_AGENT); mt[t] = __uint_as_float((unsigned)w); m2[t] = __uint_as_float((unsigned)(w >> 32)); } else { mt[t] = 0.f; m2[t] = 0.f; } ms += mt[t]; }
            const float mean = ms / (float)ntn; float q = 0.f;
#pragma unroll
            for (int t = 0; t < 4; ++t) if (t < ntn) { const float dm = mt[t] - mean; q += m2[t] + 256.0f * dm * dm; }
            S[row] = (f32x2v){mean, 1.0f / sqrtf(q / (256.0f * (float)ntn) + eps)};
        }
        asm volatile("s_waitcnt lgkmcnt(0)" ::: "memory"); __builtin_amdgcn_s_barrier(); asm volatile("" ::: "memory");
        return bad;
    }
};
struct EpiLnRes {
    static constexpr bool PERM = false, AFTER_DRAIN = true;
    const float* base; float* out; int ldc; const float* bias; PanelStats st; unsigned poison;
    __device__ __forceinline__ void refuse(size_t i0, size_t stride, int M, int N) const { const float q = __builtin_nanf(""); for (size_t i = i0; i < (size_t)M * N; i += stride) out[(i / N) * ldc + i % N] = q;
        if (i0 == 0) { unsigned expect = 0u; __hip_atomic_compare_exchange_strong(st.tmo + 1, &expect, 0x7f0u, __ATOMIC_RELAXED, __ATOMIC_RELAXED, __HIP_MEMORY_SCOPE_AGENT); __hip_atomic_store(st.tmo, 1u, __ATOMIC_RELAXED, __HIP_MEMORY_SCOPE_AGENT); } }
    __device__ __forceinline__ void fused(f32x4 (&acc)[2][2][4][2], const Unit& u, int wr, int wc, int fr, int fq, PG8_LAS unsigned char* lds, int wid, int lane) const {
        typedef float f32x2v __attribute__((ext_vector_type(2)));
        const PG8_LAS f32x2v* S = (const PG8_LAS f32x2v*)(lds + 8192);
        const int col0 = u.pn * BM + wc * 32 + 4 * fq;
#pragma unroll
        for (int bj = 0; bj < 2; ++bj)
#pragma unroll
            for (int n = 0; n < 2; ++n) { const f32x4 bv = bias ? *(const f32x4*)(bias + col0 + bj * HALF + n * 16) : (f32x4){0.f, 0.f, 0.f, 0.f};
#pragma unroll
                for (int ai = 0; ai < 2; ++ai)
#pragma unroll
                    for (int m = 0; m < 4; ++m) acc[ai][bj][m][n] += bv; }
        const bool bad = st.run(acc, u, wr, wc, fr, fq, lds, wid, lane) || poison != 0u;
        const float qnan = __builtin_nanf("");
#pragma unroll
        for (int ai = 0; ai < 2; ++ai)
#pragma unroll
            for (int m = 0; m < 4; ++m) { const int r = ai * HALF + wr * 64 + m * 16 + fr; const f32x2v sr = S[r]; const size_t off = (size_t)(u.pm * BM + r) * ldc + col0;
#pragma unroll
                for (int bj = 0; bj < 2; ++bj)
#pragma unroll
                    for (int n = 0; n < 2; ++n) { const f32x4 bs = *(const f32x4*)(base + off + bj * HALF + n * 16); f32x4 o = bs + (acc[ai][bj][m][n] - sr.x) * sr.y;
                        if (bad) o = (f32x4){qnan, qnan, qnan, qnan}; *(f32x4*)(out + off + bj * HALF + n * 16) = o; }
                asm volatile("" ::: "memory"); }
    }
};
struct EpiLnResLn {
    static constexpr bool PERM = false, AFTER_DRAIN = true;
    const float* base; float* out; bf16_t* xn; int ldc; const float* bias; PanelStats st1, st2; unsigned poison;
    __device__ __forceinline__ void refuse(size_t i0, size_t stride, int M, int N) const { const float q = __builtin_nanf(""); for (size_t i = i0; i < (size_t)M * N; i += stride) { const size_t o = (i / N) * ldc + i % N; out[o] = q; xn[o] = (bf16_t)0x7fc0u; }
        if (i0 == 0) { unsigned expect = 0u; __hip_atomic_compare_exchange_strong(st1.tmo + 1, &expect, 0x7f0u, __ATOMIC_RELAXED, __ATOMIC_RELAXED, __HIP_MEMORY_SCOPE_AGENT); __hip_atomic_store(st1.tmo, 1u, __ATOMIC_RELAXED, __HIP_MEMORY_SCOPE_AGENT); } }
    __device__ __forceinline__ void fused(f32x4 (&acc)[2][2][4][2], const Unit& u, int wr, int wc, int fr, int fq, PG8_LAS unsigned char* lds, int wid, int lane) const {
        typedef float f32x2v __attribute__((ext_vector_type(2))); typedef unsigned u32x2v __attribute__((ext_vector_type(2)));
        const PG8_LAS f32x2v* S = (const PG8_LAS f32x2v*)(lds + 8192);
        const int col0 = u.pn * BM + wc * 32 + 4 * fq;
#pragma unroll
        for (int bj = 0; bj < 2; ++bj)
#pragma unroll
            for (int n = 0; n < 2; ++n) { const f32x4 bv = bias ? *(const f32x4*)(bias + col0 + bj * HALF + n * 16) : (f32x4){0.f, 0.f, 0.f, 0.f};
#pragma unroll
                for (int ai = 0; ai < 2; ++ai)
#pragma unroll
                    for (int m = 0; m < 4; ++m) acc[ai][bj][m][n] += bv; }
        bool bad = st1.run(acc, u, wr, wc, fr, fq, lds, wid, lane) || poison != 0u;
        const float qnan = __builtin_nanf("");
#pragma unroll
        for (int ai = 0; ai < 2; ++ai)
#pragma unroll
            for (int m = 0; m < 4; ++m) { const int r = ai * HALF + wr * 64 + m * 16 + fr; const f32x2v sr = S[r]; const size_t off = (size_t)(u.pm * BM + r) * ldc + col0;
#pragma unroll
                for (int bj = 0; bj < 2; ++bj)
#pragma unroll
                    for (int n = 0; n < 2; ++n) { const f32x4 bs = *(const f32x4*)(base + off + bj * HALF + n * 16); acc[ai][bj][m][n] = bs + (acc[ai][bj][m][n] - sr.x) * sr.y; }
                asm volatile("" : "+v"(acc[ai][0][m][0]), "+v"(acc[ai][0][m][1]), "+v"(acc[ai][1][m][0]), "+v"(acc[ai][1][m][1]));
                if (m & 1) asm volatile("" ::: "memory"); }
        const bool bad1 = bad;
        bad = st2.run(acc, u, wr, wc, fr, fq, lds, wid, lane) || bad;
#pragma unroll
        for (int ai = 0; ai < 2; ++ai)
#pragma unroll
            for (int m = 0; m < 4; ++m) { const int r = ai * HALF + wr * 64 + m * 16 + fr; const f32x2v sr = S[r]; const size_t off = (size_t)(u.pm * BM + r) * ldc + col0;
#pragma unroll
                for (int bj = 0; bj < 2; ++bj)
#pragma unroll
                    for (int n = 0; n < 2; ++n) { const f32x4 x1 = acc[ai][bj][m][n]; *(f32x4*)(out + off + bj * HALF + n * 16) = bad1 ? (f32x4){qnan, qnan, qnan, qnan} : x1;
                        const f32x4 o = (x1 - sr.x) * sr.y; u32x2v w; w.x = cvt_pk_bf16(o[0], o[1]); w.y = cvt_pk_bf16(o[2], o[3]);
                        if (bad) { w.x = 0x7fc07fc0u; w.y = 0x7fc07fc0u; } *(u32x2v*)(xn + off + bj * HALF + n * 16) = w; }
                asm volatile("" ::: "memory"); }
    }
};

template <class Epi, class Sched, bool STAMP = false>
__device__ __forceinline__ void gemm_phase(PG8_LAS unsigned char* lds, const Gemm g, const Sched& S, const Epi& E, unsigned long long* stamps) {
    const int tid = threadIdx.x, wid = __builtin_amdgcn_readfirstlane(tid >> 6), lane = tid & 63, wr = wid >> 2, wc = wid & 3, fr = lane & 15, fq = lane >> 4;
    const int K = g.K, nt = K / BK;
    int ts_lo = 0, ts_hi = 0, nts = 0; const unsigned long long rt_entry = STAMP ? (unsigned long long)wall_clock64() : 0ull;
#define PG8_STAMP() do { if (STAMP && wid == 0 && nts < 64) { const unsigned long long _c = (unsigned long long)clock64(); \
        ts_lo = (lane == nts) ? (int)(unsigned)_c : ts_lo; ts_hi = (lane == nts) ? (int)(unsigned)(_c >> 32) : ts_hi; ++nts; } } while (0)
    PG8_STAMP();
    unsigned voffA[2], voffB[2];
#pragma unroll
    for (int i = 0; i < 2; ++i) { int R, C; stage_rc(tid * 16 + i * 8192, R, C); const int Rb = Epi::PERM ? ((R & ~31) + perm32(R & 31)) : R;
        voffA[i] = (unsigned)(R * K + C) * 2u; voffB[i] = (unsigned)(Rb * K + C) * 2u; }
    const size_t kstep = (size_t)(BK * 2);
    const size_t hstep = (size_t)HALF * K * 2;
    const size_t tstep = 2 * hstep;
    const unsigned ldsw = (unsigned)wid * 1024u;
    const int aoff = lds_byte(wr * 64 + fr, fq * 8), boff = lds_byte(wc * 32 + fr, fq * 8);
#define PG8_SA(b, h) (((b) * 2 + (h)) * HTB)
#define PG8_SB(b, h) ((4 + (b) * 2 + (h)) * HTB)
#define PG8_STAGE(bufoff, gbase, voff) do { _Pragma("unroll") for (int _i = 0; _i < 2; ++_i) \
        __builtin_amdgcn_global_load_lds((const unsigned*)((const char*)(gbase) + (voff)[_i]), (PG8_LAS unsigned*)(lds + (bufoff) + ldsw + _i * 8192), 16, 0, 0); } while (0)
#define PG8_LDA(dst, b, h) do { _Pragma("unroll") for (int m = 0; m < 4; ++m) _Pragma("unroll") for (int k = 0; k < 2; ++k) dst[m][k] = *(const PG8_LAS bf16x8*)(lds + PG8_SA(b, h) + aoff + m * 2048 + k * 1024); } while (0)
#define PG8_LDB(dst, b, h) do { _Pragma("unroll") for (int n = 0; n < 2; ++n) _Pragma("unroll") for (int k = 0; k < 2; ++k) dst[n][k] = *(const PG8_LAS bf16x8*)(lds + PG8_SB(b, h) + boff + n * 2048 + k * 1024); } while (0)
#define PG8_MMA(ai, bj, At, Bt) do { __builtin_amdgcn_s_setprio(1); _Pragma("unroll") for (int m = 0; m < 4; ++m) _Pragma("unroll") for (int n = 0; n < 2; ++n) _Pragma("unroll") for (int k = 0; k < 2; ++k) \
        acc[ai][bj][m][n] = __builtin_amdgcn_mfma_f32_16x16x32_bf16(Bt[n][k], At[m][k], acc[ai][bj][m][n], 0, 0, 0); __builtin_amdgcn_s_setprio(0); } while (0)
#define PG8_WAIT_V(n) asm volatile("s_waitcnt vmcnt(" #n ")" ::: "memory")
#define PG8_WAIT_L(n) asm volatile("s_waitcnt lgkmcnt(" #n ")" ::: "memory")
#define PG8_BAR __builtin_amdgcn_s_barrier()
#define PG8_SCHED __builtin_amdgcn_sched_barrier(0)
    Unit cur, nxt; int ui = 0;
    if (!S.next(0, cur)) return;
    f32x4 acc[2][2][4][2];
#pragma unroll
    for (int a = 0; a < 2; ++a)
#pragma unroll
        for (int b = 0; b < 2; ++b)
#pragma unroll
            for (int m = 0; m < 4; ++m)
#pragma unroll
                for (int n = 0; n < 2; ++n) acc[a][b][m][n] = (f32x4){0.f, 0.f, 0.f, 0.f};
    bf16x8 At[4][2], B0[2][2], B1[2][2];
    const char* cA = (const char*)g.A + (size_t)cur.pm * tstep; const char* cB = (const char*)g.Bt + (size_t)cur.pn * tstep;
    S.a_ready(cur);
    PG8_STAGE(PG8_SB(0, 0), cB, voffB); PG8_STAGE(PG8_SA(0, 0), cA, voffA); PG8_STAGE(PG8_SB(0, 1), cB + hstep, voffB); PG8_STAGE(PG8_SA(0, 1), cA + hstep, voffA);
    if (wr == 1) PG8_BAR;
    PG8_WAIT_V(4); PG8_BAR;
    PG8_STAGE(PG8_SB(1, 0), cB + kstep, voffB); PG8_STAGE(PG8_SA(1, 0), cA + kstep, voffA); PG8_STAGE(PG8_SB(1, 1), cB + hstep + kstep, voffB);
    PG8_WAIT_V(6); PG8_BAR;
    PG8_STAMP();
    for (;;) {
        const bool has_next = S.next(ui + 1, nxt);
        const char* nA = has_next ? (const char*)g.A + (size_t)nxt.pm * tstep : cA; const char* nB = has_next ? (const char*)g.Bt + (size_t)nxt.pn * tstep : cB;
        for (int t = 0; t < nt; t += 2) {
            const bool last = (t == nt - 2);
            const char* a1 = cA + (size_t)(t + 1) * kstep;
            const char* a2 = last ? nA : cA + (size_t)(t + 2) * kstep; const char* b2 = last ? nB : cB + (size_t)(t + 2) * kstep;
            const char* a3 = a2 + kstep; const char* b3 = b2 + kstep;
            if (last && has_next) S.a_ready(nxt);
            PG8_LDB(B0, 0, 0); PG8_SCHED; PG8_LDA(At, 0, 0); PG8_STAGE(PG8_SA(1, 1), a1 + hstep, voffA);
            PG8_WAIT_L(8); PG8_BAR; PG8_WAIT_L(0); PG8_MMA(0, 0, At, B0); PG8_BAR; PG8_SCHED;
            PG8_LDB(B1, 0, 1); PG8_STAGE(PG8_SB(0, 0), b2, voffB);
            PG8_BAR; PG8_WAIT_L(0); PG8_MMA(0, 1, At, B1); PG8_BAR;
            PG8_LDA(At, 0, 1); PG8_STAGE(PG8_SA(0, 0), a2, voffA);
            PG8_BAR; PG8_WAIT_L(0); PG8_MMA(1, 0, At, B0); PG8_BAR; PG8_SCHED;
            PG8_STAGE(PG8_SB(0, 1), b2 + hstep, voffB);
            PG8_WAIT_V(6); PG8_BAR; PG8_MMA(1, 1, At, B1); PG8_BAR;
            PG8_LDB(B0, 1, 0); PG8_SCHED; PG8_LDA(At, 1, 0); PG8_STAGE(PG8_SA(0, 1), a2 + hstep, voffA);
            PG8_WAIT_L(8); PG8_BAR; PG8_WAIT_L(0); PG8_MMA(0, 0, At, B0); PG8_BAR; PG8_SCHED;
            PG8_LDB(B1, 1, 1); PG8_STAGE(PG8_SB(1, 0), b3, voffB);
            PG8_BAR; PG8_WAIT_L(0); PG8_MMA(0, 1, At, B1); PG8_BAR;
            PG8_LDA(At, 1, 1); PG8_STAGE(PG8_SA(1, 0), a3, voffA);
            PG8_BAR; PG8_WAIT_L(0); PG8_MMA(1, 0, At, B0); PG8_BAR; PG8_SCHED;
            PG8_STAGE(PG8_SB(1, 1), b3 + hstep, voffB);
            PG8_WAIT_V(6); PG8_BAR; PG8_MMA(1, 1, At, B1); PG8_BAR;
        }
        PG8_STAMP();
        if constexpr (!Epi::AFTER_DRAIN) { E(acc, cur, wr, wc, fr, fq); S.done(cur); }
        PG8_STAMP();
        if (!has_next) break;
#pragma unroll
        for (int a = 0; a < 2; ++a)
#pragma unroll
            for (int b = 0; b < 2; ++b)
#pragma unroll
                for (int m = 0; m < 4; ++m)
#pragma unroll
                    for (int n = 0; n < 2; ++n) acc[a][b][m][n] = (f32x4){0.f, 0.f, 0.f, 0.f};
        cur = nxt; cA = nA; cB = nB; ++ui;
    }
    PG8_WAIT_V(0);
    if (wr == 0) PG8_BAR;
    PG8_BAR;
    if constexpr (Epi::AFTER_DRAIN) { E.fused(acc, cur, wr, wc, fr, fq, lds, wid, lane); S.done(cur); }
    PG8_STAMP();
    if (STAMP && wid == 0) { stamps[lane] = lane < nts ? (((unsigned long long)(unsigned)ts_hi << 32) | (unsigned)ts_lo) : 0ull;
        if (lane == 62) stamps[62] = rt_entry; if (lane == 63) stamps[63] = (unsigned long long)wall_clock64(); }
#undef PG8_STAMP
#undef PG8_SA
#undef PG8_SB
#undef PG8_STAGE
#undef PG8_LDA
#undef PG8_LDB
#undef PG8_MMA
#undef PG8_WAIT_V
#undef PG8_WAIT_L
#undef PG8_BAR
#undef PG8_SCHED
}
}
#define XB_TMO      128
#define XB_XCNT(j)  (256  + 64 * (j))
#define XB_XSUB(j)  (1280 + 64 * (j))
#define XB_XGEN(j)  (2304 + 64 * (j))
#define XB_TOP      3328
#define XB_TOPGEN   3392
#define XCD_BAR_WORDS 3456
#define XB_SPIN_CAP (1u << 18)
#define LAS __attribute__((address_space(3)))

__device__ __forceinline__ unsigned xb_ld(unsigned* p)              { return __hip_atomic_load(p, __ATOMIC_RELAXED, __HIP_MEMORY_SCOPE_AGENT); }
__device__ __forceinline__ unsigned xb_add(unsigned* p, unsigned v) { return __hip_atomic_fetch_add(p, v, __ATOMIC_RELAXED, __HIP_MEMORY_SCOPE_AGENT); }
__device__ __forceinline__ unsigned xb_xcc_id() { return (unsigned)__builtin_amdgcn_s_getreg((3 << 11) | 20) & 0xFu; }
#define XB_SPIN(cond, bar) do { unsigned _sp = 0; while (cond) { __builtin_amdgcn_s_sleep(1); \
    if ((++_sp & 255u) == 0u) { if (xb_ld(&(bar)[XB_TMO])) break; if (_sp > XB_SPIN_CAP) { atomicAdd(&(bar)[XB_TMO], 1u); break; } } } } while (0)

struct XcdBarrier {
    unsigned* bar; unsigned x;
    volatile LAS unsigned* st;
};

__device__ __forceinline__ XcdBarrier xcd_barrier_post(unsigned* bar, volatile LAS unsigned* st) {
    XcdBarrier b; b.bar = bar; b.x = xb_xcc_id(); b.st = st;
    if (threadIdx.x == 0) (void)xb_add(&bar[XB_XCNT(b.x)], 1u);
    return b;
}
__device__ __forceinline__ void xcd_barrier_complete(unsigned* bar, unsigned x, unsigned& nloc, unsigned& nx) {
    const unsigned G = gridDim.x * gridDim.y * gridDim.z;
    unsigned sum, cnt, mine, sp = 0u;
    for (;;) {
        sum = 0u; cnt = 0u; mine = 0u;
#pragma unroll
        for (unsigned j = 0; j < 16; ++j) { const unsigned c = xb_ld(&bar[XB_XCNT(j)]); sum += c; cnt += (c > 0u) ? 1u : 0u; mine = (j == x) ? c : mine; }
        if (sum == G) break;
        __builtin_amdgcn_s_sleep(1);
        if ((++sp & 255u) == 0u) { if (xb_ld(&bar[XB_TMO])) break; if (sp > XB_SPIN_CAP) { atomicAdd(&bar[XB_TMO], 1u); break; } }
    }
    nloc = mine > 0u ? mine : 1u; nx = cnt > 0u ? cnt : 1u;
}

__device__ __forceinline__ void xcd_barrier(const XcdBarrier& b) {
    asm volatile("s_waitcnt vmcnt(0)" ::: "memory");
    __syncthreads();
    if (threadIdx.x == 0) {
        unsigned* bar = b.bar;
        __builtin_amdgcn_s_waitcnt(0);
        unsigned nloc = b.st[0], nx = b.st[1];
        if (nloc == 0u) { xcd_barrier_complete(bar, b.x, nloc, nx); b.st[0] = nloc; b.st[1] = nx; }
        const unsigned old = xb_add(&bar[XB_XSUB(b.x)], 1u);
        const unsigned gen = old / nloc;
        if (old + 1u == (gen + 1u) * nloc) {
            __builtin_amdgcn_fence(__ATOMIC_RELEASE, "agent");
            asm volatile("s_waitcnt vmcnt(0)" ::: "memory");
            const unsigned og = xb_add(&bar[XB_TOP], 1u);
            const unsigned tg = og / nx;
            if (og + 1u == (tg + 1u) * nx) xb_add(&bar[XB_TOPGEN], 1u);
            else XB_SPIN(xb_ld(&bar[XB_TOPGEN]) == tg, bar);
            __builtin_amdgcn_fence(__ATOMIC_ACQUIRE, "agent");
            xb_add(&bar[XB_XGEN(b.x)], 1u);
            asm volatile("s_waitcnt vmcnt(0)" ::: "memory");
        } else {
            XB_SPIN(xb_ld(&bar[XB_XGEN(b.x)]) == gen, bar);
            __builtin_amdgcn_fence(__ATOMIC_ACQUIRE, "agent");
            asm volatile("s_waitcnt vmcnt(0)" ::: "memory");
        }
    }
    __syncthreads();
}

#ifndef PROBE_PH
#define PROBE_PH -1
#define PROBE_N 0
#endif
namespace mk {
typedef unsigned short bf16;
typedef unsigned v4u __attribute__((ext_vector_type(4)));
typedef unsigned v2u __attribute__((ext_vector_type(2)));
typedef float f32x4 __attribute__((ext_vector_type(4)));
typedef short bf16x8 __attribute__((ext_vector_type(8)));
typedef __bf16 bf16x2 __attribute__((ext_vector_type(2)));

constexpr int NB = 8, SEQ = 2048, DM = 1024, T = NB * SEQ, NQKV = 3072;
constexpr float LN_EPS = 1e-5f;
constexpr float DN_ALPHA = 1.189207115002721f;
constexpr int NWAVES = 8, NTHR = 512;

constexpr size_t MiB = 1u << 20;
constexpr size_t WS_CTL = 0;
constexpr size_t CTL_ZERO_BYTES = 64 * 1024;
constexpr size_t WS_MODP = 1 * MiB;
constexpr size_t WS_MOD = 4 * MiB;
constexpr size_t WS_KMEAN = 4 * MiB + 256 * 1024;
constexpr size_t WS_WIN = 5 * MiB;
constexpr size_t WS_WOUT = 11 * MiB;
constexpr size_t WS_WQ = 13 * MiB;
constexpr size_t WS_U = 16 * MiB;
constexpr size_t WS_V = 48 * MiB;
constexpr size_t WS_H = 80 * MiB;
constexpr size_t WS_QKV = 112 * MiB;
constexpr size_t WS_ATT = 208 * MiB;
constexpr size_t WS_END = 256 * MiB;
constexpr int CW_BAR = 4096;
constexpr float PEER_USCALE = 32.f;

constexpr int RING_BYTES = 131072;
constexpr int MISC_OFF = RING_BYTES + 320;
constexpr int LDS_BYTES = 147456;

__device__ __forceinline__ unsigned f2bf(float f) { unsigned u = __float_as_uint(f); return (u + 0x7fffu + ((u >> 16) & 1u)) >> 16; }
__device__ __forceinline__ unsigned pk2(float lo, float hi) { return f2bf(lo) | (f2bf(hi) << 16); }
__device__ __forceinline__ float bflo(unsigned w) { return __uint_as_float(w << 16); }
__device__ __forceinline__ float bfhi(unsigned w) { return __uint_as_float(w & 0xffff0000u); }
__device__ __forceinline__ float dot2(unsigned a, unsigned b, float acc) { return __builtin_amdgcn_fdot2_f32_bf16(__builtin_bit_cast(bf16x2, a), __builtin_bit_cast(bf16x2, b), acc, false); }
__device__ __forceinline__ float wave_sum(float v) {
#pragma unroll
    for (int o = 1; o < 64; o <<= 1) v += __shfl_xor(v, o);
    return v;
}
__device__ __forceinline__ int t5_bucket(int d) {
    if (d < 16) return d;
    int b = 16;
    b += (d >= 22); b += (d >= 30); b += (d >= 40); b += (d >= 54); b += (d >= 73); b += (d >= 99); b += (d >= 134); b += (d >= 182);
    b += (d >= 246); b += (d >= 332); b += (d >= 450); b += (d >= 609); b += (d >= 825); b += (d >= 1117); b += (d >= 1513);
    return b;
}

template <int CTRL> __device__ __forceinline__ float dppf(float v) { return __builtin_bit_cast(float, __builtin_amdgcn_update_dpp(0, __builtin_bit_cast(int, v), CTRL, 0xf, 0xf, false)); }
struct EpiQKV {
    static constexpr bool PERM = true, AFTER_DRAIN = false;
    pg8::EpiBf16<0> base; float* kmean;
    __device__ __forceinline__ void operator()(const pg8::f32x4 (&acc)[2][2][4][2], const pg8::Unit& u, int wr, int wc, int fr, int fq) const {
        base(acc, u, wr, wc, fr, fq);
        if (u.pn == 2 || u.pn == 3) {
            const int b = u.pm >> 3, n = u.pm & 7;
#pragma unroll
            for (int bj = 0; bj < 2; ++bj)
#pragma unroll
                for (int nn = 0; nn < 2; ++nn) {
                    pg8::f32x4 cs = acc[0][bj][0][nn];
#pragma unroll
                    for (int ai = 0; ai < 2; ++ai)
#pragma unroll
                        for (int m = 0; m < 4; ++m) if (ai + m) cs += acc[ai][bj][m][nn];
                    float v[4] = {cs.x, cs.y, cs.z, cs.w};
#pragma unroll
                    for (int j = 0; j < 4; ++j) { float t = v[j]; t += dppf<0xB1>(t); t += dppf<0x4E>(t); t += dppf<0x141>(t); t += dppf<0x140>(t); v[j] = t; }
                    if (fr == 0) {
                        const int c = (u.pn - 2) * 256 + bj * 128 + wc * 32 + 8 * fq + 4 * nn;
                        float* dst = kmean + ((b * 8 + (c >> 6)) * 8 + n) * 64 + (c & 63);
#pragma unroll
                        for (int j = 0; j < 4; ++j) atomicAdd(dst + j, v[j] * (1.f / 256.f));
                    }
                }
        }
    }
};
struct Args {
    const float* in[17]; float* out; unsigned char* ws; int ph_lo, ph_hi, bar_idx, pad;
};

template <int MODE>
__device__ __forceinline__ void transpose_item(const float* W, int K, int N, bf16* WT, LAS float* scr, int item, int lane, const float* gna, const float* gnb) {
    const int nblk = N / 32, kb = item / nblk, nb = item % nblk, k0 = 64 * kb, n0 = 32 * nb;
    float cs = 1.f;
    if (MODE == 1) { if (n0 < 512 || (n0 >= 1536 && n0 < 2048)) cs = 0.125f; }
#pragma unroll 8
    for (int i = 0; i < 32; ++i) { const int kk = 2 * i + (lane >> 5); float v = W[(size_t)(k0 + kk) * N + n0 + (lane & 31)] * cs;
        if (MODE == 2) { const int k = k0 + kk; v *= (k < 512) ? gna[k] : gnb[k - 512]; }
        scr[kk * 33 + (lane & 31)] = v; }
    asm volatile("s_waitcnt lgkmcnt(0)" ::: "memory");
    const int c = lane & 7;
#pragma unroll
    for (int j = 0; j < 4; ++j) { const int n = (lane >> 3) + 8 * j; const LAS float* s = scr + (8 * c) * 33 + n;
        v4u o; o.x = pk2(s[0 * 33], s[1 * 33]); o.y = pk2(s[2 * 33], s[3 * 33]); o.z = pk2(s[4 * 33], s[5 * 33]); o.w = pk2(s[6 * 33], s[7 * 33]);
        *(v4u*)(WT + (size_t)(n0 + n) * K + k0 + 8 * c) = o; }
    asm volatile("s_waitcnt lgkmcnt(0)" ::: "memory");
}

__device__ __forceinline__ void p0_prologue(const Args& a, LAS unsigned char* lds, int G, int tid, int lane, int wave) {
    unsigned char* ws = a.ws;
    {
        const float* c = a.in[1]; const float* w_ada = a.in[2]; float* modp = (float*)(ws + WS_MODP);
        LAS float* sc = (LAS float*)lds;
        for (int item = blockIdx.x; item < 192; item += G) {
            const int ks = item / 12, cb = item % 12;
            { const int b = tid >> 6, i = tid & 63; const float v = c[b * DM + ks * 64 + i]; sc[b * 64 + i] = v / (1.f + __expf(-v)); }
            __syncthreads();
            const int col = cb * 512 + tid;
            float acc[8];
#pragma unroll
            for (int b = 0; b < 8; ++b) acc[b] = 0.f;
#pragma unroll 8
            for (int i = 0; i < 64; ++i) { const float w = w_ada[(size_t)(ks * 64 + i) * 6144 + col];
#pragma unroll
                for (int b = 0; b < 8; ++b) acc[b] += sc[b * 64 + i] * w; }
#pragma unroll
            for (int b = 0; b < 8; ++b) modp[(size_t)(ks * 8 + b) * 6144 + col] = acc[b];
            __syncthreads();
        }
    }
    {
        LAS float* scr = (LAS float*)(lds + wave * 16384);
        const int gw = blockIdx.x * NWAVES + wave, NGW = G * NWAVES;
        constexpr int I_IN = 16 * 96, I_O = 16 * 32, I_Q = 16 * 32;
        for (int it = gw; it < I_IN + I_O + I_Q; it += NGW) {
            int r = it;
            if (r < I_IN) { transpose_item<1>(a.in[4], DM, NQKV, (bf16*)(ws + WS_WIN), scr, r, lane, nullptr, nullptr); continue; } r -= I_IN;
            if (r < I_O) { transpose_item<2>(a.in[8], DM, DM, (bf16*)(ws + WS_WOUT), scr, r, lane, a.in[6], a.in[7]); continue; } r -= I_O;
            transpose_item<0>(a.in[11], DM, DM, (bf16*)(ws + WS_WQ), scr, r, lane, nullptr, nullptr);
        }
    }
    {
        const size_t nthr = (size_t)G * NTHR, gt = (size_t)blockIdx.x * NTHR + tid;
        const size_t per = (size_t)16384 * 1024 / 16;
        for (size_t i = gt; i < 2 * per; i += nthr) {
            const bool second = i >= per; const size_t j = second ? i - per : i; const float sc = second ? 1.f : PEER_USCALE;
            const f32x4* src = (const f32x4*)(second ? a.in[14] : a.in[13]) + 4 * j;
            v4u o;
#pragma unroll
            for (int q = 0; q < 4; ++q) { const f32x4 p = src[q]; int w = 0;
                w = __builtin_amdgcn_cvt_pk_fp8_f32(p.x * sc, p.y * sc, w, false); w = __builtin_amdgcn_cvt_pk_fp8_f32(p.z * sc, p.w * sc, w, true); o[q] = (unsigned)w; }
            ((v4u*)(ws + (second ? WS_V : WS_U)))[j] = o;
        }
        float* km = (float*)(ws + WS_KMEAN);
        for (size_t i = gt; i < 32768; i += nthr) km[i] = 0.f;
    }
}

__device__ __forceinline__ void p1_mod_h(const Args& a, LAS unsigned char* lds, int G, int tid, int lane, int wave) {
    unsigned char* ws = a.ws;
    const float* modp = (const float*)(ws + WS_MODP); const float* b_ada = a.in[3];
    float* mod = (float*)(ws + WS_MOD);
    for (int i = blockIdx.x * NTHR + tid; i < 8 * 6144; i += G * NTHR) {
        const int b = i / 6144, j = i % 6144; float s = b_ada[j];
#pragma unroll
        for (int ks = 0; ks < 16; ++ks) s += modp[(size_t)(ks * 8 + b) * 6144 + j];
        mod[i] = s;
    }
    LAS float* sm = (LAS float*)lds;
    const float* x = a.in[0]; bf16* H = (bf16*)(ws + WS_H);
    int curb = -1;
    for (int rb = blockIdx.x; rb < T / 64; rb += G) {
        const int b = rb >> 5;
        if (b != curb) {
            __syncthreads();
            for (int j = tid; j < 2048; j += NTHR) { float s = b_ada[j];
#pragma unroll
                for (int ks = 0; ks < 16; ++ks) s += modp[(size_t)(ks * 8 + b) * 6144 + j];
                sm[j] = s; }
            __syncthreads();
            curb = b;
        }
#pragma unroll 2
        for (int r = 0; r < 8; ++r) {
            const int row = rb * 64 + wave * 8 + r;
#pragma unroll
            for (int hf = 0; hf < 2; ++hf) {
                const int c0 = hf * 512 + 8 * lane;
                const f32x4 p = *(const f32x4*)(x + (size_t)row * DM + c0), q = *(const f32x4*)(x + (size_t)row * DM + c0 + 4);
                const f32x4 s0 = *(const LAS f32x4*)(sm + 1024 + c0), s1 = *(const LAS f32x4*)(sm + 1024 + c0 + 4);
                const f32x4 h0 = *(const LAS f32x4*)(sm + c0), h1 = *(const LAS f32x4*)(sm + c0 + 4);
                v4u o; o.x = pk2(p.x * (1.f + s0.x) + h0.x, p.y * (1.f + s0.y) + h0.y); o.y = pk2(p.z * (1.f + s0.z) + h0.z, p.w * (1.f + s0.w) + h0.w);
                o.z = pk2(q.x * (1.f + s1.x) + h1.x, q.y * (1.f + s1.y) + h1.y); o.w = pk2(q.z * (1.f + s1.z) + h1.z, q.w * (1.f + s1.w) + h1.w);
                *(v4u*)(H + (size_t)row * DM + c0) = o;
            }
        }
    }
}

__device__ __forceinline__ void p3_kmean(const Args& a, LAS unsigned char* lds, int G, int tid) {
    unsigned char* ws = a.ws; const bf16* QKV = (const bf16*)(ws + WS_QKV); float* km = (float*)(ws + WS_KMEAN);
    LAS float* red = (LAS float*)lds;
    for (int item = blockIdx.x; item < 256; item += G) {
        const int b = item >> 5, n = (item >> 2) & 7, rq = item & 3;
        const int cp = tid & 255, rg = tid >> 8;
        const size_t row0 = (size_t)b * SEQ + n * 256 + rq * 64 + rg * 32;
        float s0 = 0.f, s1 = 0.f;
#pragma unroll 8
        for (int r = 0; r < 32; ++r) { const unsigned w = *(const unsigned*)(QKV + (row0 + r) * NQKV + 512 + 2 * cp); s0 += bflo(w); s1 += bfhi(w); }
        if (rg == 1) { red[2 * cp] = s0; red[2 * cp + 1] = s1; }
        __syncthreads();
        if (rg == 0) { s0 += red[2 * cp]; s1 += red[2 * cp + 1]; const int c = 2 * cp, h = c >> 6, d = c & 63;
            float* dst = km + ((b * 8 + h) * 8 + n) * 64 + d;
            atomicAdd(dst, s0 * (1.f / 256.f)); atomicAdd(dst + 1, s1 * (1.f / 256.f)); }
        __syncthreads();
    }
}

__device__ __forceinline__ void unpack8(const v4u w, float (&v)[8]) { v[0] = bflo(w.x); v[1] = bfhi(w.x); v[2] = bflo(w.y); v[3] = bfhi(w.y); v[4] = bflo(w.z); v[5] = bfhi(w.z); v[6] = bflo(w.w); v[7] = bfhi(w.w); }
typedef short v4i16 __attribute__((ext_vector_type(4)));
constexpr float LOG2E = 1.4426950408889634f;
constexpr int AT_ROW = 160, AT_K = 0, AT_V = 128 * AT_ROW, AT_LUT = 256 * AT_ROW, AT_GATE = AT_LUT + 8192, AT_SEL = AT_GATE + 4096, AT_ANY = AT_SEL + 512;
constexpr size_t WS_YA = WS_ATT, WS_OB0 = WS_ATT + 16 * MiB, WS_OB1 = WS_ATT + 32 * MiB, WS_OB2 = WS_H, WS_LSE = WS_H + 16 * MiB;

__device__ __forceinline__ unsigned pkbf(float lo, float hi) { bf16x2 t; t.x = (__bf16)lo; t.y = (__bf16)hi; return __builtin_bit_cast(unsigned, t); }
__device__ __forceinline__ bf16x8 mk8(v4i16 a, v4i16 b) { return __builtin_shufflevector(a, b, 0, 1, 2, 3, 4, 5, 6, 7); }
__device__ __forceinline__ v4i16 tr16(const LAS unsigned char* p) { return __builtin_amdgcn_ds_read_tr16_b64_v4i16((LAS v4i16*)p); }

struct AttnState { bf16x8 qf[2]; f32x4 ot[4]; float m, l; };

template <bool SEL>
__device__ __forceinline__ void attn_chunk(AttnState& st, const LAS unsigned char* lds, int s_lo, int s_hi, int m_lo, int m_hi, int lane, int qidx, int k0, int dmax, bool lanesel) {
    const int q15 = lane & 15, g = lane >> 4;
    f32x4 s0[4], s1[4];
#pragma unroll
    for (int sub = 0; sub < 4; ++sub) {
        s0[sub] = (f32x4){0.f, 0.f, 0.f, 0.f}; s1[sub] = (f32x4){0.f, 0.f, 0.f, 0.f};
        if (sub >= s_lo && sub <= s_hi) {
            const LAS unsigned char* kb = lds + AT_K + (sub * 32 + q15) * AT_ROW + g * 16;
#pragma unroll
            for (int ks = 0; ks < 2; ++ks) {
                const bf16x8 a0 = *(const LAS bf16x8*)(kb + ks * 64), a1 = *(const LAS bf16x8*)(kb + 16 * AT_ROW + ks * 64);
                s0[sub] = __builtin_amdgcn_mfma_f32_16x16x32_bf16(a0, st.qf[ks], s0[sub], 0, 0, 0);
                s1[sub] = __builtin_amdgcn_mfma_f32_16x16x32_bf16(a1, st.qf[ks], s1[sub], 0, 0, 0);
            }
        }
    }
    const LAS float* lut = (const LAS float*)(lds + AT_LUT);
    float sc[4][8]; float mx = -INFINITY;
#pragma unroll
    for (int sub = 0; sub < 4; ++sub) {
        const float sv[8] = {s0[sub].x, s0[sub].y, s0[sub].z, s0[sub].w, s1[sub].x, s1[sub].y, s1[sub].z, s1[sub].w};
        const int dbase = qidx - (k0 + sub * 32 + 4 * g);
        if (sub < s_lo || sub > s_hi) {
#pragma unroll
            for (int r = 0; r < 8; ++r) sc[sub][r] = -INFINITY;
        } else if (sub >= m_lo && sub <= m_hi) {
#pragma unroll
            for (int r = 0; r < 8; ++r) {
                const int d = dbase - (r & 3) - (r >> 2) * 16;
                const bool ok = (!SEL || lanesel) && d >= 0 && d <= dmax;
                const int dc = d < 0 ? 0 : (d > dmax ? dmax : d);
                sc[sub][r] = ok ? (sv[r] * LOG2E + lut[dc]) : -INFINITY;
                mx = fmaxf(mx, sc[sub][r]);
            }
        } else {
            const LAS float* lp = lut + (dbase - 19);
#pragma unroll
            for (int r = 0; r < 8; ++r) {
                const float v = sv[r] * LOG2E + lp[19 - (r & 3) - (r >> 2) * 16];
                sc[sub][r] = (SEL && !lanesel) ? -INFINITY : v;
                mx = fmaxf(mx, sc[sub][r]);
            }
        }
    }
    mx = fmaxf(mx, __shfl_xor(mx, 16)); mx = fmaxf(mx, __shfl_xor(mx, 32));
    const float mn = fmaxf(st.m, mx), mu = (mn == -INFINITY) ? 0.f : mn;
    const float alpha = __builtin_amdgcn_exp2f(st.m - mu);
    float ps = 0.f;
#pragma unroll
    for (int sub = 0; sub < 4; ++sub) {
        if (sub >= s_lo && sub <= s_hi) {
#pragma unroll
            for (int r = 0; r < 8; ++r) { sc[sub][r] = __builtin_amdgcn_exp2f(sc[sub][r] - mu); ps += sc[sub][r]; }
        }
    }
    st.l = st.l * alpha + ps; st.m = mn;
    if (!__all(alpha == 1.f)) {
#pragma unroll
        for (int n = 0; n < 4; ++n) st.ot[n] *= alpha;
    }
#pragma unroll
    for (int sub = 0; sub < 4; ++sub) {
        if (sub >= s_lo && sub <= s_hi) {
            v4u pw; pw.x = pkbf(sc[sub][0], sc[sub][1]); pw.y = pkbf(sc[sub][2], sc[sub][3]); pw.z = pkbf(sc[sub][4], sc[sub][5]); pw.w = pkbf(sc[sub][6], sc[sub][7]);
            const bf16x8 pb = __builtin_bit_cast(bf16x8, pw);
            const LAS unsigned char* vb = lds + AT_V + (sub * 32 + 4 * g + (q15 >> 2)) * AT_ROW + (q15 & 3) * 8;
#pragma unroll
            for (int n = 0; n < 4; ++n) {
                const v4i16 r1 = tr16(vb + n * 32), r2 = tr16(vb + 16 * AT_ROW + n * 32);
                st.ot[n] = __builtin_amdgcn_mfma_f32_16x16x32_bf16(mk8(r1, r2), pb, st.ot[n], 0, 0, 0);
            }
        }
    }
}

struct ChunkRegs { v4u k0, k1, v0, v1; };
__device__ __forceinline__ void chunk_fetch(ChunkRegs& c, const bf16* kbase  , int kstride_tok, int tid) {
    const int r0 = tid >> 3, cc = tid & 7;
    const bf16* p0 = kbase + (size_t)(r0 * kstride_tok) * NQKV + cc * 8; const bf16* p1 = kbase + (size_t)((r0 + 64) * kstride_tok) * NQKV + cc * 8;
    c.k0 = *(const v4u*)p0; c.k1 = *(const v4u*)p1; c.v0 = *(const v4u*)(p0 + 512); c.v1 = *(const v4u*)(p1 + 512);
}
__device__ __forceinline__ void chunk_store(const ChunkRegs& c, LAS unsigned char* lds, int tid) {
    const int r0 = tid >> 3, cc = tid & 7;
    *(LAS v4u*)(lds + AT_K + r0 * AT_ROW + cc * 16) = c.k0; *(LAS v4u*)(lds + AT_K + (r0 + 64) * AT_ROW + cc * 16) = c.k1;
    *(LAS v4u*)(lds + AT_V + r0 * AT_ROW + cc * 16) = c.v0; *(LAS v4u*)(lds + AT_V + (r0 + 64) * AT_ROW + cc * 16) = c.v1;
}
__device__ __forceinline__ void attn_init(AttnState& st, const bf16* qrow  , int lane) {
    const int g = lane >> 4;
    st.qf[0] = *(const bf16x8*)(qrow + 8 * g); st.qf[1] = *(const bf16x8*)(qrow + 32 + 8 * g);
#pragma unroll
    for (int n = 0; n < 4; ++n) st.ot[n] = (f32x4){0.f, 0.f, 0.f, 0.f};
    st.m = -INFINITY; st.l = 0.f;
}
__device__ __forceinline__ float attn_finish(AttnState& st, bf16* orow  , int lane) {
    float l = st.l; l += __shfl_xor(l, 16); l += __shfl_xor(l, 32);
    const float inv = 1.f / l; const int g = lane >> 4;
#pragma unroll
    for (int n = 0; n < 4; ++n) { v2u w; w.x = pkbf(st.ot[n][0] * inv, st.ot[n][1] * inv); w.y = pkbf(st.ot[n][2] * inv, st.ot[n][3] * inv);
        *(v2u*)(orow + 16 * n + 4 * g) = w; }
    return l;
}

template <int MODE>
__device__ __forceinline__ void moba_item(const Args& a, LAS unsigned char* lds, int item, int tid, int lane, int wave) {
    unsigned char* ws = a.ws; const bf16* QKV = (const bf16*)(ws + WS_QKV);
    const int qblk = 7 - (item >> 7), idx = item & 127, bh = idx >> 1, b = bh >> 3, h = bh & 7, qt = 2 * qblk + (idx & 1);
    const size_t tokb = (size_t)b * SEQ;
    LAS float* lut = (LAS float*)(lds + AT_LUT); LAS float* gates = (LAS float*)(lds + AT_GATE); LAS unsigned* selm = (LAS unsigned*)(lds + AT_SEL); LAS unsigned* anyw = (LAS unsigned*)(lds + AT_ANY);
    __syncthreads();
    for (int d = tid; d < 2048; d += NTHR) lut[d] = a.in[5][h * 32 + t5_bucket(d)] * LOG2E;
    if (tid == 0) *anyw = 0u;
    unsigned anysel;
    if (qblk > 3) {
        {
            const int qi = tid & 127, gi = tid >> 7;
            const bf16* qp = QKV + (tokb + qt * 128 + qi) * NQKV + h * 64;
            float ga = 0.f, gb = 0.f; const float* kma = (const float*)(ws + WS_KMEAN) + ((b * 8 + h) * 8 + gi) * 64; const float* kmb = kma + 4 * 64;
#pragma unroll
            for (int i = 0; i < 8; ++i) { const v4u w = *(const v4u*)(qp + 8 * i); float qv[8]; unpack8(w, qv);
#pragma unroll
                for (int j = 0; j < 8; ++j) { ga += qv[j] * kma[8 * i + j]; gb += qv[j] * kmb[8 * i + j]; } }
            gates[qi * 8 + gi] = ga; gates[qi * 8 + gi + 4] = gb;
        }
        __syncthreads();
        if (tid < 128) {
            float gv[8];
#pragma unroll
            for (int n = 0; n < 8; ++n) gv[n] = (n < qblk) ? gates[tid * 8 + n] : -INFINITY;
            unsigned sel = 0;
#pragma unroll
            for (int r = 0; r < 3; ++r) { float best = -INFINITY; int bi = 0;
#pragma unroll
                for (int n = 0; n < 8; ++n) { const bool take = !((sel >> n) & 1u) && (gv[n] > best); best = take ? gv[n] : best; bi = take ? n : bi; }
                sel |= 1u << bi; }
            selm[tid] = sel; atomicOr((unsigned*)anyw, sel);
        }
        __syncthreads();
        anysel = *anyw;
    } else { anysel = (1u << qblk) - 1u; __syncthreads(); }
    const unsigned mysel = (qblk > 3) ? selm[wave * 16 + (lane & 15)] : anysel;
    unsigned cm = 0;
    for (int n = 0; n < qblk; ++n) if ((anysel >> n) & 1u) cm |= 3u << (2 * n);
    cm |= 1u << (2 * qblk); if (qt & 1) cm |= 2u << (2 * qblk);
    const int qpos = qt * 128 + wave * 16 + (lane & 15), wq_hi = qt * 128 + wave * 16 + 15, wq_lo = qt * 128 + wave * 16;
    AttnState st; attn_init(st, QKV + (tokb + qpos) * NQKV + h * 64, lane);
    ChunkRegs cr; const bf16* kcol = QKV + tokb * NQKV + 512 + h * 64;
    { const int c0 = __builtin_ctz(cm); if (MODE != 2) chunk_fetch(cr, kcol + (size_t)(c0 * 128) * NQKV, 1, tid); }
    while (cm) {
        const int cur = __builtin_ctz(cm); cm &= cm - 1u;
        __syncthreads();
        if (MODE != 2) chunk_store(cr, lds, tid);
        __syncthreads();
        if (cm) { const int nx = __builtin_ctz(cm); if (MODE != 2) chunk_fetch(cr, kcol + (size_t)(nx * 128) * NQKV, 1, tid); }
        const int n = cur >> 1, k0 = cur * 128; const bool own = (n == qblk);
        const bool lsel = own || ((mysel >> n) & 1u);
        if (own) {
            int s_hi = (wq_hi - k0) >> 5; s_hi = s_hi > 3 ? 3 : s_hi;
            int m_lo = (wq_lo - k0 + 1) >> 5; m_lo = m_lo < 0 ? 0 : m_lo;
            if (s_hi >= 0 && MODE != 3) attn_chunk<false>(st, lds, 0, s_hi, m_lo, s_hi, lane, qpos, k0, 2047, true);
        } else if (__any(lsel)) {
            if (MODE != 3) attn_chunk<true>(st, lds, 0, 3, 4, 3, lane, qpos, k0, 2047, lsel);
        }
    }
    attn_finish(st, (bf16*)(ws + WS_YA) + (tokb + qpos) * 512 + h * 64, lane);
}

template <int MODE>
__device__ __forceinline__ void dil_item(const Args& a, LAS unsigned char* lds, int item, int tid, int lane, int wave) {
    unsigned char* ws = a.ws; const bf16* QKV = (const bf16*)(ws + WS_QKV);
    const int grp = item >> 4, sub16 = item & 15, br = grp % 3, bh = grp / 3, b = bh >> 3, h = bh & 7;
    const int dil = (br == 0) ? 1 : (br == 1 ? 4 : 16);
    const int r = (br == 0) ? 0 : (br == 1 ? (sub16 >> 2) : sub16), j = (br == 0) ? sub16 : (br == 1 ? (sub16 & 3) : 0);
    const size_t tokb = (size_t)b * SEQ;
    LAS float* lut = (LAS float*)(lds + AT_LUT);
    __syncthreads();
    for (int d = tid; d <= 128; d += NTHR) lut[d] = a.in[5][(8 + h) * 32 + t5_bucket(d * dil)] * LOG2E;
    const int lq = 128 * j + wave * 16 + (lane & 15);
    const size_t qtok = tokb + (size_t)lq * dil + r;
    AttnState st; attn_init(st, QKV + qtok * NQKV + 1536 + h * 64, lane);
    ChunkRegs cr; const bf16* kcol = QKV + (tokb + r) * NQKV + 2048 + h * 64;
    const int c_first = (j > 0) ? 0 : 1;
    if (MODE != 2) chunk_fetch(cr, kcol + (size_t)((128 * (j - 1 + c_first)) * dil) * NQKV, dil, tid);
#pragma unroll 1
    for (int c = c_first; c < 2; ++c) {
        __syncthreads();
        if (MODE != 2) chunk_store(cr, lds, tid);
        __syncthreads();
        if (c == 0) if (MODE != 2) chunk_fetch(cr, kcol + (size_t)((128 * j) * dil) * NQKV, dil, tid);
        const int k0 = 128 * (j - 1 + c), wh = wave >> 1;
        const int s_lo = (c == 0) ? wh : 0, s_hi = (c == 0) ? 3 : wh;
        if (MODE != 3) attn_chunk<false>(st, lds, s_lo, s_hi, wh, wh, lane, lq, k0, 128, true);
    }
    bf16* ob = (bf16*)(ws + (br == 0 ? WS_OB0 : (br == 1 ? WS_OB1 : WS_OB2)));
    const float l = attn_finish(st, ob + qtok * 512 + h * 64, lane);
    if ((lane >> 4) == 0) ((float*)(ws + WS_LSE))[((size_t)br * T + qtok) * 8 + h] = st.m + __builtin_amdgcn_logf(l);
}

template <int MODE>
__device__ __forceinline__ void p4_attn(const Args& a, LAS unsigned char* lds, int G, int tid, int lane, int wave) {
    for (int v = blockIdx.x; v < 256; v += G) {
        moba_item<MODE>(a, lds, v, tid, lane, wave);
        moba_item<MODE>(a, lds, 256 + v, tid, lane, wave);
        moba_item<MODE>(a, lds, 767 - v, tid, lane, wave);
        moba_item<MODE>(a, lds, 1023 - v, tid, lane, wave);
#pragma unroll 1
        for (int i = 0; i < 12; ++i) dil_item<MODE>(a, lds, v * 12 + i, tid, lane, wave);
    }
}

__device__ __forceinline__ void p5_combine_rms(const Args& a, int G, int lane, int wave) {
    unsigned char* ws = a.ws; const bf16* YA = (const bf16*)(ws + WS_YA);
    const bf16* OB0 = (const bf16*)(ws + WS_OB0); const bf16* OB1 = (const bf16*)(ws + WS_OB1); const bf16* OB2 = (const bf16*)(ws + WS_OB2);
    const float* LSE = (const float*)(ws + WS_LSE); bf16* A2 = (bf16*)a.out;
    for (int row = blockIdx.x * NWAVES + wave; row < T; row += G * NWAVES) {
        float v[8], o0[8], o1[8], o2[8];
        unpack8(*(const v4u*)(YA + (size_t)row * 512 + 8 * lane), v);
        unpack8(*(const v4u*)(OB0 + (size_t)row * 512 + 8 * lane), o0); unpack8(*(const v4u*)(OB1 + (size_t)row * 512 + 8 * lane), o1); unpack8(*(const v4u*)(OB2 + (size_t)row * 512 + 8 * lane), o2);
        const int h = lane >> 3;
        const float l0 = LSE[((size_t)0 * T + row) * 8 + h], l1 = LSE[((size_t)1 * T + row) * 8 + h], l2 = LSE[((size_t)2 * T + row) * 8 + h];
        const float mx = fmaxf(l0, fmaxf(l1, l2));
        float w0 = __builtin_amdgcn_exp2f(l0 - mx), w1 = __builtin_amdgcn_exp2f(l1 - mx), w2 = __builtin_amdgcn_exp2f(l2 - mx);
        const float inv = 1.f / (w0 + w1 + w2); w0 *= inv; w1 *= inv; w2 *= inv;
        float ssa = 0.f, ssb = 0.f;
#pragma unroll
        for (int j = 0; j < 8; ++j) { o0[j] = w0 * o0[j] + w1 * o1[j] + w2 * o2[j]; ssa += v[j] * v[j]; ssb += o0[j] * o0[j]; }
        ssa = wave_sum(ssa); ssb = wave_sum(ssb);
        const float ra = rsqrtf(ssa * (1.f / 512.f) + LN_EPS), rb = rsqrtf(ssb * (1.f / 512.f) + LN_EPS);
        v4u o; o.x = pkbf(v[0] * ra, v[1] * ra); o.y = pkbf(v[2] * ra, v[3] * ra); o.z = pkbf(v[4] * ra, v[5] * ra); o.w = pkbf(v[6] * ra, v[7] * ra);
        *(v4u*)(A2 + (size_t)row * DM + 8 * lane) = o;
        o.x = pkbf(o0[0] * rb, o0[1] * rb); o.y = pkbf(o0[2] * rb, o0[3] * rb); o.z = pkbf(o0[4] * rb, o0[5] * rb); o.w = pkbf(o0[6] * rb, o0[7] * rb);
        *(v4u*)(A2 + (size_t)row * DM + 512 + 8 * lane) = o;
    }
}
__device__ __forceinline__ void load16(const float* p, int lane, float (&v)[16]) {
#pragma unroll
    for (int q = 0; q < 4; ++q) { const f32x4 t = *(const f32x4*)(p + (q >> 1) * 512 + 8 * lane + (q & 1) * 4); v[4 * q] = t.x; v[4 * q + 1] = t.y; v[4 * q + 2] = t.z; v[4 * q + 3] = t.w; }
}
__device__ __forceinline__ void store16(float* p, int lane, const float (&v)[16]) {
#pragma unroll
    for (int q = 0; q < 4; ++q) { f32x4 t; t.x = v[4 * q]; t.y = v[4 * q + 1]; t.z = v[4 * q + 2]; t.w = v[4 * q + 3]; *(f32x4*)(p + (q >> 1) * 512 + 8 * lane + (q & 1) * 4) = t; }
}
__device__ __forceinline__ void layer_norm16(float (&z)[16], const float* g, const float* bta, int lane) {
    float s = 0.f;
#pragma unroll
    for (int j = 0; j < 16; ++j) s += z[j];
    const float mu = wave_sum(s) * (1.f / DM); float q = 0.f;
#pragma unroll
    for (int j = 0; j < 16; ++j) { z[j] -= mu; q += z[j] * z[j]; }
    const float rs = rsqrtf(wave_sum(q) * (1.f / DM) + LN_EPS);
    float gg[16], bb[16]; load16(g, lane, gg); load16(bta, lane, bb);
#pragma unroll
    for (int j = 0; j < 16; ++j) z[j] = z[j] * rs * gg[j] + bb[j];
}

__device__ __forceinline__ void p7_ln1(const Args& a, int G, int lane, int wave) {
    unsigned char* ws = a.ws; const float* x = a.in[0]; const float* Y = (const float*)(ws + WS_QKV); const float* mod = (const float*)(ws + WS_MOD);
    float* x1 = a.out; bf16* H2 = (bf16*)(ws + WS_H);
    for (int row = blockIdx.x * NWAVES + wave; row < T; row += G * NWAVES) {
        const int b = row >> 11; float z[16], y[16], t[16];
        load16(x + (size_t)row * DM, lane, z); load16(Y + (size_t)row * DM, lane, y); load16(mod + b * 6144 + 2048, lane, t);
#pragma unroll
        for (int j = 0; j < 16; ++j) z[j] = DN_ALPHA * z[j] + (1.f + t[j]) * y[j];
        layer_norm16(z, a.in[9], a.in[10], lane);
        store16(x1 + (size_t)row * DM, lane, z);
        load16(mod + b * 6144 + 4096, lane, y); load16(mod + b * 6144 + 3072, lane, t);
#pragma unroll
        for (int j = 0; j < 16; ++j) z[j] = z[j] * (1.f + y[j]) + t[j];
        v4u o0, o1; o0.x = pk2(z[0], z[1]); o0.y = pk2(z[2], z[3]); o0.z = pk2(z[4], z[5]); o0.w = pk2(z[6], z[7]);
        o1.x = pk2(z[8], z[9]); o1.y = pk2(z[10], z[11]); o1.z = pk2(z[12], z[13]); o1.w = pk2(z[14], z[15]);
        *(v4u*)(H2 + (size_t)row * DM + 8 * lane) = o0; *(v4u*)(H2 + (size_t)row * DM + 512 + 8 * lane) = o1;
    }
}

__device__ __forceinline__ unsigned mono(float s) { const unsigned u = __float_as_uint(s); return u ^ ((unsigned)((int)u >> 31) | 0x80000000u); }
__device__ __forceinline__ float unmono(unsigned k) { return __uint_as_float((k & 0x80000000u) ? (k ^ 0x80000000u) : ~k); }
__device__ __forceinline__ void ins16(unsigned (&t)[16], unsigned x) {
#pragma unroll
    for (int j = 0; j < 16; ++j) { const unsigned hi = t[j] > x ? t[j] : x; x = t[j] > x ? x : t[j]; t[j] = hi; }
}
__device__ __forceinline__ unsigned lookup8(unsigned long long lo, unsigned long long hi, int idx) {
    const unsigned long long w = (idx & 8) ? hi : lo;
    return (unsigned)(w >> ((idx & 7) * 8)) & 0xffu;
}
template <int N> __device__ __forceinline__ void sort_desc(unsigned (&a)[N]) {
#pragma unroll
    for (int k = 2; k <= N; k <<= 1)
#pragma unroll
        for (int j = k >> 1; j > 0; j >>= 1)
#pragma unroll
            for (int i = 0; i < N; ++i) { const int l = i ^ j;
                if (l > i) { const unsigned x = a[i], y = a[l], hi = x > y ? x : y, lo = x > y ? y : x;
                    if ((i & k) == 0) { a[i] = hi; a[l] = lo; } else { a[i] = lo; a[l] = hi; } } }
}
__device__ __forceinline__ void merge_top16(unsigned (&a)[16], const unsigned (&b)[16]) {
#pragma unroll
    for (int i = 0; i < 16; ++i) a[i] = a[i] > b[15 - i] ? a[i] : b[15 - i];
#pragma unroll
    for (int j = 8; j > 0; j >>= 1)
#pragma unroll
        for (int i = 0; i < 16; ++i) { const int l = i ^ j; if (l > i) { const unsigned x = a[i], y = a[l]; a[i] = x > y ? x : y; a[l] = x > y ? y : x; } }
}
__device__ __forceinline__ void xmerge(unsigned (&a)[16], int mask) {
    unsigned b[16];
#pragma unroll
    for (int i = 0; i < 16; ++i) b[i] = (unsigned)__shfl_xor((int)a[i], mask);
    merge_top16(a, b);
}
constexpr int TK_ROW = 144;
__device__ __forceinline__ void p9_topk(const Args& a, LAS unsigned char* lds, int G, int tid) {
    unsigned char* ws = a.ws; const float* QP = (const float*)(ws + WS_QKV); const float* sub_keys = a.in[12];
    int* elist = (int*)(ws + WS_ATT); float* glist = (float*)(ws + WS_ATT + 8 * MiB);
    const int lane = tid & 63, wave = tid >> 6, c = lane & 15, g = lane >> 4;
    for (int i = tid; i < 256 * 8; i += NTHR) { const int row = i >> 3, ch = i & 7;
        const f32x4 p = *(const f32x4*)(sub_keys + row * 64 + ch * 8), q = *(const f32x4*)(sub_keys + row * 64 + ch * 8 + 4);
        const float v[8] = {p.x, p.y, p.z, p.w, q.x, q.y, q.z, q.w}; float r[8]; v4u hi, lo;
        hi.x = pkbf(v[0], v[1]); hi.y = pkbf(v[2], v[3]); hi.z = pkbf(v[4], v[5]); hi.w = pkbf(v[6], v[7]);
        r[0] = v[0] - bflo(hi.x); r[1] = v[1] - bfhi(hi.x); r[2] = v[2] - bflo(hi.y); r[3] = v[3] - bfhi(hi.y);
        r[4] = v[4] - bflo(hi.z); r[5] = v[5] - bfhi(hi.z); r[6] = v[6] - bflo(hi.w); r[7] = v[7] - bfhi(hi.w);
        lo.x = pkbf(r[0], r[1]); lo.y = pkbf(r[2], r[3]); lo.z = pkbf(r[4], r[5]); lo.w = pkbf(r[6], r[7]);
        *(LAS v4u*)(lds + row * TK_ROW + ch * 16) = hi; *(LAS v4u*)(lds + 256 * TK_ROW + row * TK_ROW + ch * 16) = lo; }
    __syncthreads();
    for (int task = blockIdx.x * NWAVES + wave; task < T / 2; task += G * NWAVES) {
        const int tok = task * 2 + (c >> 3), head = c & 7;
        unsigned T1[16], T2[16];
#pragma unroll 1
        for (int hf = 0; hf < 2; ++hf) {
            bf16x8 qh[2], ql[2];
#pragma unroll
            for (int ks = 0; ks < 2; ++ks) {
                const float* qp = QP + (size_t)tok * DM + head * 128 + hf * 64 + ks * 32 + 8 * g;
                const f32x4 p = *(const f32x4*)qp, q = *(const f32x4*)(qp + 4);
                v4u hi, lo; hi.x = pkbf(p.x, p.y); hi.y = pkbf(p.z, p.w); hi.z = pkbf(q.x, q.y); hi.w = pkbf(q.z, q.w);
                lo.x = pkbf(p.x - bflo(hi.x), p.y - bfhi(hi.x)); lo.y = pkbf(p.z - bflo(hi.y), p.w - bfhi(hi.y));
                lo.z = pkbf(q.x - bflo(hi.z), q.y - bfhi(hi.z)); lo.w = pkbf(q.z - bflo(hi.w), q.w - bfhi(hi.w));
                qh[ks] = __builtin_bit_cast(bf16x8, hi); ql[ks] = __builtin_bit_cast(bf16x8, lo);
            }
            unsigned P[32];
#pragma unroll
            for (int kt = 0; kt < 8; ++kt) {
                f32x4 acc = {0.f, 0.f, 0.f, 0.f};
#pragma unroll
                for (int ks = 0; ks < 2; ++ks) {
                    const LAS unsigned char* kp = lds + (hf * 128 + kt * 16 + c) * TK_ROW + ks * 64 + g * 16;
                    const bf16x8 kh = *(const LAS bf16x8*)kp, kl = *(const LAS bf16x8*)(kp + 256 * TK_ROW);
                    acc = __builtin_amdgcn_mfma_f32_16x16x32_bf16(kh, qh[ks], acc, 0, 0, 0);
                    acc = __builtin_amdgcn_mfma_f32_16x16x32_bf16(kl, qh[ks], acc, 0, 0, 0);
                    acc = __builtin_amdgcn_mfma_f32_16x16x32_bf16(kh, ql[ks], acc, 0, 0, 0);
                }
#pragma unroll
                for (int r = 0; r < 4; ++r) P[kt * 4 + r] = (mono(acc[r]) & ~127u) | (unsigned)(127 - (kt * 16 + r)) ;
            }
#pragma unroll
            for (int i = 0; i < 32; ++i) P[i] -= (unsigned)(4 * g);
            unsigned A[16], B[16];
#pragma unroll
            for (int i = 0; i < 16; ++i) { A[i] = P[i]; B[i] = P[16 + i]; }
            __builtin_amdgcn_sched_barrier(0);
            sort_desc<16>(A); __builtin_amdgcn_sched_barrier(0); sort_desc<16>(B); __builtin_amdgcn_sched_barrier(0); merge_top16(A, B);
            __builtin_amdgcn_sched_barrier(0);
            xmerge(A, 16); __builtin_amdgcn_sched_barrier(0); xmerge(A, 32); __builtin_amdgcn_sched_barrier(0);
#pragma unroll
            for (int i = 0; i < 16; ++i) { if (hf == 0) T1[i] = A[i]; else T2[i] = A[i]; }
        }
        float v1[16], v2[16]; unsigned long long i1lo = 0, i1hi = 0, i2lo = 0, i2hi = 0;
#pragma unroll
        for (int j = 0; j < 16; ++j) {
            v1[j] = unmono(T1[j] & ~127u); v2[j] = unmono(T2[j] & ~127u);
            const unsigned long long s1 = (unsigned long long)(127u - (T1[j] & 127u)) << ((j & 7) * 8), s2 = (unsigned long long)(127u - (T2[j] & 127u)) << ((j & 7) * 8);
            if (j < 8) { i1lo |= s1; i2lo |= s2; } else { i1hi |= s1; i2hi |= s2; }
        }
        unsigned top[16];
#pragma unroll
        for (int j = 0; j < 16; ++j) top[j] = (mono(v1[0] + v2[j]) & ~255u) | (unsigned)(255 - j);
#pragma unroll
        for (int aa = 1; aa < 16; ++aa)
#pragma unroll
            for (int bb = 0; bb < 16; ++bb)
                if ((aa + 1) * (bb + 1) <= 16) ins16(top, (mono(v1[aa] + v2[bb]) & ~255u) | (unsigned)(255 - (aa * 16 + bb)));
        if (g == 0) {
            float vals[16]; int ex[16]; float sum = 0.f;
            const float vmax = unmono(top[0] & ~255u);
#pragma unroll
            for (int r = 0; r < 16; ++r) { const int pos = 255 - (int)(top[r] & 255u);
                ex[r] = (int)(lookup8(i1lo, i1hi, pos >> 4) * 128u + lookup8(i2lo, i2hi, pos & 15));
                vals[r] = __expf(unmono(top[r] & ~255u) - vmax); sum += vals[r]; }
            const float inv = 1.f / sum; const size_t p = (size_t)tok * 8 + head;
#pragma unroll
            for (int r = 0; r < 4; ++r) {
                *(int4*)(elist + p * 16 + 4 * r) = make_int4(ex[4 * r], ex[4 * r + 1], ex[4 * r + 2], ex[4 * r + 3]);
                f32x4 gg; gg.x = vals[4 * r] * inv; gg.y = vals[4 * r + 1] * inv; gg.z = vals[4 * r + 2] * inv; gg.w = vals[4 * r + 3] * inv;
                *(f32x4*)(glist + p * 16 + 4 * r) = gg;
            }
        }
    }
}

typedef float f32x2 __attribute__((ext_vector_type(2)));
__device__ __forceinline__ float wave_total(float v) {
    v += dppf<0xB1>(v); v += dppf<0x4E>(v); v += dppf<0x141>(v); v += dppf<0x140>(v);
    const int iv = __builtin_bit_cast(int, v);
    return (__builtin_bit_cast(float, __builtin_amdgcn_readlane(iv, 0)) + __builtin_bit_cast(float, __builtin_amdgcn_readlane(iv, 16)))
         + (__builtin_bit_cast(float, __builtin_amdgcn_readlane(iv, 32)) + __builtin_bit_cast(float, __builtin_amdgcn_readlane(iv, 48)));
}
__device__ __forceinline__ float gelu1(float v) {
    const float av = fabsf(v), t = __builtin_amdgcn_rcpf(av * 0.2316418882f + 1.0f);
    float q = t * 0.5307027145f + (-0.7265760135f); q = q * t + 0.7107068705f; q = q * t + (-0.142248368f); q = q * t + 0.127414796f; q = q * t;
    const float e = __builtin_amdgcn_exp2f((v * v) * (-0.72134752044f)), m = v * (q * e);
    return v < 0.f ? m : v - m;
}
__device__ __forceinline__ void ld16c(const float* p, float (&v)[16]) {
#pragma unroll
    for (int q = 0; q < 4; ++q) { const f32x4 t = ((const f32x4*)p)[q]; v[4 * q] = t.x; v[4 * q + 1] = t.y; v[4 * q + 2] = t.z; v[4 * q + 3] = t.w; }
}
constexpr int PW_X = 0, PW_XROW = 1088, PW_UT = 4352, PW_UROW = 272, PW_LIST = 8704, PW_BYTES = 12800;
__device__ __forceinline__ void peer_axpy(float (&f)[16], const v4u vr, float act) {
#pragma unroll
    for (int q = 0; q < 4; ++q) {
        const f32x2 lo = __builtin_amdgcn_cvt_pk_f32_fp8((int)vr[q], false), hi = __builtin_amdgcn_cvt_pk_f32_fp8((int)vr[q], true);
        f[4 * q] += act * lo.x; f[4 * q + 1] += act * lo.y; f[4 * q + 2] += act * hi.x; f[4 * q + 3] += act * hi.y;
    }
}
__device__ __forceinline__ void peer_pair(float (&f)[16], const v4u vr, const f32x4 a4, const v2u myent, int p) {
    const float gp = __builtin_bit_cast(float, __builtin_amdgcn_readlane((int)myent.y, p));
    const float av = (p & 3) == 0 ? a4.x : ((p & 3) == 1 ? a4.y : ((p & 3) == 2 ? a4.z : a4.w));
    const float act = __builtin_bit_cast(float, __builtin_amdgcn_readlane(__float_as_int(av), 16 * (p >> 2))) * gp;
    peer_axpy(f, vr, act);
    __builtin_amdgcn_sched_barrier(0);
}
__device__ __forceinline__ void peer_batch(float (&f)[16], const LAS unsigned char* wl, int t, int bt, const unsigned char* U8, const unsigned char* V8, int lane) {
    const int l15 = lane & 15, g = lane >> 4;
    const LAS unsigned char* ent = wl + PW_LIST + 1024 * t + 128 * bt;
    const v2u myent = *(const LAS v2u*)(ent + 8 * l15);
    v4u ur[4][4], vrA[4];
    {
        int er[4];
#pragma unroll
        for (int q = 0; q < 4; ++q) er[q] = (int)(*(const LAS unsigned*)(ent + 8 * (4 * q + g)));
#pragma unroll
        for (int c = 0; c < 4; ++c)
#pragma unroll
            for (int q = 0; q < 4; ++q) ur[c][q] = *(const v4u*)(U8 + (size_t)er[q] * 1024 + 256 * c + 16 * l15);
    }
#pragma unroll
    for (int p = 0; p < 4; ++p) { const int ep = __builtin_amdgcn_readlane((int)myent.x, p); vrA[p] = *(const v4u*)(V8 + (size_t)ep * 1024 + 16 * lane); }
    __builtin_amdgcn_sched_barrier(0);
    f32x4 acc = {0.f, 0.f, 0.f, 0.f};
#pragma unroll
    for (int c = 0; c < 4; ++c) {
#pragma unroll
        for (int q = 0; q < 4; ++q) *(LAS v4u*)(wl + PW_UT + (4 * q + g) * PW_UROW + 16 * l15) = ur[c][q];
        asm volatile("s_waitcnt lgkmcnt(0)" ::: "memory");
#pragma unroll
        for (int j = 0; j < 4; ++j) {
            const v4u a16 = *(const LAS v4u*)(wl + PW_UT + l15 * PW_UROW + 64 * j + 16 * g);
            const v4u x16 = *(const LAS v4u*)(wl + PW_X + t * PW_XROW + 256 * c + 64 * j + 16 * g);
            const long a0 = (long)(((unsigned long long)a16.y << 32) | a16.x), a1 = (long)(((unsigned long long)a16.w << 32) | a16.z);
            const long x0 = (long)(((unsigned long long)x16.y << 32) | x16.x), x1 = (long)(((unsigned long long)x16.w << 32) | x16.z);
            acc = __builtin_amdgcn_mfma_f32_16x16x32_fp8_fp8(a0, x0, acc, 0, 0, 0);
            acc = __builtin_amdgcn_mfma_f32_16x16x32_fp8_fp8(a1, x1, acc, 0, 0, 0);
        }
        asm volatile("s_waitcnt lgkmcnt(0)" ::: "memory");
    }
    __builtin_amdgcn_sched_barrier(0);
    f32x4 a4;
#pragma unroll
    for (int r = 0; r < 4; ++r) a4[r] = gelu1(acc[r] * (1.f / PEER_USCALE));
    v4u vrB[4], vrC[4], vrD[4];
#pragma unroll
    for (int p = 0; p < 4; ++p) { const int ep = __builtin_amdgcn_readlane((int)myent.x, 4 + p); vrB[p] = *(const v4u*)(V8 + (size_t)ep * 1024 + 16 * lane); }
#pragma unroll
    for (int p = 0; p < 4; ++p) { const int ep = __builtin_amdgcn_readlane((int)myent.x, 8 + p); vrC[p] = *(const v4u*)(V8 + (size_t)ep * 1024 + 16 * lane); }
    __builtin_amdgcn_sched_barrier(0);
#pragma unroll
    for (int p = 0; p < 4; ++p) peer_pair(f, vrA[p], a4, myent, p);
#pragma unroll
    for (int p = 0; p < 4; ++p) { const int ep = __builtin_amdgcn_readlane((int)myent.x, 12 + p); vrD[p] = *(const v4u*)(V8 + (size_t)ep * 1024 + 16 * lane); }
    __builtin_amdgcn_sched_barrier(0);
#pragma unroll
    for (int p = 0; p < 4; ++p) peer_pair(f, vrB[p], a4, myent, 4 + p);
#pragma unroll
    for (int p = 0; p < 4; ++p) peer_pair(f, vrC[p], a4, myent, 8 + p);
#pragma unroll
    for (int p = 0; p < 4; ++p) peer_pair(f, vrD[p], a4, myent, 12 + p);
}
__device__ __forceinline__ void p10_peer(const Args& a, LAS unsigned char* lds, int G, int lane, int wave) {
    unsigned char* ws = a.ws; const unsigned char* U8 = ws + WS_U; const unsigned char* V8 = ws + WS_V;
    const int* elist = (const int*)(ws + WS_ATT); const float* glist = (const float*)(ws + WS_ATT + 8 * MiB);
    const float* mod = (const float*)(ws + WS_MOD); float* out = a.out;
    const int NGW = G * NWAVES;
    LAS unsigned char* wl = lds + wave * PW_BYTES;
    for (int grp0 = blockIdx.x * NWAVES + wave; grp0 < T / 4; grp0 += NGW) {
        const int tok0 = grp0 * 4, b = tok0 >> 11;
        {
            float sc[16], sh[16]; ld16c(mod + b * 6144 + 4096 + 16 * lane, sc); ld16c(mod + b * 6144 + 3072 + 16 * lane, sh);
            int e0[4], e1[4]; float g0[4], g1[4];
#pragma unroll
            for (int t = 0; t < 4; ++t) {
                float xv[16]; ld16c(out + (size_t)(tok0 + t) * DM + 16 * lane, xv);
#pragma unroll
                for (int j = 0; j < 16; ++j) xv[j] = xv[j] * (1.f + sc[j]) + sh[j];
                v4u o;
#pragma unroll
                for (int q = 0; q < 4; ++q) { int w = 0; w = __builtin_amdgcn_cvt_pk_fp8_f32(xv[4 * q], xv[4 * q + 1], w, false); w = __builtin_amdgcn_cvt_pk_fp8_f32(xv[4 * q + 2], xv[4 * q + 3], w, true); o[q] = (unsigned)w; }
                *(LAS v4u*)(wl + PW_X + t * PW_XROW + 16 * lane) = o;
                e0[t] = elist[(size_t)(tok0 + t) * 128 + lane]; e1[t] = elist[(size_t)(tok0 + t) * 128 + 64 + lane];
                g0[t] = glist[(size_t)(tok0 + t) * 128 + lane]; g1[t] = glist[(size_t)(tok0 + t) * 128 + 64 + lane];
            }
            int base[4] = {0, 0, 0, 0};
#pragma unroll 1
            for (int s = 0; s < 16; ++s) {
#pragma unroll
                for (int t = 0; t < 4; ++t) {
                    const bool h0 = (e0[t] >> 10) == s, h1 = (e1[t] >> 10) == s;
                    const unsigned long long m0 = __ballot(h0), m1 = __ballot(h1);
                    const int c0 = __builtin_popcountll(m0), c1 = __builtin_popcountll(m1);
                    const int r0 = (int)__builtin_amdgcn_mbcnt_hi((unsigned)(m0 >> 32), __builtin_amdgcn_mbcnt_lo((unsigned)m0, 0u));
                    const int r1 = (int)__builtin_amdgcn_mbcnt_hi((unsigned)(m1 >> 32), __builtin_amdgcn_mbcnt_lo((unsigned)m1, 0u));
                    if (h0) { v2u w; w.x = (unsigned)e0[t]; w.y = __float_as_uint(g0[t]); *(LAS v2u*)(wl + PW_LIST + 1024 * t + 8 * (base[t] + r0)) = w; }
                    if (h1) { v2u w; w.x = (unsigned)e1[t]; w.y = __float_as_uint(g1[t]); *(LAS v2u*)(wl + PW_LIST + 1024 * t + 8 * (base[t] + c0 + r1)) = w; }
                    base[t] += c0 + c1;
                }
            }
            asm volatile("s_waitcnt lgkmcnt(0)" ::: "memory");
        }
        float f[4][16];
#pragma unroll
        for (int t = 0; t < 4; ++t)
#pragma unroll
            for (int jj = 0; jj < 16; ++jj) f[t][jj] = 0.f;
#pragma unroll 1
        for (int bt = 0; bt < 8; ++bt) {
#pragma unroll
            for (int t = 0; t < 4; ++t) peer_batch(f[t], wl, t, bt, U8, V8, lane);
        }
        float g2[16], lg[16], lb[16];
        { const float* lgp = a.in[15]; const float* lbp = a.in[16]; asm volatile("" : "+s"(lgp), "+s"(lbp));
          ld16c(mod + b * 6144 + 5120 + 16 * lane, g2); ld16c(lgp + 16 * lane, lg); ld16c(lbp + 16 * lane, lb); }
#pragma unroll
        for (int t = 0; t < 4; ++t) {
            float z[16]; ld16c(out + (size_t)(tok0 + t) * DM + 16 * lane, z);
            float sm = 0.f;
#pragma unroll
            for (int jj = 0; jj < 16; ++jj) { z[jj] = DN_ALPHA * z[jj] + (1.f + g2[jj]) * f[t][jj]; sm += z[jj]; }
            const float mu = wave_total(sm) * (1.f / DM); float q = 0.f;
#pragma unroll
            for (int jj = 0; jj < 16; ++jj) { z[jj] -= mu; q += z[jj] * z[jj]; }
            const float rs = rsqrtf(wave_total(q) * (1.f / DM) + LN_EPS);
#pragma unroll
            for (int q4 = 0; q4 < 4; ++q4) { f32x4 o; o.x = z[4 * q4] * rs * lg[4 * q4] + lb[4 * q4]; o.y = z[4 * q4 + 1] * rs * lg[4 * q4 + 1] + lb[4 * q4 + 1];
                o.z = z[4 * q4 + 2] * rs * lg[4 * q4 + 2] + lb[4 * q4 + 2]; o.w = z[4 * q4 + 3] * rs * lg[4 * q4 + 3] + lb[4 * q4 + 3];
                ((f32x4*)(out + (size_t)(tok0 + t) * DM + 16 * lane))[q4] = o; }
        }
    }
}

constexpr int N_PHASES = 11;
__global__ void __launch_bounds__(NTHR, 2) mega(Args args) {
    extern __shared__ __attribute__((aligned(16))) unsigned char lds_raw[];
    LAS unsigned char* lds = (LAS unsigned char*)lds_raw;
    const int tid = threadIdx.x, lane = tid & 63, wave = __builtin_amdgcn_readfirstlane(tid >> 6), G = gridDim.x;
    unsigned char* ws = args.ws;
    volatile LAS unsigned* MISC = (volatile LAS unsigned*)(lds + MISC_OFF);
    for (int u = tid; u < (LDS_BYTES - RING_BYTES) / 4; u += NTHR) ((LAS unsigned*)(lds + RING_BYTES))[u] = 0u;
    __syncthreads();
    const int lo = args.ph_lo, hi = args.ph_hi;
    unsigned* barw = (unsigned*)(ws + WS_CTL) + CW_BAR + args.bar_idx * XCD_BAR_WORDS;
    XcdBarrier bar; bar.bar = barw; bar.x = 0; bar.st = nullptr;
    if (hi - lo > 1) bar = xcd_barrier_post(barw, MISC + 8);
#define IN(k) (lo <= (k) && (k) < hi)
#define REPS(k) ((PROBE_PH == (k)) ? 1 + PROBE_N : 1)
#define REPBAR(k, rep) do { if ((rep) + 1 < REPS(k)) xcd_barrier(bar); } while (0)
#define SEAM(k) do { if (IN(k) && IN((k) + 1)) xcd_barrier(bar); } while (0)

    if (IN(0)) { for (int rep = 0; rep < REPS(0); ++rep) { p0_prologue(args, lds, G, tid, lane, wave); REPBAR(0, rep); } } SEAM(0);
    if (IN(1)) { for (int rep = 0; rep < REPS(1); ++rep) { p1_mod_h(args, lds, G, tid, lane, wave); REPBAR(1, rep); } } SEAM(1);
    if (IN(2)) { for (int rep = 0; rep < REPS(2); ++rep) {
        __syncthreads();
        pg8::Gemm g{(const pg8::bf16_t*)(ws + WS_H), (const pg8::bf16_t*)(ws + WS_WIN), T, NQKV, DM};
        pg8::StaticOrder S; S.init(T, NQKV, G, (int)blockIdx.x);
        EpiQKV E{pg8::EpiBf16<0>{(pg8::bf16_t*)(ws + WS_QKV), NQKV, nullptr, 0, 0}, (float*)(ws + WS_KMEAN)};
        pg8::gemm_phase<EpiQKV, pg8::StaticOrder, false>(lds, g, S, E, nullptr);
        REPBAR(2, rep); }
    } SEAM(2);
    if (IN(4)) {
        if (PROBE_PH == 4) { p4_attn<PROBE_N>(args, lds, G, tid, lane, wave); xcd_barrier(bar); }
        p4_attn<0>(args, lds, G, tid, lane, wave); } SEAM(4);
    if (IN(5)) { for (int rep = 0; rep < REPS(5); ++rep) { p5_combine_rms(args, G, lane, wave); REPBAR(5, rep); } } SEAM(5);
    if (IN(6)) { for (int rep = 0; rep < REPS(6); ++rep) {
        __syncthreads();
        pg8::Gemm g{(const pg8::bf16_t*)args.out, (const pg8::bf16_t*)(ws + WS_WOUT), T, DM, DM};
        pg8::StaticOrder S; S.init(T, DM, G, (int)blockIdx.x);
        pg8::EpiF32 E{(float*)(ws + WS_QKV), DM, nullptr};
        pg8::gemm_phase<pg8::EpiF32, pg8::StaticOrder, false>(lds, g, S, E, nullptr);
        REPBAR(6, rep); }
    } SEAM(6);
    if (IN(7)) { for (int rep = 0; rep < REPS(7); ++rep) { p7_ln1(args, G, lane, wave); REPBAR(7, rep); } } SEAM(7);
    if (IN(8)) { for (int rep = 0; rep < REPS(8); ++rep) {
        __syncthreads();
        pg8::Gemm g{(const pg8::bf16_t*)(ws + WS_H), (const pg8::bf16_t*)(ws + WS_WQ), T, DM, DM};
        pg8::StaticOrder S; S.init(T, DM, G, (int)blockIdx.x);
        pg8::EpiF32 E{(float*)(ws + WS_QKV), DM, nullptr};
        pg8::gemm_phase<pg8::EpiF32, pg8::StaticOrder, false>(lds, g, S, E, nullptr);
        REPBAR(8, rep); }
    } SEAM(8);
    if (IN(9)) { for (int rep = 0; rep < REPS(9); ++rep) { __syncthreads(); p9_topk(args, lds, G, tid); REPBAR(9, rep); } } SEAM(9);
    if (IN(10)) { __syncthreads(); p10_peer(args, lds, G, lane, wave); }
#undef IN
#undef SEAM
}
}

#ifndef MK_N_LAUNCHES
#define MK_N_LAUNCHES 1
#endif

extern "C" void kernel_launch(void* const* d_in, const int* in_sizes, int n_in, void* d_out, int out_size, void* d_ws, size_t ws_size, hipStream_t stream) {
    static int grid = 0;
    if (!grid) {
        int dev = 0, cus = 0, per_cu = 0;
        if (hipGetDevice(&dev) != hipSuccess || hipDeviceGetAttribute(&cus, hipDeviceAttributeMultiprocessorCount, dev) != hipSuccess) { fprintf(stderr, "kernel_launch: device query failed\n"); return; }
        if (hipFuncSetAttribute((const void*)mk::mega, hipFuncAttributeMaxDynamicSharedMemorySize, mk::LDS_BYTES) != hipSuccess) { fprintf(stderr, "kernel_launch: hipFuncSetAttribute failed\n"); return; }
        if (hipOccupancyMaxActiveBlocksPerMultiprocessor(&per_cu, (const void*)mk::mega, mk::NTHR, mk::LDS_BYTES) != hipSuccess || per_cu < 1) { fprintf(stderr, "kernel_launch: occupancy query says %d\n", per_cu); return; }
        grid = cus;
    }
    if (n_in != 17 || ws_size < mk::WS_END) { fprintf(stderr, "kernel_launch: unexpected n_in %d / ws %zu\n", n_in, ws_size); return; }
    (void)hipMemsetAsync((char*)d_ws + mk::WS_CTL, 0, mk::CTL_ZERO_BYTES, stream);
    mk::Args a{};
    for (int i = 0; i < 17; ++i) a.in[i] = (const float*)d_in[i];
    a.out = (float*)d_out; a.ws = (unsigned char*)d_ws;
    a.ph_lo = 0; a.ph_hi = mk::N_PHASES;
    hipLaunchKernelGGL(mk::mega, dim3(grid), dim3(mk::NTHR), mk::LDS_BYTES, stream, a);
}
```
